# Optimizing an MI355X kernel written in HIP

```python
import jax, jax.numpy as jnp
from jax import lax
import numpy as np

D_MODEL = 1024
BATCH = 2
SEQ = 16384
DEPTH = 2

CHUNK = 64
N_META = 16
BLOCK_Q = 128
EPS = 1e-6

SB_HEADS = 8
SB_HEAD_DIM = D_MODEL // 16
SB_WIDTH = SB_HEADS * SB_HEAD_DIM
CONV_CH = D_MODEL // 2
CONV_K = 3
IN_COLS = 3 * SB_WIDTH + 3 * CONV_CH

POOL_WINDOWS = (2, 4, 8, 16)
POOL_CH = D_MODEL // len(POOL_WINDOWS)

PEER_HEADS = 8
PEER_NKEYS = 128
PEER_N = PEER_NKEYS * PEER_NKEYS
PEER_TOPK = 16
PEER_HALF = 128
PEER_TOKEN_BLOCK = 128

N_EVEN = (DEPTH + 1) // 2
N_ODD = DEPTH // 2

kernel_name = 'hybrid_stickbreak_conv_pool_peer_encoder'


def rms_norm(x, g):
    xf = x.astype(jnp.float32)
    y = xf * lax.rsqrt(jnp.mean(xf * xf, axis=-1, keepdims=True) + EPS)
    return (y * g.astype(jnp.float32)).astype(x.dtype)


def stick_breaking_attention(q, k, v):
    b, h, lp, dh = q.shape
    nb = lp // BLOCK_Q
    scale = dh ** -0.5
    kf = k.astype(jnp.float32)
    vf = v.astype(jnp.float32)
    qb = q.astype(jnp.float32).reshape(b, h, nb, BLOCK_Q, dh).transpose(2, 0, 1, 3, 4)
    key_pos = jnp.arange(lp)

    def one_block(args):
        q_blk, blk = args
        z = jnp.einsum('bhqd,bhkd->bhqk', q_blk, kf) * scale
        q_pos = blk * BLOCK_Q + jnp.arange(BLOCK_Q)
        causal = key_pos[None, :] < q_pos[:, None]
        log_keep = jnp.where(causal, jax.nn.log_sigmoid(-z), 0.0)
        later = lax.cumsum(log_keep, axis=3, reverse=True) - log_keep
        w = jnp.where(causal, jnp.exp(jax.nn.log_sigmoid(z) + later), 0.0)
        return jnp.einsum('bhqk,bhkd->bhqd', w, vf)

    out = lax.map(one_block, (qb, jnp.arange(nb)))
    return out.transpose(1, 2, 0, 3, 4).reshape(b, h, lp, dh).astype(v.dtype)


def causal_short_conv(u, w):
    lp = u.shape[1]
    up = jnp.pad(u, ((0, 0), (CONV_K - 1, 0), (0, 0)))
    y = w[0] * up[:, 0:lp]
    for i in range(1, CONV_K):
        y = y + w[i] * up[:, i:i + lp]
    return y


def even_layer(x, norm_g, w_in, q_g, k_g, conv_w, w_out):
    b, lp, _ = x.shape
    h = rms_norm(x, norm_g)
    proj = h @ w_in
    cuts = [SB_WIDTH, 2 * SB_WIDTH, 3 * SB_WIDTH, 3 * SB_WIDTH + CONV_CH, 3 * SB_WIDTH + 2 * CONV_CH]
    q, k, v, gate_b, gate_c, u = jnp.split(proj, cuts, axis=-1)
    q = rms_norm(q.reshape(b, lp, SB_HEADS, SB_HEAD_DIM), q_g).transpose(0, 2, 1, 3)
    k = rms_norm(k.reshape(b, lp, SB_HEADS, SB_HEAD_DIM), k_g).transpose(0, 2, 1, 3)
    v = v.reshape(b, lp, SB_HEADS, SB_HEAD_DIM).transpose(0, 2, 1, 3)
    att = stick_breaking_attention(q, k, v).transpose(0, 2, 1, 3).reshape(b, lp, SB_WIDTH)
    conv = gate_b * causal_short_conv(gate_c * u, conv_w)
    return jnp.concatenate([att, conv], axis=-1) @ w_out


def odd_layer(x, norm_g, pool_w, pool_scale):
    b, lp, _ = x.shape
    hf = rms_norm(x, norm_g).astype(jnp.float32)
    csum = jnp.pad(jnp.cumsum(hf, axis=1), ((0, 0), (1, 0), (0, 0)))
    count = jnp.arange(1, lp + 1).astype(jnp.float32)
    diffs = []
    for g, w in enumerate(POOL_WINDOWS):
        sl = slice(g * POOL_CH, (g + 1) * POOL_CH)
        c = csum[:, :, sl]
        lo = jnp.pad(c, ((0, 0), (w - 1, 0), (0, 0)))[:, :lp]
        mean = (c[:, 1:] - lo) / jnp.minimum(count, float(w))[None, :, None]
        diffs.append(mean - hf[:, :, sl])
    d = jnp.stack(diffs, axis=2)
    y = jnp.einsum('blgc,gce->blge', d, pool_w.astype(jnp.float32)).reshape(b, lp, D_MODEL)
    return (y * pool_scale.astype(jnp.float32)).astype(x.dtype)


def peer_ffn(x, norm_g, w_query, sub_keys, expert_u, expert_v):
    b, lp, d = x.shape
    h = rms_norm(x, norm_g).reshape(-1, PEER_TOKEN_BLOCK, d)
    keys = sub_keys.astype(jnp.float32)

    def one_block(hb):
        t = hb.shape[0]
        q = (hb @ w_query).astype(jnp.float32).reshape(t, PEER_HEADS, 2, PEER_HALF)
        s = jnp.einsum('thpc,phkc->thpk', q, keys)
        sv, si = lax.top_k(s, PEER_TOPK)
        cand = (sv[:, :, 0, :, None] + sv[:, :, 1, None, :]).reshape(t, PEER_HEADS, PEER_TOPK * PEER_TOPK)
        cand_idx = (si[:, :, 0, :, None] * PEER_NKEYS + si[:, :, 1, None, :]).reshape(t, PEER_HEADS, PEER_TOPK * PEER_TOPK)
        top_s, top_pos = lax.top_k(cand, PEER_TOPK)
        idx = jnp.take_along_axis(cand_idx, top_pos, axis=-1).reshape(t, PEER_HEADS * PEER_TOPK)
        gate = jax.nn.softmax(top_s, axis=-1).reshape(t, PEER_HEADS * PEER_TOPK)
        u = expert_u[idx]
        act = jax.nn.gelu(jnp.einsum('tnd,td->tn', u, hb).astype(jnp.float32))
        return jnp.einsum('tn,tnd->td', (gate * act).astype(expert_v.dtype), expert_v[idx])

    y = lax.map(one_block, h)
    return y.reshape(b, lp, d).astype(x.dtype)


def setup_inputs(seed: int = 0) -> dict:
    key = jax.random.key(seed)
    ks = jax.random.split(key, 16)
    f32 = jnp.float32
    nrm = lambda k, shape, scale: jax.random.normal(k, shape, f32) * scale
    gain = lambda k, shape: 1.0 + 0.02 * jax.random.normal(k, shape, f32)
    return {
        'x': nrm(ks[0], (BATCH, SEQ, D_MODEL), 1.0),
        'meta_tokens': nrm(ks[1], (N_META, D_MODEL), 1.0),
        'even_norm_g': gain(ks[2], (N_EVEN, D_MODEL)),
        'even_w_in': nrm(ks[3], (N_EVEN, D_MODEL, IN_COLS), D_MODEL ** -0.5),
        'even_q_norm_g': gain(ks[4], (N_EVEN, SB_HEAD_DIM)),
        'even_k_norm_g': gain(ks[5], (N_EVEN, SB_HEAD_DIM)),
        'even_conv_w': nrm(ks[6], (N_EVEN, CONV_K, CONV_CH), CONV_K ** -0.5),
        'even_w_out': nrm(ks[7], (N_EVEN, SB_WIDTH + CONV_CH, D_MODEL), (SB_WIDTH + CONV_CH) ** -0.5),
        'odd_norm_g': gain(ks[8], (N_ODD, D_MODEL)),
        'odd_pool_w': nrm(ks[9], (N_ODD, len(POOL_WINDOWS), POOL_CH, POOL_CH), POOL_CH ** -0.5),
        'odd_pool_scale': gain(ks[10], (N_ODD, D_MODEL)),
        'ffn_norm_g': gain(ks[11], (DEPTH, D_MODEL)),
        'peer_w_query': nrm(ks[12], (DEPTH, D_MODEL, PEER_HEADS * 2 * PEER_HALF), D_MODEL ** -0.5),
        'peer_sub_keys': nrm(ks[13], (DEPTH, 2, PEER_HEADS, PEER_NKEYS, PEER_HALF), PEER_HALF ** -0.5),
        'peer_u': nrm(ks[14], (DEPTH, PEER_N, D_MODEL), D_MODEL ** -0.5),
        'peer_v': nrm(ks[15], (DEPTH, PEER_N, D_MODEL), PEER_HEADS ** -0.5),
    }


def reference(x, meta_tokens, even_norm_g, even_w_in, even_q_norm_g, even_k_norm_g, even_conv_w, even_w_out, odd_norm_g, odd_pool_w, odd_pool_scale, ffn_norm_g, peer_w_query, peer_sub_keys, peer_u, peer_v):
    b, seq, d = x.shape
    total = N_META + seq
    lp = -(-total // BLOCK_Q) * BLOCK_Q
    meta = jnp.broadcast_to(meta_tokens[None].astype(x.dtype), (b, N_META, d))
    h = jnp.concatenate([meta, x], axis=1)
    h = jnp.pad(h, ((0, 0), (0, lp - total), (0, 0)))
    for layer in range(DEPTH):
        i = layer // 2
        if layer % 2 == 0:
            h = h + even_layer(h, even_norm_g[i], even_w_in[i], even_q_norm_g[i], even_k_norm_g[i], even_conv_w[i], even_w_out[i])
        else:
            h = h + odd_layer(h, odd_norm_g[i], odd_pool_w[i], odd_pool_scale[i])
        h = h + peer_ffn(h, ffn_norm_g[layer], peer_w_query[layer], peer_sub_keys[layer], peer_u[layer], peer_v[layer])
    return h[:, N_META:N_META + seq]
```

```cpp
#include <hip/hip_runtime.h>
#include <hip/hip_cooperative_groups.h>
#include <stdint.h>
#include <stdio.h>
namespace cg = cooperative_groups;

typedef unsigned short bf16_t;
typedef unsigned u32x4 __attribute__((ext_vector_type(4)));
typedef float f32x4 __attribute__((ext_vector_type(4)));

constexpr int D = 1024, NB = 2, SEQ = 16384, NMETA = 16;
constexpr int XROWS = NB * SEQ;
constexpr int MROW0 = XROWS;
constexpr int NROWS = XROWS + NMETA;
constexpr int RP = 33024;
constexpr int NPOS = SEQ + NMETA;
constexpr int INC = 3072;
constexpr int P1W = 2560;
constexpr int NEXP = 16384;
constexpr float EPS = 1e-6f;
constexpr float LOG2E = 1.4426950408889634f;
constexpr float CARRY2_STOP = -150.5f;

constexpr size_t MiB = 1u << 20;
constexpr size_t WS_CTL = 0;
constexpr size_t WS_WIN = 1 * MiB;
constexpr size_t WS_WOUT = 7 * MiB;
constexpr size_t WS_WQ = 9 * MiB;
constexpr size_t WS_KEYS = 17 * MiB;
constexpr size_t WS_POOL = 18 * MiB;
constexpr size_t WS_RS0 = 19 * MiB;
constexpr size_t WS_SSQ1 = 20 * MiB;
constexpr size_t WS_RS2 = 23 * MiB;
constexpr size_t WS_SSQ3 = 24 * MiB;
constexpr size_t WS_UB = 32 * MiB;
constexpr size_t WS_VB = 96 * MiB;
constexpr size_t WS_XB = 160 * MiB;
constexpr size_t WS_H1 = 225 * MiB;
constexpr size_t WS_P1 = 290 * MiB;
constexpr size_t WS_IDX = 452 * MiB;
constexpr size_t WS_GATE = 469 * MiB;
constexpr size_t WS_END = 486 * MiB;

__device__ __forceinline__ float bf2f(bf16_t v) { return __uint_as_float(((unsigned)v) << 16); }
__device__ __forceinline__ float bflo(unsigned w) { return __uint_as_float(w << 16); }
__device__ __forceinline__ float bfhi(unsigned w) { return __uint_as_float(w & 0xffff0000u); }
__device__ __forceinline__ bf16_t f2bf(float f) { unsigned u = __float_as_uint(f); return (bf16_t)((u + 0x7fffu + ((u >> 16) & 1u)) >> 16); }
__device__ __forceinline__ unsigned pk2(float lo, float hi) { return (unsigned)f2bf(lo) | ((unsigned)f2bf(hi) << 16); }
__device__ __forceinline__ float wave_sum(float v) {
#pragma unroll
    for (int o = 1; o < 64; o <<= 1) v += __shfl_xor(v, o);
    return v;
}
__device__ __forceinline__ int prow(int b, int p) { return p < NMETA ? MROW0 + p : b * SEQ + (p - NMETA); }
__device__ __forceinline__ void rowpos(int row, int& b, int& p) { if (row >= MROW0) { b = 0; p = row - MROW0; } else { b = row >> 14; p = (row & (SEQ - 1)) + NMETA; } }
__host__ __device__ __forceinline__ int win_btrow(int u64, int d) { return 256 * (u64 >> 2) + 128 * (d >> 5) + 32 * (u64 & 3) + (d & 31); }
__host__ __device__ __forceinline__ int win_srccol(int u64, int d) {
    if (u64 < 24) return 64 * u64 + d;
    if (u64 < 32) return 1536 + 64 * (u64 - 24) + d;
    const int c32 = u64 - 32;
    return d < 32 ? 2048 + 32 * c32 + d : 2560 + 32 * c32 + (d - 32);
}
__device__ __forceinline__ float gelu_tanh(float x) {
    const float y = 0.7978845608028654f * (x + 0.044715f * x * x * x);
    const float e = __expf(2.f * y);
    const float t = 1.f - 2.f / (1.f + e);
    return 0.5f * x * (1.f + t);
}

struct Args {
    const float* x; const float* meta; const float* even_g; const float* w_in; const float* qg; const float* kg; const float* conv_w; const float* w_out;
    const float* odd_g; const float* pool_w; const float* pool_scale; const float* ffn_g; const float* w_query; const float* sub_keys; const float* peer_u; const float* peer_v;
    float* out; unsigned char* ws; int ph_lo, ph_hi;
};

__device__ __forceinline__ void p0_prep(const Args& a, long gtid, long gsz) {
    unsigned char* ws = a.ws;
    bf16_t* WinT = (bf16_t*)(ws + WS_WIN); bf16_t* WoutT = (bf16_t*)(ws + WS_WOUT); bf16_t* WqT = (bf16_t*)(ws + WS_WQ);
    bf16_t* KeysB = (bf16_t*)(ws + WS_KEYS); bf16_t* PoolT = (bf16_t*)(ws + WS_POOL);
    bf16_t* UB = (bf16_t*)(ws + WS_UB); bf16_t* VB = (bf16_t*)(ws + WS_VB); bf16_t* XB = (bf16_t*)(ws + WS_XB); float* RS0 = (float*)(ws + WS_RS0);
    for (long i = gtid; i < (long)INC * D; i += gsz) {
        const int k = (int)(i % D), l = (int)(i / D), u64 = l >> 6, d = l & 63;
        WinT[(size_t)win_btrow(u64, d) * D + k] = f2bf(a.w_in[(size_t)k * INC + win_srccol(u64, d)] * a.even_g[k]);
    }
    for (long i = gtid; i < (long)D * D; i += gsz) { const int k = (int)(i % D), n = (int)(i / D); WoutT[(size_t)n * D + k] = f2bf(a.w_out[(size_t)k * D + n]); }
    for (long i = gtid; i < 2L * 2048 * D; i += gsz) {
        const int k = (int)(i % D); const long r = i / D; const int n = (int)(r % 2048), l = (int)(r / 2048);
        WqT[((size_t)l * 2048 + n) * D + k] = f2bf(a.w_query[((size_t)l * D + k) * 2048 + n] * a.ffn_g[l * D + k]);
    }
    for (long i = gtid; i < 2L * 2 * 8 * 128 * 128; i += gsz) KeysB[i] = f2bf(a.sub_keys[i]);
    for (long i = gtid; i < 1024L * 256; i += gsz) {
        const int c = (int)(i % 256), n = (int)(i / 256), g = n >> 8, e = n & 255;
        PoolT[(size_t)n * 256 + c] = f2bf(a.pool_w[((size_t)g * 256 + c) * 256 + e] * a.odd_g[g * 256 + c] * a.pool_scale[n]);
    }
    for (long i = gtid; i < 2L * NEXP * D / 4; i += gsz) {
        const long e4 = i * 4; const int l = (int)(e4 / ((long)NEXP * D)), dcol = (int)(e4 % D);
        const f32x4 u = *(const f32x4*)(a.peer_u + e4), v = *(const f32x4*)(a.peer_v + e4), g = *(const f32x4*)(a.ffn_g + l * D + dcol);
        *(uint2*)(UB + e4) = make_uint2(pk2(u[0] * g[0], u[1] * g[1]), pk2(u[2] * g[2], u[3] * g[3]));
        *(uint2*)(VB + e4) = make_uint2(pk2(v[0], v[1]), pk2(v[2], v[3]));
    }
    const long gw = gtid >> 6, nw = gsz >> 6; const int lane = (int)(gtid & 63);
    for (long row = gw; row < RP; row += nw) {
        bf16_t* o = XB + (size_t)row * D;
        if (row >= NROWS) { for (int j = 0; j < 4; ++j) *(uint2*)(o + 256 * j + 4 * lane) = make_uint2(0u, 0u); if (lane == 0) RS0[row] = 1.f; continue; }
        const float* src = row < XROWS ? a.x + (size_t)row * D : a.meta + (size_t)(row - MROW0) * D;
        float ss = 0.f;
        for (int j = 0; j < 4; ++j) { const f32x4 v = *(const f32x4*)(src + 256 * j + 4 * lane); ss += v[0] * v[0] + v[1] * v[1] + v[2] * v[2] + v[3] * v[3];
            *(uint2*)(o + 256 * j + 4 * lane) = make_uint2(pk2(v[0], v[1]), pk2(v[2], v[3])); }
        ss = wave_sum(ss);
        if (lane == 0) RS0[row] = rsqrtf(ss * (1.f / D) + EPS);
    }
}

template <class BRow, class AOff, class Epi>
__device__ __forceinline__ void naive_gemm(const bf16_t* A, int lda, const bf16_t* Bt, int K, int nrows, int nunits, BRow brow, AOff aoff, Epi epi, long gtid, long gsz) {
    const int rblks = (nrows + 63) / 64;
    const long nwaves = (long)rblks * nunits;
    const int lane = (int)(gtid & 63);
    for (long w = gtid >> 6; w < nwaves; w += gsz >> 6) {
        const int unit = __builtin_amdgcn_readfirstlane((int)(w / rblks));
        const int row = (int)(w % rblks) * 64 + lane;
        const int rr = row < nrows ? row : nrows - 1;
        const bf16_t* arow = A + (size_t)rr * lda + aoff(unit);
        float acc[64];
#pragma unroll
        for (int c = 0; c < 64; ++c) acc[c] = 0.f;
        for (int k = 0; k < K; k += 8) {
            const u32x4 av = *(const u32x4*)(arow + k);
            const float a0 = bflo(av[0]), a1 = bfhi(av[0]), a2 = bflo(av[1]), a3 = bfhi(av[1]), a4 = bflo(av[2]), a5 = bfhi(av[2]), a6 = bflo(av[3]), a7 = bfhi(av[3]);
#pragma unroll
            for (int c = 0; c < 64; ++c) {
                const u32x4 bv = *(const u32x4*)(Bt + (size_t)brow(unit, c) * K + k);
                acc[c] += a0 * bflo(bv[0]) + a1 * bfhi(bv[0]) + a2 * bflo(bv[1]) + a3 * bfhi(bv[1]) + a4 * bflo(bv[2]) + a5 * bfhi(bv[2]) + a6 * bflo(bv[3]) + a7 * bfhi(bv[3]);
            }
        }
        if (row < nrows) epi(row, unit, acc);
    }
}

__device__ __forceinline__ void p1_gemm_in(const Args& a, long gtid, long gsz) {
    unsigned char* ws = a.ws;
    const bf16_t* XB = (const bf16_t*)(ws + WS_XB); const bf16_t* WinT = (const bf16_t*)(ws + WS_WIN); const float* RS0 = (const float*)(ws + WS_RS0);
    bf16_t* P1 = (bf16_t*)(ws + WS_P1);
    const float* qg = a.qg; const float* kg = a.kg;
    naive_gemm(XB, D, WinT, D, NROWS, 48,
        [](int u, int c) { return win_btrow(u, c); }, [](int) { return 0; },
        [=](int row, int u, float (&acc)[64]) {
            const float s = RS0[row];
            bf16_t* o = P1 + (size_t)row * P1W;
            if (u < 16) {
                float ss = 0.f;
#pragma unroll
                for (int c = 0; c < 64; ++c) { acc[c] *= s; ss += acc[c] * acc[c]; }
                const float r = rsqrtf(ss * (1.f / 64.f) + EPS) * (u < 8 ? 0.125f * LOG2E : 1.f);
                const float* g = u < 8 ? qg : kg;
#pragma unroll
                for (int c = 0; c < 64; ++c) o[u * 64 + c] = f2bf(acc[c] * r * g[c]);
            } else if (u < 32) {
#pragma unroll
                for (int c = 0; c < 64; ++c) o[u * 64 + c] = f2bf(acc[c] * s);
            } else {
                const int c32 = u - 32;
#pragma unroll
                for (int c = 0; c < 32; ++c) o[2048 + 32 * c32 + c] = f2bf((acc[c] * s) * (acc[32 + c] * s));
            }
        }, gtid, gsz);
}

__device__ __forceinline__ void p2_attn_conv(const Args& a, bf16_t* MIX, long gtid, long gsz) {
    const bf16_t* P1 = (const bf16_t*)(a.ws + WS_P1);
    for (long it = gtid; it < (long)NROWS * 8; it += gsz) {
        const int row = (int)(it % NROWS), h = (int)(it / NROWS);
        int b, p; rowpos(row, b, p);
        float q[64], o[64];
        const bf16_t* qp = P1 + (size_t)row * P1W + h * 64;
#pragma unroll
        for (int c = 0; c < 64; ++c) { q[c] = bf2f(qp[c]); o[c] = 0.f; }
        float carry = 0.f;
        for (int s = p - 1; s >= 0; --s) {
            const bf16_t* kp = P1 + (size_t)prow(b, s) * P1W + 512 + h * 64;
            float z = 0.f;
#pragma unroll
            for (int c = 0; c < 64; ++c) z += q[c] * bf2f(kp[c]);
            const float L = z > 0.f ? z + log2f(1.f + exp2f(-z)) : log2f(1.f + exp2f(z));
            const float w = exp2f(z - L + carry);
            const bf16_t* vp = kp + 512;
#pragma unroll
            for (int c = 0; c < 64; ++c) o[c] += w * bf2f(vp[c]);
            carry -= L;
            if (carry < CARRY2_STOP) break;
        }
        bf16_t* op = MIX + (size_t)row * D + h * 64;
#pragma unroll
        for (int c = 0; c < 64; ++c) op[c] = f2bf(o[c]);
    }
    for (long it = gtid; it < (long)NROWS * 512; it += gsz) {
        const int c = (int)(it & 511), row = (int)(it >> 9);
        int b, p; rowpos(row, b, p);
        float y = a.conv_w[2 * 512 + c] * bf2f(P1[(size_t)row * P1W + 2048 + c]);
        if (p >= 1) y += a.conv_w[1 * 512 + c] * bf2f(P1[(size_t)prow(b, p - 1) * P1W + 2048 + c]);
        if (p >= 2) y += a.conv_w[0 * 512 + c] * bf2f(P1[(size_t)prow(b, p - 2) * P1W + 2048 + c]);
        MIX[(size_t)row * D + 512 + c] = f2bf(y * bf2f(P1[(size_t)row * P1W + 1536 + c]));
    }
}

__device__ __forceinline__ void p3_gemm_out(const Args& a, const bf16_t* MIX, long gtid, long gsz) {
    const bf16_t* WoutT = (const bf16_t*)(a.ws + WS_WOUT); bf16_t* H1 = (bf16_t*)(a.ws + WS_H1); float* SSQ1 = (float*)(a.ws + WS_SSQ1);
    const float* x = a.x; const float* meta = a.meta;
    naive_gemm(MIX, D, WoutT, D, NROWS, 16,
        [](int u, int c) { return u * 64 + c; }, [](int) { return 0; },
        [=](int row, int u, float (&acc)[64]) {
            const float* h0 = (row < XROWS ? x + (size_t)row * D : meta + (size_t)(row - MROW0) * D) + u * 64;
            float ss = 0.f;
#pragma unroll
            for (int c = 0; c < 64; ++c) { const bf16_t hb = f2bf(h0[c] + acc[c]); const float hv = bf2f(hb); ss += hv * hv; H1[(size_t)row * D + u * 64 + c] = hb; }
            SSQ1[(size_t)row * 16 + u] = ss;
        }, gtid, gsz);
}

__device__ __forceinline__ void p4_gemm_q(const Args& a, int layer, const bf16_t* H, int nrows, long gtid, long gsz) {
    const bf16_t* WqT = (const bf16_t*)(a.ws + WS_WQ) + (size_t)layer * 2048 * D; bf16_t* QP = (bf16_t*)(a.ws + WS_P1);
    naive_gemm(H, D, WqT, D, nrows, 32,
        [](int u, int c) { return u * 64 + c; }, [](int) { return 0; },
        [=](int row, int u, float (&acc)[64]) {
#pragma unroll
            for (int c = 0; c < 64; ++c) QP[(size_t)row * 2048 + u * 64 + c] = f2bf(acc[c]);
        }, gtid, gsz);
}

__device__ __forceinline__ void ins16(float (&tv)[16], int (&ti)[16], float v, int i) {
#pragma unroll
    for (int j = 0; j < 16; ++j) { const bool sw = v > tv[j]; const float ov = tv[j]; const int oi = ti[j]; tv[j] = sw ? v : ov; ti[j] = sw ? i : oi; v = sw ? ov : v; i = sw ? oi : i; }
}
__device__ __forceinline__ void p5_topk(const Args& a, int layer, const float* SSQ, int nrows, long gtid, long gsz) {
    const bf16_t* QP = (const bf16_t*)(a.ws + WS_P1); const bf16_t* KeysB = (const bf16_t*)(a.ws + WS_KEYS) + (size_t)layer * 2 * 8 * 128 * 128;
    int* IDX = (int*)(a.ws + WS_IDX); float* GATE = (float*)(a.ws + WS_GATE);
    for (long it = gtid; it < (long)nrows * 8; it += gsz) {
        const int row = (int)(it % nrows), h = (int)(it / nrows);
        float sv[2][16]; int si[2][16];
#pragma unroll
        for (int p = 0; p < 2; ++p) {
#pragma unroll
            for (int j = 0; j < 16; ++j) { sv[p][j] = -INFINITY; si[p][j] = 0; }
            const bf16_t* qp = QP + (size_t)row * 2048 + h * 256 + p * 128;
            const bf16_t* kb = KeysB + ((size_t)(p * 8 + h) * 128) * 128;
            for (int k = 0; k < 128; ++k) {
                float s = 0.f;
                for (int c = 0; c < 128; c += 8) {
                    const u32x4 qv = *(const u32x4*)(qp + c), kv = *(const u32x4*)(kb + (size_t)k * 128 + c);
                    s += bflo(qv[0]) * bflo(kv[0]) + bfhi(qv[0]) * bfhi(kv[0]) + bflo(qv[1]) * bflo(kv[1]) + bfhi(qv[1]) * bfhi(kv[1])
                       + bflo(qv[2]) * bflo(kv[2]) + bfhi(qv[2]) * bfhi(kv[2]) + bflo(qv[3]) * bflo(kv[3]) + bfhi(qv[3]) * bfhi(kv[3]);
                }
                ins16(sv[p], si[p], s, k);
            }
        }
        float tv[16]; int ti[16];
#pragma unroll
        for (int j = 0; j < 16; ++j) { tv[j] = -INFINITY; ti[j] = 0; }
#pragma unroll
        for (int i = 0; i < 16; ++i)
#pragma unroll
            for (int j = 0; j < 16; ++j) ins16(tv, ti, sv[0][i] + sv[1][j], si[0][i] * 128 + si[1][j]);
        float ssq = 0.f;
        for (int j = 0; j < 16; ++j) ssq += SSQ[(size_t)row * 16 + j];
        const float rstd = rsqrtf(ssq * (1.f / D) + EPS);
        float e[16], sum = 0.f;
#pragma unroll
        for (int j = 0; j < 16; ++j) { e[j] = __expf((tv[j] - tv[0]) * rstd); sum += e[j]; }
        const float inv = 1.f / sum;
#pragma unroll
        for (int j = 0; j < 16; ++j) { IDX[(size_t)row * 128 + h * 16 + j] = ti[j]; GATE[(size_t)row * 128 + h * 16 + j] = e[j] * inv; }
    }
}

template <bool FINAL>
__device__ __forceinline__ void p6_peer(const Args& a, int layer, const bf16_t* H, const float* SSQ, bf16_t* Hout, float* RSout, int nrows, long gtid, long gsz) {
    const bf16_t* UB = (const bf16_t*)(a.ws + WS_UB) + (size_t)layer * NEXP * D; const bf16_t* VB = (const bf16_t*)(a.ws + WS_VB) + (size_t)layer * NEXP * D;
    const int* IDX = (const int*)(a.ws + WS_IDX); const float* GATE = (const float*)(a.ws + WS_GATE);
    const int lane = (int)(gtid & 63);
    for (long row = gtid >> 6; row < nrows; row += gsz >> 6) {
        const bf16_t* hp = H + (size_t)row * D;
        const u32x4 h0 = *(const u32x4*)(hp + lane * 8), h1 = *(const u32x4*)(hp + 512 + lane * 8);
        float hv[16];
#pragma unroll
        for (int j = 0; j < 4; ++j) { hv[2 * j] = bflo(h0[j]); hv[2 * j + 1] = bfhi(h0[j]); hv[8 + 2 * j] = bflo(h1[j]); hv[9 + 2 * j] = bfhi(h1[j]); }
        float ssq = 0.f;
        for (int j = 0; j < 16; ++j) ssq += SSQ[(size_t)row * 16 + j];
        const float rstd = rsqrtf(ssq * (1.f / D) + EPS);
        float y[16];
#pragma unroll
        for (int j = 0; j < 16; ++j) y[j] = 0.f;
        for (int n = 0; n < 128; ++n) {
            const int e = IDX[(size_t)row * 128 + n]; const float g = GATE[(size_t)row * 128 + n];
            const bf16_t* up = UB + (size_t)e * D; const bf16_t* vp = VB + (size_t)e * D;
            const u32x4 u0 = *(const u32x4*)(up + lane * 8), u1 = *(const u32x4*)(up + 512 + lane * 8);
            float dsum = 0.f;
#pragma unroll
            for (int j = 0; j < 4; ++j) dsum += hv[2 * j] * bflo(u0[j]) + hv[2 * j + 1] * bfhi(u0[j]) + hv[8 + 2 * j] * bflo(u1[j]) + hv[9 + 2 * j] * bfhi(u1[j]);
            dsum = wave_sum(dsum);
            const float c = g * gelu_tanh(dsum * rstd);
            const u32x4 v0 = *(const u32x4*)(vp + lane * 8), v1 = *(const u32x4*)(vp + 512 + lane * 8);
#pragma unroll
            for (int j = 0; j < 4; ++j) { y[2 * j] += c * bflo(v0[j]); y[2 * j + 1] += c * bfhi(v0[j]); y[8 + 2 * j] += c * bflo(v1[j]); y[9 + 2 * j] += c * bfhi(v1[j]); }
        }
#pragma unroll
        for (int j = 0; j < 16; ++j) y[j] += hv[j];
        if (FINAL) {
            float* o = a.out + (size_t)row * D;
            *(f32x4*)(o + lane * 8) = (f32x4){y[0], y[1], y[2], y[3]}; *(f32x4*)(o + lane * 8 + 4) = (f32x4){y[4], y[5], y[6], y[7]};
            *(f32x4*)(o + 512 + lane * 8) = (f32x4){y[8], y[9], y[10], y[11]}; *(f32x4*)(o + 512 + lane * 8 + 4) = (f32x4){y[12], y[13], y[14], y[15]};
        } else {
            u32x4 w0, w1; float ss = 0.f;
#pragma unroll
            for (int j = 0; j < 4; ++j) { w0[j] = pk2(y[2 * j], y[2 * j + 1]); w1[j] = pk2(y[8 + 2 * j], y[9 + 2 * j]); }
#pragma unroll
            for (int j = 0; j < 4; ++j) { const float a0 = bflo(w0[j]), a1 = bfhi(w0[j]), b0 = bflo(w1[j]), b1 = bfhi(w1[j]); ss += a0 * a0 + a1 * a1 + b0 * b0 + b1 * b1; }
            ss = wave_sum(ss);
            *(u32x4*)(Hout + (size_t)row * D + lane * 8) = w0; *(u32x4*)(Hout + (size_t)row * D + 512 + lane * 8) = w1;
            if (lane == 0) RSout[row] = rsqrtf(ss * (1.f / D) + EPS);
        }
    }
}

__device__ __forceinline__ void p7_poold(const Args& a, bf16_t* Dm, long gtid, long gsz) {
    const bf16_t* H2 = (const bf16_t*)(a.ws + WS_XB); const float* RS2 = (const float*)(a.ws + WS_RS2);
    for (long it = gtid; it < (long)XROWS * D; it += gsz) {
        const int c = (int)(it & (D - 1)), row = (int)(it >> 10);
        int b, p; rowpos(row, b, p);
        const int w = 2 << (c >> 8);
        const int lo = p - w + 1 > 0 ? p - w + 1 : 0;
        float s = 0.f, self = 0.f;
        for (int j = lo; j <= p; ++j) { const int r = prow(b, j); const float v = bf2f(H2[(size_t)r * D + c]) * RS2[r]; s += v; self = v; }
        Dm[(size_t)row * D + c] = f2bf(s / (float)(p - lo + 1) - self);
    }
}

__device__ __forceinline__ void p8_gemm_pool(const Args& a, const bf16_t* Dm, long gtid, long gsz) {
    const bf16_t* PoolT = (const bf16_t*)(a.ws + WS_POOL); const bf16_t* H2 = (const bf16_t*)(a.ws + WS_XB); bf16_t* H3 = (bf16_t*)(a.ws + WS_H1); float* SSQ3 = (float*)(a.ws + WS_SSQ3);
    naive_gemm(Dm, D, PoolT, 256, XROWS, 16,
        [](int u, int c) { return u * 64 + c; }, [](int u) { return (u >> 2) * 256; },
        [=](int row, int u, float (&acc)[64]) {
            float ss = 0.f;
#pragma unroll
            for (int c = 0; c < 64; ++c) { const bf16_t hb = f2bf(bf2f(H2[(size_t)row * D + u * 64 + c]) + acc[c]); const float hv = bf2f(hb); ss += hv * hv; H3[(size_t)row * D + u * 64 + c] = hb; }
            SSQ3[(size_t)row * 16 + u] = ss;
        }, gtid, gsz);
}

constexpr int NPHASE = 12;
__global__ void __launch_bounds__(256) mega(Args a) {
    const long gtid = (long)blockIdx.x * blockDim.x + threadIdx.x, gsz = (long)gridDim.x * blockDim.x;
    bf16_t* MIX = (bf16_t*)a.out;
    for (int ph = a.ph_lo; ph < a.ph_hi; ++ph) {
        switch (ph) {
        case 0: p0_prep(a, gtid, gsz); break;
        case 1: p1_gemm_in(a, gtid, gsz); break;
        case 2: p2_attn_conv(a, MIX, gtid, gsz); break;
        case 3: p3_gemm_out(a, MIX, gtid, gsz); break;
        case 4: p4_gemm_q(a, 0, (const bf16_t*)(a.ws + WS_H1), NROWS, gtid, gsz); break;
        case 5: p5_topk(a, 0, (const float*)(a.ws + WS_SSQ1), NROWS, gtid, gsz); break;
        case 6: p6_peer<false>(a, 0, (const bf16_t*)(a.ws + WS_H1), (const float*)(a.ws + WS_SSQ1), (bf16_t*)(a.ws + WS_XB), (float*)(a.ws + WS_RS2), NROWS, gtid, gsz); break;
        case 7: p7_poold(a, MIX, gtid, gsz); break;
        case 8: p8_gemm_pool(a, MIX, gtid, gsz); break;
        case 9: p4_gemm_q(a, 1, (const bf16_t*)(a.ws + WS_H1), XROWS, gtid, gsz); break;
        case 10: p5_topk(a, 1, (const float*)(a.ws + WS_SSQ3), XROWS, gtid, gsz); break;
        case 11: p6_peer<true>(a, 1, (const bf16_t*)(a.ws + WS_H1), (const float*)(a.ws + WS_SSQ3), nullptr, nullptr, XROWS, gtid, gsz); break;
        }
    }
}

extern "C" void kernel_launch(void* const* d_in, const int* in_sizes, int n_in, void* d_out, int out_size, void* d_ws, size_t ws_size, hipStream_t stream) {
    if (n_in != 16 || ws_size < WS_END) { fprintf(stderr, "kernel_launch: unexpected n_in %d / ws %zu\n", n_in, ws_size); return; }
    Args a{};
    a.x = (const float*)d_in[0]; a.meta = (const float*)d_in[1]; a.even_g = (const float*)d_in[2]; a.w_in = (const float*)d_in[3]; a.qg = (const float*)d_in[4]; a.kg = (const float*)d_in[5];
    a.conv_w = (const float*)d_in[6]; a.w_out = (const float*)d_in[7]; a.odd_g = (const float*)d_in[8]; a.pool_w = (const float*)d_in[9]; a.pool_scale = (const float*)d_in[10];
    a.ffn_g = (const float*)d_in[11]; a.w_query = (const float*)d_in[12]; a.sub_keys = (const float*)d_in[13]; a.peer_u = (const float*)d_in[14]; a.peer_v = (const float*)d_in[15];
    a.out = (float*)d_out; a.ws = (unsigned char*)d_ws;
    for (int ph = 0; ph < NPHASE; ++ph) {
        a.ph_lo = ph; a.ph_hi = ph + 1;
        hipLaunchKernelGGL(mega, dim3(1024), dim3(256), 0, stream, a);
    }
}
```

```cpp
#include <hip/hip_runtime.h>
#include <hip/hip_cooperative_groups.h>
#include <stdint.h>
#include <stdio.h>
namespace cg = cooperative_groups;

typedef unsigned short bf16_t;
typedef unsigned u32x4 __attribute__((ext_vector_type(4)));
typedef float f32x4 __attribute__((ext_vector_type(4)));
typedef unsigned u32x3 __attribute__((ext_vector_type(3)));
typedef unsigned u32x2 __attribute__((ext_vector_type(2)));
typedef float f32x16 __attribute__((ext_vector_type(16)));
typedef unsigned u32x6 __attribute__((ext_vector_type(6)));
typedef float f32x32 __attribute__((ext_vector_type(32)));

constexpr int D = 1024, NB = 2, SEQ = 16384, NMETA = 16;
constexpr int XROWS = NB * SEQ;
constexpr int MROW0 = XROWS;
constexpr int NROWS = XROWS + NMETA;
constexpr int RP = 33024;
constexpr int NPOS = SEQ + NMETA;
constexpr int INC = 3072;
constexpr int P1W = 2560;
constexpr int NEXP = 16384;
constexpr float EPS = 1e-6f;
constexpr float LOG2E = 1.4426950408889634f;
constexpr float CARRY2_STOP = -150.5f;
#ifndef TAB_U4
#define TAB_U4 0
#endif
#ifndef TAB_V4
#define TAB_V4 1
#endif
#ifndef TAB_U8
#define TAB_U8 2
#endif
constexpr bool U4 = TAB_U4 != 0, V4 = TAB_V4 != 0;
constexpr bool U8 = TAB_U8 != 0;
#ifndef TAB_VMF
#define TAB_VMF 1
#endif
constexpr bool VMF = TAB_VMF != 0;
constexpr bool UI4 = TAB_U8 == 2;
constexpr int USTRIDE = UI4 ? 512 : U8 ? 1024 : U4 ? 512 : 768, VSTRIDE = V4 ? 512 : 768;
#ifndef TAB_CQ
#define TAB_CQ 1
#endif
constexpr bool CQ = TAB_CQ != 0;
static_assert(!CQ || !U4, "column-quarter u table is fp6 only");

constexpr size_t MiB = 1u << 20;
constexpr size_t WS_CTL = 0;
constexpr size_t WS_WIN = 1 * MiB;
constexpr size_t WS_WOUT = 7 * MiB;
constexpr size_t WS_WQ = 9 * MiB;
constexpr size_t WS_KEYS = 17 * MiB;
constexpr size_t WS_POOL = 18 * MiB;
constexpr size_t WS_RS0 = 19 * MiB;
constexpr size_t WS_SSQ1 = 20 * MiB;
constexpr size_t WS_RS2 = 23 * MiB;
constexpr size_t WS_SSQ3 = 24 * MiB;
constexpr size_t WS_UB = 32 * MiB;
constexpr size_t WS_VB = 96 * MiB;
constexpr size_t WS_XB = 160 * MiB;
constexpr size_t WS_H1 = 225 * MiB;
constexpr size_t WS_P1 = 290 * MiB;
constexpr size_t WS_IDX = 452 * MiB;
constexpr size_t WS_GATE = 469 * MiB;
constexpr size_t WS_END = 486 * MiB;

#define LAS __attribute__((address_space(3)))
#define MKRSRC(p, bytes) __builtin_amdgcn_make_buffer_rsrc((void*)(p), 0, (int)(bytes), 0x00020000)
__device__ __forceinline__ float bf2f(bf16_t v) { return __uint_as_float(((unsigned)v) << 16); }
__device__ __forceinline__ float bflo(unsigned w) { return __uint_as_float(w << 16); }
__device__ __forceinline__ float bfhi(unsigned w) { return __uint_as_float(w & 0xffff0000u); }
__device__ __forceinline__ bf16_t f2bf(float f) { unsigned u = __float_as_uint(f); return (bf16_t)((u + 0x7fffu + ((u >> 16) & 1u)) >> 16); }
__device__ __forceinline__ unsigned pk2(float lo, float hi) { unsigned r; asm("v_cvt_pk_bf16_f32 %0, %1, %2" : "=v"(r) : "v"(lo), "v"(hi)); return r; }
__device__ __forceinline__ float wave_sum(float v) {
#pragma unroll
    for (int o = 1; o < 64; o <<= 1) v += __shfl_xor(v, o);
    return v;
}
__device__ __forceinline__ int opaque_tid() { int t = (int)threadIdx.x; asm volatile("" : "+v"(t)); return t; }

__device__ __forceinline__ float dpp_xor1(float v) { return __builtin_bit_cast(float, __builtin_amdgcn_update_dpp(0, __builtin_bit_cast(int, v), 0xB1, 0xF, 0xF, true)); }
__device__ __forceinline__ float dpp_xor2(float v) { return __builtin_bit_cast(float, __builtin_amdgcn_update_dpp(0, __builtin_bit_cast(int, v), 0x4E, 0xF, 0xF, true)); }
__device__ __forceinline__ float dpp_xor8(float v) { return __builtin_bit_cast(float, __builtin_amdgcn_update_dpp(0, __builtin_bit_cast(int, v), 0x128, 0xF, 0xF, true)); }
__device__ __forceinline__ int prow(int b, int p) { return p < NMETA ? MROW0 + p : b * SEQ + (p - NMETA); }
__device__ __forceinline__ void rowpos(int row, int& b, int& p) { if (row >= MROW0) { b = 0; p = row - MROW0; } else { b = row >> 14; p = (row & (SEQ - 1)) + NMETA; } }
__host__ __device__ __forceinline__ int win_btrow(int u64, int d) { return 256 * (u64 >> 2) + 128 * (d >> 5) + 32 * (u64 & 3) + (d & 31); }
__host__ __device__ __forceinline__ int win_srccol(int u64, int d) {
    if (u64 < 24) return 64 * u64 + d;
    if (u64 < 32) return 1536 + 64 * (u64 - 24) + d;
    const int c32 = u64 - 32;
    return d < 32 ? 2048 + 32 * c32 + d : 2560 + 32 * c32 + (d - 32);
}
__device__ __forceinline__ float gelu_tanh(float x) {
    const float y = 0.7978845608028654f * (x + 0.044715f * x * x * x);
    const float e = __expf(2.f * y);
    const float t = 1.f - 2.f / (1.f + e);
    return 0.5f * x * (1.f + t);
}

struct Args {
    const float* x; const float* meta; const float* even_g; const float* w_in; const float* qg; const float* kg; const float* conv_w; const float* w_out;
    const float* odd_g; const float* pool_w; const float* pool_scale; const float* ffn_g; const float* w_query; const float* sub_keys; const float* peer_u; const float* peer_v;
    float* out; unsigned char* ws; int ph_lo, ph_hi;
};

__device__ __forceinline__ void p0_prep(const Args& a, long gtid, long gsz) {
    unsigned char* ws = a.ws;
    bf16_t* WinT = (bf16_t*)(ws + WS_WIN); bf16_t* WoutT = (bf16_t*)(ws + WS_WOUT); bf16_t* WqT = (bf16_t*)(ws + WS_WQ);
    bf16_t* KeysB = (bf16_t*)(ws + WS_KEYS); bf16_t* PoolT = (bf16_t*)(ws + WS_POOL);
    bf16_t* UB = (bf16_t*)(ws + WS_UB); bf16_t* VB = (bf16_t*)(ws + WS_VB); bf16_t* XB = (bf16_t*)(ws + WS_XB); float* RS0 = (float*)(ws + WS_RS0);
    for (long i = gtid; i < (long)INC * D; i += gsz) {
        const int k = (int)(i % D), l = (int)(i / D), u64 = l >> 6, d = l & 63;
        WinT[(size_t)win_btrow(u64, d) * D + k] = f2bf(a.w_in[(size_t)k * INC + win_srccol(u64, d)] * a.even_g[k]);
    }
    for (long i = gtid; i < (long)D * D; i += gsz) { const int k = (int)(i % D), n = (int)(i / D); WoutT[(size_t)n * D + k] = f2bf(a.w_out[(size_t)k * D + n]); }
    for (long i = gtid; i < 2L * 2048 * D; i += gsz) {
        const int k = (int)(i % D); const long r = i / D; const int n = (int)(r % 2048), l = (int)(r / 2048);
        WqT[((size_t)l * 2048 + n) * D + k] = f2bf(a.w_query[((size_t)l * D + k) * 2048 + n] * a.ffn_g[l * D + k]);
    }
    for (long i = gtid; i < 2L * 2 * 8 * 128 * 128; i += gsz) KeysB[i] = f2bf(a.sub_keys[i]);
    for (long i = gtid; i < 1024L * 256; i += gsz) {
        const int c = (int)(i % 256), n = (int)(i / 256), g = n >> 8, e = n & 255;
        PoolT[(size_t)n * 256 + c] = f2bf(a.pool_w[((size_t)g * 256 + c) * 256 + e] * a.odd_g[g * 256 + c] * a.pool_scale[n]);
    }
    for (long i = gtid; i < 2L * NEXP * D / 4; i += gsz) {
        const long e4 = i * 4; const int l = (int)(e4 / ((long)NEXP * D)), dcol = (int)(e4 % D);
        const f32x4 u = *(const f32x4*)(a.peer_u + e4), v = *(const f32x4*)(a.peer_v + e4), g = *(const f32x4*)(a.ffn_g + l * D + dcol);
        *(uint2*)(UB + e4) = make_uint2(pk2(u[0] * g[0], u[1] * g[1]), pk2(u[2] * g[2], u[3] * g[3]));
        *(uint2*)(VB + e4) = make_uint2(pk2(v[0], v[1]), pk2(v[2], v[3]));
    }
    const long gw = gtid >> 6, nw = gsz >> 6; const int lane = (int)(gtid & 63);
    for (long row = gw; row < RP; row += nw) {
        bf16_t* o = XB + (size_t)row * D;
        if (row >= NROWS) { for (int j = 0; j < 4; ++j) *(uint2*)(o + 256 * j + 4 * lane) = make_uint2(0u, 0u); if (lane == 0) RS0[row] = 1.f; continue; }
        const float* src = row < XROWS ? a.x + (size_t)row * D : a.meta + (size_t)(row - MROW0) * D;
        float ss = 0.f;
        for (int j = 0; j < 4; ++j) { const f32x4 v = *(const f32x4*)(src + 256 * j + 4 * lane); ss += v[0] * v[0] + v[1] * v[1] + v[2] * v[2] + v[3] * v[3];
            *(uint2*)(o + 256 * j + 4 * lane) = make_uint2(pk2(v[0], v[1]), pk2(v[2], v[3])); }
        ss = wave_sum(ss);
        if (lane == 0) RS0[row] = rsqrtf(ss * (1.f / D) + EPS);
    }
}

template <class BRow, class AOff, class Epi>
__device__ __forceinline__ void naive_gemm(const bf16_t* A, int lda, const bf16_t* Bt, int K, int nrows, int nunits, BRow brow, AOff aoff, Epi epi, long gtid, long gsz) {
    const int rblks = (nrows + 63) / 64;
    const long nwaves = (long)rblks * nunits;
    const int lane = (int)(gtid & 63);
    for (long w = gtid >> 6; w < nwaves; w += gsz >> 6) {
        const int unit = __builtin_amdgcn_readfirstlane((int)(w / rblks));
        const int row = (int)(w % rblks) * 64 + lane;
        const int rr = row < nrows ? row : nrows - 1;
        const bf16_t* arow = A + (size_t)rr * lda + aoff(unit);
        float acc[64];
#pragma unroll
        for (int c = 0; c < 64; ++c) acc[c] = 0.f;
        for (int k = 0; k < K; k += 8) {
            const u32x4 av = *(const u32x4*)(arow + k);
            const float a0 = bflo(av[0]), a1 = bfhi(av[0]), a2 = bflo(av[1]), a3 = bfhi(av[1]), a4 = bflo(av[2]), a5 = bfhi(av[2]), a6 = bflo(av[3]), a7 = bfhi(av[3]);
#pragma unroll
            for (int c = 0; c < 64; ++c) {
                const u32x4 bv = *(const u32x4*)(Bt + (size_t)brow(unit, c) * K + k);
                acc[c] += a0 * bflo(bv[0]) + a1 * bfhi(bv[0]) + a2 * bflo(bv[1]) + a3 * bfhi(bv[1]) + a4 * bflo(bv[2]) + a5 * bfhi(bv[2]) + a6 * bflo(bv[3]) + a7 * bfhi(bv[3]);
            }
        }
        if (row < nrows) epi(row, unit, acc);
    }
}

__device__ __forceinline__ void p1_gemm_in(const Args& a, long gtid, long gsz) {
    unsigned char* ws = a.ws;
    const bf16_t* XB = (const bf16_t*)(ws + WS_XB); const bf16_t* WinT = (const bf16_t*)(ws + WS_WIN); const float* RS0 = (const float*)(ws + WS_RS0);
    bf16_t* P1 = (bf16_t*)(ws + WS_P1);
    const float* qg = a.qg; const float* kg = a.kg;
    naive_gemm(XB, D, WinT, D, NROWS, 48,
        [](int u, int c) { return win_btrow(u, c); }, [](int) { return 0; },
        [=](int row, int u, float (&acc)[64]) {
            const float s = RS0[row];
            bf16_t* o = P1 + (size_t)row * P1W;
            if (u < 16) {
                float ss = 0.f;
#pragma unroll
                for (int c = 0; c < 64; ++c) { acc[c] *= s; ss += acc[c] * acc[c]; }
                const float r = rsqrtf(ss * (1.f / 64.f) + EPS) * (u < 8 ? 0.125f * LOG2E : 1.f);
                const float* g = u < 8 ? qg : kg;
#pragma unroll
                for (int c = 0; c < 64; ++c) o[u * 64 + c] = f2bf(acc[c] * r * g[c]);
            } else if (u < 32) {
#pragma unroll
                for (int c = 0; c < 64; ++c) o[u * 64 + c] = f2bf(acc[c] * s);
            } else {
                const int c32 = u - 32;
#pragma unroll
                for (int c = 0; c < 32; ++c) o[2048 + 32 * c32 + c] = f2bf((acc[c] * s) * (acc[32 + c] * s));
            }
        }, gtid, gsz);
}

__device__ __forceinline__ void p2_attn_conv(const Args& a, bf16_t* MIX, long gtid, long gsz) {
    const bf16_t* P1 = (const bf16_t*)(a.ws + WS_P1);
    for (long it = gtid; it < (long)NROWS * 8; it += gsz) {
        const int row = (int)(it % NROWS), h = (int)(it / NROWS);
        int b, p; rowpos(row, b, p);
        float q[64], o[64];
        const bf16_t* qp = P1 + (size_t)row * P1W + h * 64;
#pragma unroll
        for (int c = 0; c < 64; ++c) { q[c] = bf2f(qp[c]); o[c] = 0.f; }
        float carry = 0.f;
        for (int s = p - 1; s >= 0; --s) {
            const bf16_t* kp = P1 + (size_t)prow(b, s) * P1W + 512 + h * 64;
            float z = 0.f;
#pragma unroll
            for (int c = 0; c < 64; ++c) z += q[c] * bf2f(kp[c]);
            const float L = z > 0.f ? z + log2f(1.f + exp2f(-z)) : log2f(1.f + exp2f(z));
            const float w = exp2f(z - L + carry);
            const bf16_t* vp = kp + 512;
#pragma unroll
            for (int c = 0; c < 64; ++c) o[c] += w * bf2f(vp[c]);
            carry -= L;
            if (carry < CARRY2_STOP) break;
        }
        bf16_t* op = MIX + (size_t)row * D + h * 64;
#pragma unroll
        for (int c = 0; c < 64; ++c) op[c] = f2bf(o[c]);
    }
    for (long it = gtid; it < (long)NROWS * 512; it += gsz) {
        const int c = (int)(it & 511), row = (int)(it >> 9);
        int b, p; rowpos(row, b, p);
        float y = a.conv_w[2 * 512 + c] * bf2f(P1[(size_t)row * P1W + 2048 + c]);
        if (p >= 1) y += a.conv_w[1 * 512 + c] * bf2f(P1[(size_t)prow(b, p - 1) * P1W + 2048 + c]);
        if (p >= 2) y += a.conv_w[0 * 512 + c] * bf2f(P1[(size_t)prow(b, p - 2) * P1W + 2048 + c]);
        MIX[(size_t)row * D + 512 + c] = f2bf(y * bf2f(P1[(size_t)row * P1W + 1536 + c]));
    }
}

__device__ __forceinline__ void p3_gemm_out(const Args& a, const bf16_t* MIX, long gtid, long gsz) {
    const bf16_t* WoutT = (const bf16_t*)(a.ws + WS_WOUT); bf16_t* H1 = (bf16_t*)(a.ws + WS_H1); float* SSQ1 = (float*)(a.ws + WS_SSQ1);
    const float* x = a.x; const float* meta = a.meta;
    naive_gemm(MIX, D, WoutT, D, NROWS, 16,
        [](int u, int c) { return u * 64 + c; }, [](int) { return 0; },
        [=](int row, int u, float (&acc)[64]) {
            const float* h0 = (row < XROWS ? x + (size_t)row * D : meta + (size_t)(row - MROW0) * D) + u * 64;
            float ss = 0.f;
#pragma unroll
            for (int c = 0; c < 64; ++c) { const bf16_t hb = f2bf(h0[c] + acc[c]); const float hv = bf2f(hb); ss += hv * hv; H1[(size_t)row * D + u * 64 + c] = hb; }
            SSQ1[(size_t)row * 16 + u] = ss;
        }, gtid, gsz);
}

__device__ __forceinline__ void p4_gemm_q(const Args& a, int layer, const bf16_t* H, int nrows, long gtid, long gsz) {
    const bf16_t* WqT = (const bf16_t*)(a.ws + WS_WQ) + (size_t)layer * 2048 * D; bf16_t* QP = (bf16_t*)(a.ws + WS_P1);
    naive_gemm(H, D, WqT, D, nrows, 32,
        [](int u, int c) { return u * 64 + c; }, [](int) { return 0; },
        [=](int row, int u, float (&acc)[64]) {
#pragma unroll
            for (int c = 0; c < 64; ++c) QP[(size_t)row * 2048 + u * 64 + c] = f2bf(acc[c]);
        }, gtid, gsz);
}

__device__ __forceinline__ void ins16(float (&tv)[16], int (&ti)[16], float v, int i) {
#pragma unroll
    for (int j = 0; j < 16; ++j) { const bool sw = v > tv[j]; const float ov = tv[j]; const int oi = ti[j]; tv[j] = sw ? v : ov; ti[j] = sw ? i : oi; v = sw ? ov : v; i = sw ? oi : i; }
}
__device__ __forceinline__ void p5_topk(const Args& a, int layer, const float* SSQ, int nrows, long gtid, long gsz) {
    const bf16_t* QP = (const bf16_t*)(a.ws + WS_P1); const bf16_t* KeysB = (const bf16_t*)(a.ws + WS_KEYS) + (size_t)layer * 2 * 8 * 128 * 128;
    int* IDX = (int*)(a.ws + WS_IDX); float* GATE = (float*)(a.ws + WS_GATE);
    for (long it = gtid; it < (long)nrows * 8; it += gsz) {
        const int row = (int)(it % nrows), h = (int)(it / nrows);
        float sv[2][16]; int si[2][16];
#pragma unroll
        for (int p = 0; p < 2; ++p) {
#pragma unroll
            for (int j = 0; j < 16; ++j) { sv[p][j] = -INFINITY; si[p][j] = 0; }
            const bf16_t* qp = QP + (size_t)row * 2048 + h * 256 + p * 128;
            const bf16_t* kb = KeysB + ((size_t)(p * 8 + h) * 128) * 128;
            for (int k = 0; k < 128; ++k) {
                float s = 0.f;
                for (int c = 0; c < 128; c += 8) {
                    const u32x4 qv = *(const u32x4*)(qp + c), kv = *(const u32x4*)(kb + (size_t)k * 128 + c);
                    s += bflo(qv[0]) * bflo(kv[0]) + bfhi(qv[0]) * bfhi(kv[0]) + bflo(qv[1]) * bflo(kv[1]) + bfhi(qv[1]) * bfhi(kv[1])
                       + bflo(qv[2]) * bflo(kv[2]) + bfhi(qv[2]) * bfhi(kv[2]) + bflo(qv[3]) * bflo(kv[3]) + bfhi(qv[3]) * bfhi(kv[3]);
                }
                ins16(sv[p], si[p], s, k);
            }
        }
        float tv[16]; int ti[16];
#pragma unroll
        for (int j = 0; j < 16; ++j) { tv[j] = -INFINITY; ti[j] = 0; }
#pragma unroll
        for (int i = 0; i < 16; ++i)
#pragma unroll
            for (int j = 0; j < 16; ++j) ins16(tv, ti, sv[0][i] + sv[1][j], si[0][i] * 128 + si[1][j]);
        float ssq = 0.f;
        for (int j = 0; j < 16; ++j) ssq += SSQ[(size_t)row * 16 + j];
        const float rstd = rsqrtf(ssq * (1.f / D) + EPS);
        float e[16], sum = 0.f;
#pragma unroll
        for (int j = 0; j < 16; ++j) { e[j] = __expf((tv[j] - tv[0]) * rstd); sum += e[j]; }
        const float inv = 1.f / sum;
#pragma unroll
        for (int j = 0; j < 16; ++j) { IDX[(size_t)row * 128 + h * 16 + j] = ti[j]; GATE[(size_t)row * 128 + h * 16 + j] = e[j] * inv; }
    }
}

template <bool FINAL>
__device__ __forceinline__ void p6_peer(const Args& a, int layer, const bf16_t* H, const float* SSQ, bf16_t* Hout, float* RSout, int nrows, long gtid, long gsz) {
    const bf16_t* UB = (const bf16_t*)(a.ws + WS_UB) + (size_t)layer * NEXP * D; const bf16_t* VB = (const bf16_t*)(a.ws + WS_VB) + (size_t)layer * NEXP * D;
    const int* IDX = (const int*)(a.ws + WS_IDX); const float* GATE = (const float*)(a.ws + WS_GATE);
    const int lane = (int)(gtid & 63);
    for (long row = gtid >> 6; row < nrows; row += gsz >> 6) {
        const bf16_t* hp = H + (size_t)row * D;
        const u32x4 h0 = *(const u32x4*)(hp + lane * 8), h1 = *(const u32x4*)(hp + 512 + lane * 8);
        float hv[16];
#pragma unroll
        for (int j = 0; j < 4; ++j) { hv[2 * j] = bflo(h0[j]); hv[2 * j + 1] = bfhi(h0[j]); hv[8 + 2 * j] = bflo(h1[j]); hv[9 + 2 * j] = bfhi(h1[j]); }
        float ssq = 0.f;
        for (int j = 0; j < 16; ++j) ssq += SSQ[(size_t)row * 16 + j];
        const float rstd = rsqrtf(ssq * (1.f / D) + EPS);
        float y[16];
#pragma unroll
        for (int j = 0; j < 16; ++j) y[j] = 0.f;
        for (int n = 0; n < 128; ++n) {
            const int e = IDX[(size_t)row * 128 + n]; const float g = GATE[(size_t)row * 128 + n];
            const bf16_t* up = UB + (size_t)e * D; const bf16_t* vp = VB + (size_t)e * D;
            const u32x4 u0 = *(const u32x4*)(up + lane * 8), u1 = *(const u32x4*)(up + 512 + lane * 8);
            float dsum = 0.f;
#pragma unroll
            for (int j = 0; j < 4; ++j) dsum += hv[2 * j] * bflo(u0[j]) + hv[2 * j + 1] * bfhi(u0[j]) + hv[8 + 2 * j] * bflo(u1[j]) + hv[9 + 2 * j] * bfhi(u1[j]);
            dsum = wave_sum(dsum);
            const float c = g * gelu_tanh(dsum * rstd);
            const u32x4 v0 = *(const u32x4*)(vp + lane * 8), v1 = *(const u32x4*)(vp + 512 + lane * 8);
#pragma unroll
            for (int j = 0; j < 4; ++j) { y[2 * j] += c * bflo(v0[j]); y[2 * j + 1] += c * bfhi(v0[j]); y[8 + 2 * j] += c * bflo(v1[j]); y[9 + 2 * j] += c * bfhi(v1[j]); }
        }
#pragma unroll
        for (int j = 0; j < 16; ++j) y[j] += hv[j];
        if (FINAL) {
            float* o = a.out + (size_t)row * D;
            *(f32x4*)(o + lane * 8) = (f32x4){y[0], y[1], y[2], y[3]}; *(f32x4*)(o + lane * 8 + 4) = (f32x4){y[4], y[5], y[6], y[7]};
            *(f32x4*)(o + 512 + lane * 8) = (f32x4){y[8], y[9], y[10], y[11]}; *(f32x4*)(o + 512 + lane * 8 + 4) = (f32x4){y[12], y[13], y[14], y[15]};
        } else {
            u32x4 w0, w1; float ss = 0.f;
#pragma unroll
            for (int j = 0; j < 4; ++j) { w0[j] = pk2(y[2 * j], y[2 * j + 1]); w1[j] = pk2(y[8 + 2 * j], y[9 + 2 * j]); }
#pragma unroll
            for (int j = 0; j < 4; ++j) { const float a0 = bflo(w0[j]), a1 = bfhi(w0[j]), b0 = bflo(w1[j]), b1 = bfhi(w1[j]); ss += a0 * a0 + a1 * a1 + b0 * b0 + b1 * b1; }
            ss = wave_sum(ss);
            *(u32x4*)(Hout + (size_t)row * D + lane * 8) = w0; *(u32x4*)(Hout + (size_t)row * D + 512 + lane * 8) = w1;
            if (lane == 0) RSout[row] = rsqrtf(ss * (1.f / D) + EPS);
        }
    }
}

__device__ __forceinline__ void p7_poold(const Args& a, bf16_t* Dm, long gtid, long gsz) {
    const bf16_t* H2 = (const bf16_t*)(a.ws + WS_XB); const float* RS2 = (const float*)(a.ws + WS_RS2);
    for (long it = gtid; it < (long)XROWS * D; it += gsz) {
        const int c = (int)(it & (D - 1)), row = (int)(it >> 10);
        int b, p; rowpos(row, b, p);
        const int w = 2 << (c >> 8);
        const int lo = p - w + 1 > 0 ? p - w + 1 : 0;
        float s = 0.f, self = 0.f;
        for (int j = lo; j <= p; ++j) { const int r = prow(b, j); const float v = bf2f(H2[(size_t)r * D + c]) * RS2[r]; s += v; self = v; }
        Dm[(size_t)row * D + c] = f2bf(s / (float)(p - lo + 1) - self);
    }
}

__device__ __forceinline__ void p8_gemm_pool(const Args& a, const bf16_t* Dm, long gtid, long gsz) {
    const bf16_t* PoolT = (const bf16_t*)(a.ws + WS_POOL); const bf16_t* H2 = (const bf16_t*)(a.ws + WS_XB); bf16_t* H3 = (bf16_t*)(a.ws + WS_H1); float* SSQ3 = (float*)(a.ws + WS_SSQ3);
    naive_gemm(Dm, D, PoolT, 256, XROWS, 16,
        [](int u, int c) { return u * 64 + c; }, [](int u) { return (u >> 2) * 256; },
        [=](int row, int u, float (&acc)[64]) {
            float ss = 0.f;
#pragma unroll
            for (int c = 0; c < 64; ++c) { const bf16_t hb = f2bf(bf2f(H2[(size_t)row * D + u * 64 + c]) + acc[c]); const float hv = bf2f(hb); ss += hv * hv; H3[(size_t)row * D + u * 64 + c] = hb; }
            SSQ3[(size_t)row * 16 + u] = ss;
        }, gtid, gsz);
}


namespace pg8 {
#define PG8_LAS __attribute__((address_space(3)))
typedef unsigned short bf16_t;
typedef short bf16x8 __attribute__((ext_vector_type(8)));
typedef float f32x4 __attribute__((ext_vector_type(4)));
typedef unsigned u32x4 __attribute__((ext_vector_type(4)));
constexpr int BM = 256, BK = 64, HALF = 128, HTB = HALF * BK * 2  , STAGE_BYTES = 8 * HTB, NXCD = 8, WGM = 8;

__host__ __device__ __forceinline__ int lds_byte(int r, int c) { const int st = (r >> 4) * 2 + (c >> 5), rr = r & 15, cc = c & 31, ob = rr * 64 + cc * 2; return st * 1024 + (ob ^ (((ob >> 9) & 1) << 5)); }
__host__ __device__ __forceinline__ void stage_rc(int b, int& R, int& C) { const int st = b / 1024, sb = b % 1024, swz = sb ^ (((sb >> 9) & 1) << 5); R = (st >> 1) * 16 + swz / 64; C = (st & 1) * 32 + (swz % 64) / 2; }
__host__ __device__ __forceinline__ int perm32(int rho) { const int n = rho >> 4, i = rho & 15; return 8 * (i >> 2) + 4 * n + (i & 3); }

struct Unit { int pm, pn; };
struct Gemm { const bf16_t* A; const bf16_t* Bt; int lda, ldb, K, a_pn_off; };

struct StaticOrder {
    int nM, nN, nwg, G, c;
    __host__ __device__ void init(int M, int N, int G_, int c_) { nM = M / BM; nN = N / BM; nwg = nM * nN; G = G_; c = c_; }
    __host__ __device__ bool next(int i, Unit& u) const {
        const long L = (long)i * G + c; if (L >= nwg) return false;
        int wgid = (int)L; { const int q = nwg / NXCD, r = nwg % NXCD, xcd = wgid % NXCD, off = wgid / NXCD; wgid = (xcd < r ? xcd * (q + 1) : r * (q + 1) + (xcd - r) * q) + off; }
        const int nig = WGM * nN, gid = wgid / nig, fm = gid * WGM, gsz = (nM - fm) < WGM ? (nM - fm) : WGM;
        u.pm = fm + ((wgid % nig) % gsz); u.pn = (wgid % nig) / gsz; return true;
    }
    __device__ __forceinline__ void a_ready(const Unit&) const {}
    __device__ __forceinline__ void done(const Unit&) const {}
};


__device__ __forceinline__ unsigned cvt_pk_bf16(float lo, float hi) { unsigned r; asm volatile("v_cvt_pk_bf16_f32 %0, %1, %2" : "=v"(r) : "v"(lo), "v"(hi)); return r; }

struct EpiPlain {
    static constexpr bool PERM = true, AFTER_DRAIN = false;
    bf16_t* O; int ldc;
    __device__ __forceinline__ void operator()(const f32x4 (&acc)[2][2][4][2], const Unit& u, int wr, int wc, int fr, int fq) const {
        const int row0 = u.pm * BM + wr * 64 + fr, col0 = u.pn * BM + wc * 32 + 8 * fq;
#pragma unroll
        for (int ai = 0; ai < 2; ++ai)
#pragma unroll
            for (int m = 0; m < 4; ++m) { bf16_t* rowp = O + (size_t)(row0 + ai * HALF + m * 16) * ldc + col0;
#pragma unroll
                for (int bj = 0; bj < 2; ++bj) { const f32x4 v0 = acc[ai][bj][m][0], v1 = acc[ai][bj][m][1];
                    u32x4 w; w.x = cvt_pk_bf16(v0[0], v0[1]); w.y = cvt_pk_bf16(v0[2], v0[3]); w.z = cvt_pk_bf16(v1[0], v1[1]); w.w = cvt_pk_bf16(v1[2], v1[3]);
                    *(u32x4*)(rowp + bj * HALF) = w; } }
    }
};
struct EpiIn {
    static constexpr bool PERM = true, AFTER_DRAIN = false;
    bf16_t* P1; const float* RS0; const float* qg; const float* kg;
    __device__ __forceinline__ void operator()(const f32x4 (&acc)[2][2][4][2], const Unit& u, int wr, int wc, int fr, int fq) const {
        const int u64 = 4 * u.pn + wc;
        const int row0 = u.pm * BM + wr * 64 + fr;
        if (u64 < 16) {
            const float* g = u64 < 8 ? qg : kg; const float sc = u64 < 8 ? 0.125f * LOG2E : 1.f;
            f32x4 gv[2][2];
#pragma unroll
            for (int bj = 0; bj < 2; ++bj)
#pragma unroll
                for (int n = 0; n < 2; ++n) gv[bj][n] = *(const f32x4*)(g + 32 * bj + 8 * fq + 4 * n);
#pragma unroll
            for (int ai = 0; ai < 2; ++ai)
#pragma unroll
                for (int m = 0; m < 4; ++m) { const int row = row0 + ai * HALF + m * 16; const float s = RS0[row];
                    f32x4 v[2][2]; float ss = 0.f;
#pragma unroll
                    for (int bj = 0; bj < 2; ++bj)
#pragma unroll
                        for (int n = 0; n < 2; ++n) { v[bj][n] = acc[ai][bj][m][n] * s; ss += (v[bj][n][0] * v[bj][n][0] + v[bj][n][1] * v[bj][n][1]) + (v[bj][n][2] * v[bj][n][2] + v[bj][n][3] * v[bj][n][3]); }
                    ss += __shfl_xor(ss, 16); ss += __shfl_xor(ss, 32);
                    const float r = rsqrtf(ss * (1.f / 64.f) + EPS) * sc;
                    bf16_t* rowp = P1 + (size_t)row * P1W + u64 * 64 + 8 * fq;
#pragma unroll
                    for (int bj = 0; bj < 2; ++bj) { const f32x4 a0 = v[bj][0] * gv[bj][0] * r, a1 = v[bj][1] * gv[bj][1] * r;
                        u32x4 w; w.x = cvt_pk_bf16(a0[0], a0[1]); w.y = cvt_pk_bf16(a0[2], a0[3]); w.z = cvt_pk_bf16(a1[0], a1[1]); w.w = cvt_pk_bf16(a1[2], a1[3]);
                        *(u32x4*)(rowp + 32 * bj) = w; } }
        } else if (u64 < 32) {
#pragma unroll
            for (int ai = 0; ai < 2; ++ai)
#pragma unroll
                for (int m = 0; m < 4; ++m) { const int row = row0 + ai * HALF + m * 16; const float s = RS0[row];
                    bf16_t* rowp = P1 + (size_t)row * P1W + u64 * 64 + 8 * fq;
#pragma unroll
                    for (int bj = 0; bj < 2; ++bj) { const f32x4 a0 = acc[ai][bj][m][0] * s, a1 = acc[ai][bj][m][1] * s;
                        u32x4 w; w.x = cvt_pk_bf16(a0[0], a0[1]); w.y = cvt_pk_bf16(a0[2], a0[3]); w.z = cvt_pk_bf16(a1[0], a1[1]); w.w = cvt_pk_bf16(a1[2], a1[3]);
                        *(u32x4*)(rowp + 32 * bj) = w; } }
        } else {
            const int c32 = u64 - 32;
#pragma unroll
            for (int ai = 0; ai < 2; ++ai)
#pragma unroll
                for (int m = 0; m < 4; ++m) { const int row = row0 + ai * HALF + m * 16; const float s = RS0[row], s2 = s * s;
                    const f32x4 a0 = acc[ai][0][m][0] * acc[ai][1][m][0] * s2, a1 = acc[ai][0][m][1] * acc[ai][1][m][1] * s2;
                    u32x4 w; w.x = cvt_pk_bf16(a0[0], a0[1]); w.y = cvt_pk_bf16(a0[2], a0[3]); w.z = cvt_pk_bf16(a1[0], a1[1]); w.w = cvt_pk_bf16(a1[2], a1[3]);
                    *(u32x4*)(P1 + (size_t)row * P1W + 2048 + 32 * c32 + 8 * fq) = w; }
        }
    }
};
template <int MODE> struct EpiRes {
    static constexpr bool PERM = true, AFTER_DRAIN = false;
    const float* x; const float* meta; const bf16_t* Hb; bf16_t* Hout; float* SSQ;
    __device__ __forceinline__ void operator()(const f32x4 (&acc)[2][2][4][2], const Unit& u, int wr, int wc, int fr, int fq) const {
        const int row0 = u.pm * BM + wr * 64 + fr, col0 = u.pn * BM + wc * 32 + 8 * fq;
#pragma unroll
        for (int ai = 0; ai < 2; ++ai)
#pragma unroll
            for (int m = 0; m < 4; ++m) { const int row = row0 + ai * HALF + m * 16; float ss = 0.f;
#pragma unroll
                for (int bj = 0; bj < 2; ++bj) { const int col = col0 + bj * HALF; f32x4 b0, b1;
                    if (MODE == 0) { const float* bp = row < XROWS ? x + (size_t)row * D + col : meta + (size_t)(row < NROWS ? row - MROW0 : 0) * D + col; b0 = *(const f32x4*)bp; b1 = *(const f32x4*)(bp + 4); }
                    else { const u32x4 hb = *(const u32x4*)(Hb + (size_t)row * D + col); b0 = (f32x4){bflo(hb[0]), bfhi(hb[0]), bflo(hb[1]), bfhi(hb[1])}; b1 = (f32x4){bflo(hb[2]), bfhi(hb[2]), bflo(hb[3]), bfhi(hb[3])}; }
                    const f32x4 v0 = acc[ai][bj][m][0] + b0, v1 = acc[ai][bj][m][1] + b1;
                    u32x4 w; w.x = cvt_pk_bf16(v0[0], v0[1]); w.y = cvt_pk_bf16(v0[2], v0[3]); w.z = cvt_pk_bf16(v1[0], v1[1]); w.w = cvt_pk_bf16(v1[2], v1[3]);
#pragma unroll
                    for (int j = 0; j < 4; ++j) { const float lo = bflo(w[j]), hi = bfhi(w[j]); ss += lo * lo + hi * hi; }
                    *(u32x4*)(Hout + (size_t)row * D + col) = w; }
                ss += __shfl_xor(ss, 16); ss += __shfl_xor(ss, 32);
                if (fq == 0) SSQ[(size_t)row * 16 + 4 * u.pn + wc] = ss;
                asm volatile("" ::: "memory"); }
    }
};
template <class Epi, class Sched, bool ALIGN_EPI = false, bool SP2 = false>
__device__ __forceinline__ void gemm_phase(PG8_LAS unsigned char* lds, const Gemm g, const Sched& S, const Epi& E) {
    const int tid = opaque_tid(), wid = __builtin_amdgcn_readfirstlane(tid >> 6), lane = tid & 63, wr = wid >> 2, wc = wid & 3, fr = lane & 15, fq = lane >> 4;
    const int K = g.K, nt = K / BK;
    unsigned voffA[2], voffB[2];
#pragma unroll
    for (int i = 0; i < 2; ++i) { int R, C; stage_rc(tid * 16 + i * 8192, R, C); const int Rb = Epi::PERM ? ((R & ~31) + perm32(R & 31)) : R;
        voffA[i] = (unsigned)(R * g.lda + C) * 2u; voffB[i] = (unsigned)(Rb * g.ldb + C) * 2u; }
    const size_t kstep = (size_t)(BK * 2);
    const size_t hstepA = (size_t)HALF * g.lda * 2, hstepB = (size_t)HALF * g.ldb * 2;
    const size_t tstepA = 2 * hstepA, tstepB = 2 * hstepB;
    const size_t apn = (size_t)g.a_pn_off * 2;
    const unsigned ldsw = (unsigned)wid * 1024u;
    const int aoff = lds_byte(wr * 64 + fr, fq * 8), boff = lds_byte(wc * 32 + fr, fq * 8);
#define PG8_SA(b, h) (((b) * 2 + (h)) * HTB)
#define PG8_SB(b, h) ((4 + (b) * 2 + (h)) * HTB)
#define PG8_STAGE(bufoff, gbase, voff) do { _Pragma("unroll") for (int _i = 0; _i < 2; ++_i) \
        __builtin_amdgcn_global_load_lds((const unsigned*)((const char*)(gbase) + (voff)[_i]), (PG8_LAS unsigned*)(lds + (bufoff) + ldsw + _i * 8192), 16, 0, 0); } while (0)
#define PG8_LDA(dst, b, h) do { _Pragma("unroll") for (int m = 0; m < 4; ++m) _Pragma("unroll") for (int k = 0; k < 2; ++k) dst[m][k] = *(const PG8_LAS bf16x8*)(lds + PG8_SA(b, h) + aoff + m * 2048 + k * 1024); } while (0)
#define PG8_LDB(dst, b, h) do { _Pragma("unroll") for (int n = 0; n < 2; ++n) _Pragma("unroll") for (int k = 0; k < 2; ++k) dst[n][k] = *(const PG8_LAS bf16x8*)(lds + PG8_SB(b, h) + boff + n * 2048 + k * 1024); } while (0)
#define PG8_MMA(ai, bj, At, Bt) do { __builtin_amdgcn_s_setprio(1); _Pragma("unroll") for (int m = 0; m < 4; ++m) _Pragma("unroll") for (int n = 0; n < 2; ++n) _Pragma("unroll") for (int k = 0; k < 2; ++k) \
        acc[ai][bj][m][n] = __builtin_amdgcn_mfma_f32_16x16x32_bf16(Bt[n][k], At[m][k], acc[ai][bj][m][n], 0, 0, 0); __builtin_amdgcn_s_setprio(0); } while (0)
#define PG8_WAIT_V(n) asm volatile("s_waitcnt vmcnt(" #n ")" ::: "memory")
#define PG8_WAIT_L(n) asm volatile("s_waitcnt lgkmcnt(" #n ")" ::: "memory")
#define PG8_BAR __builtin_amdgcn_s_barrier()
#define PG8_SCHED __builtin_amdgcn_sched_barrier(0)
    Unit cur, nxt; int ui = 0;
    if (!S.next(0, cur)) return;
    f32x4 acc[2][2][4][2];
#pragma unroll
    for (int a = 0; a < 2; ++a)
#pragma unroll
        for (int b = 0; b < 2; ++b)
#pragma unroll
            for (int m = 0; m < 4; ++m)
#pragma unroll
                for (int n = 0; n < 2; ++n) acc[a][b][m][n] = (f32x4){0.f, 0.f, 0.f, 0.f};
    bf16x8 At[4][2], B0[2][2], B1[2][2];
    const char* cA = (const char*)g.A + (size_t)cur.pm * tstepA + (size_t)cur.pn * apn; const char* cB = (const char*)g.Bt + (size_t)cur.pn * tstepB;
    S.a_ready(cur);
    if constexpr (SP2) {
        PG8_STAGE(PG8_SB(0, 0), cB, voffB); PG8_STAGE(PG8_SB(0, 1), cB + hstepB, voffB); PG8_STAGE(PG8_SA(0, 0), cA, voffA); PG8_STAGE(PG8_SA(0, 1), cA + hstepA, voffA);
        if (wr == 1) PG8_BAR;
        PG8_WAIT_V(2); PG8_BAR;
        PG8_STAGE(PG8_SB(1, 0), cB + kstep, voffB); PG8_STAGE(PG8_SA(1, 0), cA + kstep, voffA); PG8_STAGE(PG8_SB(1, 1), cB + hstepB + kstep, voffB);
        PG8_WAIT_V(6); PG8_BAR;
    } else {
        PG8_STAGE(PG8_SB(0, 0), cB, voffB); PG8_STAGE(PG8_SA(0, 0), cA, voffA); PG8_STAGE(PG8_SB(0, 1), cB + hstepB, voffB); PG8_STAGE(PG8_SA(0, 1), cA + hstepA, voffA);
        if (wr == 1) PG8_BAR;
        PG8_WAIT_V(4); PG8_BAR;
        PG8_STAGE(PG8_SB(1, 0), cB + kstep, voffB); PG8_STAGE(PG8_SA(1, 0), cA + kstep, voffA); PG8_STAGE(PG8_SB(1, 1), cB + hstepB + kstep, voffB);
        PG8_WAIT_V(6); PG8_BAR;
    }
    for (;;) {
        const bool has_next = S.next(ui + 1, nxt);
        const char* nA = has_next ? (const char*)g.A + (size_t)nxt.pm * tstepA + (size_t)nxt.pn * apn : cA; const char* nB = has_next ? (const char*)g.Bt + (size_t)nxt.pn * tstepB : cB;
        for (int t = 0; t < nt; t += 2) {
            const bool last = (t == nt - 2);
            const char* a1 = cA + (size_t)(t + 1) * kstep;
            const char* a2 = last ? nA : cA + (size_t)(t + 2) * kstep; const char* b2 = last ? nB : cB + (size_t)(t + 2) * kstep;
            const char* a3 = a2 + kstep; const char* b3 = b2 + kstep;
            if (last && has_next) S.a_ready(nxt);
            if constexpr (SP2) {
            PG8_LDB(B0, 0, 0); PG8_LDB(B1, 0, 1); PG8_SCHED; PG8_LDA(At, 0, 0); PG8_STAGE(PG8_SA(1, 1), a1 + hstepA, voffA);
            PG8_WAIT_V(8); PG8_WAIT_L(0); PG8_BAR; PG8_MMA(0, 0, At, B0); PG8_MMA(0, 1, At, B1); PG8_BAR; PG8_SCHED;
            PG8_LDA(At, 0, 1); PG8_STAGE(PG8_SB(0, 0), b2, voffB); PG8_STAGE(PG8_SB(0, 1), b2 + hstepB, voffB); PG8_STAGE(PG8_SA(0, 0), a2, voffA);
            PG8_WAIT_V(8); PG8_WAIT_L(0); PG8_BAR; PG8_MMA(1, 0, At, B0); PG8_MMA(1, 1, At, B1); PG8_BAR; PG8_SCHED;
            PG8_LDB(B0, 1, 0); PG8_LDB(B1, 1, 1); PG8_SCHED; PG8_LDA(At, 1, 0); PG8_STAGE(PG8_SA(0, 1), a2 + hstepA, voffA);
            PG8_WAIT_V(8); PG8_WAIT_L(0); PG8_BAR; PG8_MMA(0, 0, At, B0); PG8_MMA(0, 1, At, B1); PG8_BAR; PG8_SCHED;
            PG8_LDA(At, 1, 1); PG8_STAGE(PG8_SB(1, 0), b3, voffB); PG8_STAGE(PG8_SB(1, 1), b3 + hstepB, voffB); PG8_STAGE(PG8_SA(1, 0), a3, voffA);
            PG8_WAIT_V(8); PG8_WAIT_L(0); PG8_BAR; PG8_MMA(1, 0, At, B0); PG8_MMA(1, 1, At, B1); PG8_BAR; PG8_SCHED;
            } else {
            PG8_LDB(B0, 0, 0); PG8_SCHED; PG8_LDA(At, 0, 0); PG8_STAGE(PG8_SA(1, 1), a1 + hstepA, voffA);
            PG8_WAIT_L(8); PG8_BAR; PG8_WAIT_L(0); PG8_MMA(0, 0, At, B0); PG8_BAR; PG8_SCHED;
            PG8_LDB(B1, 0, 1); PG8_STAGE(PG8_SB(0, 0), b2, voffB);
            PG8_BAR; PG8_WAIT_L(0); PG8_MMA(0, 1, At, B1); PG8_BAR;
            PG8_LDA(At, 0, 1); PG8_STAGE(PG8_SA(0, 0), a2, voffA);
            PG8_BAR; PG8_WAIT_L(0); PG8_MMA(1, 0, At, B0); PG8_BAR; PG8_SCHED;
            PG8_STAGE(PG8_SB(0, 1), b2 + hstepB, voffB);
            PG8_WAIT_V(6); PG8_BAR; PG8_MMA(1, 1, At, B1); PG8_BAR;
            PG8_LDB(B0, 1, 0); PG8_SCHED; PG8_LDA(At, 1, 0); PG8_STAGE(PG8_SA(0, 1), a2 + hstepA, voffA);
            PG8_WAIT_L(8); PG8_BAR; PG8_WAIT_L(0); PG8_MMA(0, 0, At, B0); PG8_BAR; PG8_SCHED;
            PG8_LDB(B1, 1, 1); PG8_STAGE(PG8_SB(1, 0), b3, voffB);
            PG8_BAR; PG8_WAIT_L(0); PG8_MMA(0, 1, At, B1); PG8_BAR;
            PG8_LDA(At, 1, 1); PG8_STAGE(PG8_SA(1, 0), a3, voffA);
            PG8_BAR; PG8_WAIT_L(0); PG8_MMA(1, 0, At, B0); PG8_BAR; PG8_SCHED;
            PG8_STAGE(PG8_SB(1, 1), b3 + hstepB, voffB);
            PG8_WAIT_V(6); PG8_BAR; PG8_MMA(1, 1, At, B1); PG8_BAR;
            }
        }
        if constexpr (ALIGN_EPI) { if (wr == 0) PG8_BAR; }
        if constexpr (!Epi::AFTER_DRAIN) { E(acc, cur, wr, wc, fr, fq); S.done(cur); }
        if (!has_next) break;
#pragma unroll
        for (int a = 0; a < 2; ++a)
#pragma unroll
            for (int b = 0; b < 2; ++b)
#pragma unroll
                for (int m = 0; m < 4; ++m)
#pragma unroll
                    for (int n = 0; n < 2; ++n) acc[a][b][m][n] = (f32x4){0.f, 0.f, 0.f, 0.f};
        cur = nxt; cA = nA; cB = nB; ++ui;
        if constexpr (ALIGN_EPI) { if (wr == 1) PG8_BAR; }
    }
    PG8_WAIT_V(0);
    if constexpr (!ALIGN_EPI) { if (wr == 0) PG8_BAR; }
    PG8_BAR;
    if constexpr (Epi::AFTER_DRAIN) { E.fused(acc, cur, wr, wc, fr, fq, lds, wid, lane); S.done(cur); }
#undef PG8_SA
#undef PG8_SB
#undef PG8_STAGE
#undef PG8_LDA
#undef PG8_LDB
#undef PG8_MMA
#undef PG8_WAIT_V
#undef PG8_WAIT_L
#undef PG8_BAR
#undef PG8_SCHED
}
}


struct RowBatch { u32x4 r[8][2]; };
__device__ __forceinline__ void batch_load(RowBatch& B, __amdgpu_buffer_rsrc_t T, int iv0, int iv1, int c, int voff) {
#pragma unroll
    for (int j = 0; j < 8; ++j) {
        const int n = 8 * c + j;
        const int e = __builtin_amdgcn_readlane(n < 64 ? iv0 : iv1, n & 63);
        B.r[j][0] = __builtin_amdgcn_raw_buffer_load_b128(T, voff, e * 2048, 0); B.r[j][1] = __builtin_amdgcn_raw_buffer_load_b128(T, voff + 1024, e * 2048, 0);
    }
}
template <bool FINAL>
__device__ __forceinline__ void p6_peer_opt(const Args& a, int layer, const bf16_t* H, const float* SSQ, bf16_t* Hout, float* RSout, int nrows, int gw, int nw, int lane) {
    const __amdgpu_buffer_rsrc_t UB = MKRSRC(a.ws + WS_UB + (size_t)layer * NEXP * D * 2, NEXP * D * 2);
    const __amdgpu_buffer_rsrc_t VB = MKRSRC(a.ws + WS_VB + (size_t)layer * NEXP * D * 2, NEXP * D * 2);
    const __amdgpu_buffer_rsrc_t IDXr = MKRSRC(a.ws + WS_IDX, RP * 128 * 4), GATEr = MKRSRC(a.ws + WS_GATE, RP * 128 * 4);
    const __amdgpu_buffer_rsrc_t Hr = MKRSRC(H, RP * D * 2), SSQr = MKRSRC(SSQ, RP * 16 * 4);
    const __amdgpu_buffer_rsrc_t Or = FINAL ? MKRSRC(a.out, XROWS * D * 4) : MKRSRC(Hout, RP * D * 2);
    const int voff = lane * 16, v4 = lane * 4;
    for (int row = gw; row < nrows; row += nw) {
        const int iv0 = __builtin_amdgcn_raw_buffer_load_b32(IDXr, v4, row * 512, 0), iv1 = __builtin_amdgcn_raw_buffer_load_b32(IDXr, v4 + 256, row * 512, 0);
        const float gv0 = __builtin_bit_cast(float, __builtin_amdgcn_raw_buffer_load_b32(GATEr, v4, row * 512, 0)), gv1 = __builtin_bit_cast(float, __builtin_amdgcn_raw_buffer_load_b32(GATEr, v4 + 256, row * 512, 0));
        RowBatch A, B;
        batch_load(A, UB, iv0, iv1, 0, voff);
        const u32x4 h0 = __builtin_amdgcn_raw_buffer_load_b128(Hr, voff, row * 2048, 0), h1 = __builtin_amdgcn_raw_buffer_load_b128(Hr, voff + 1024, row * 2048, 0);
        float hv[16];
#pragma unroll
        for (int j = 0; j < 4; ++j) { hv[2 * j] = bflo(h0[j]); hv[2 * j + 1] = bfhi(h0[j]); hv[8 + 2 * j] = bflo(h1[j]); hv[9 + 2 * j] = bfhi(h1[j]); }
        const float sq = __builtin_bit_cast(float, __builtin_amdgcn_raw_buffer_load_b32(SSQr, (lane & 15) * 4, row * 64, 0));
        const float rstd = rsqrtf(wave_sum(sq) * (0.25f / D) + EPS);
        float cc0 = 0.f, cc1 = 0.f;
#define PEER_DOTS(BUF, c) do { _Pragma("unroll") for (int j = 0; j < 8; ++j) { const int n = 8 * (c) + j; float ds = 0.f; \
            u32x4 r0 = BUF.r[j][0], r1 = BUF.r[j][1]; asm volatile("" : "+v"(r0), "+v"(r1), "+v"(cc0), "+v"(cc1));     \
            _Pragma("unroll") for (int q = 0; q < 4; ++q) ds += hv[2 * q] * bflo(r0[q]) + hv[2 * q + 1] * bfhi(r0[q]) + hv[8 + 2 * q] * bflo(r1[q]) + hv[9 + 2 * q] * bfhi(r1[q]); \
            ds = wave_sum(ds); const float act = gelu_tanh(ds * rstd); \
            cc0 = (lane == n) ? gv0 * act : cc0; cc1 = (lane == n - 64) ? gv1 * act : cc1; } } while (0)
#pragma unroll 1
        for (int c = 0; c < 16; c += 2) {
            batch_load(B, UB, iv0, iv1, c + 1, voff);
            PEER_DOTS(A, c);
            if (c + 2 < 16) batch_load(A, UB, iv0, iv1, c + 2, voff); else batch_load(A, VB, iv0, iv1, 0, voff);
            PEER_DOTS(B, c + 1);
        }
#undef PEER_DOTS
        float y[16];
#pragma unroll
        for (int j = 0; j < 16; ++j) y[j] = 0.f;
#define PEER_ACC(BUF, c) do { _Pragma("unroll") for (int j = 0; j < 8; ++j) { const int n = 8 * (c) + j; \
            const float cf = __builtin_bit_cast(float, __builtin_amdgcn_readlane(__builtin_bit_cast(int, n < 64 ? cc0 : cc1), n & 63)); \
            u32x4 r0 = BUF.r[j][0], r1 = BUF.r[j][1]; \
            asm volatile("" : "+v"(r0), "+v"(r1), "+v"(y[0]), "+v"(y[1]), "+v"(y[2]), "+v"(y[3]), "+v"(y[4]), "+v"(y[5]), "+v"(y[6]), "+v"(y[7]), "+v"(y[8]), "+v"(y[9]), "+v"(y[10]), "+v"(y[11]), "+v"(y[12]), "+v"(y[13]), "+v"(y[14]), "+v"(y[15])); \
            _Pragma("unroll") for (int q = 0; q < 4; ++q) { y[2 * q] += cf * bflo(r0[q]); y[2 * q + 1] += cf * bfhi(r0[q]); y[8 + 2 * q] += cf * bflo(r1[q]); y[9 + 2 * q] += cf * bfhi(r1[q]); } } } while (0)
#pragma unroll 1
        for (int c = 0; c < 16; c += 2) {
            batch_load(B, VB, iv0, iv1, c + 1, voff);
            PEER_ACC(A, c);
            if (c + 2 < 16) batch_load(A, VB, iv0, iv1, c + 2, voff);
            PEER_ACC(B, c + 1);
        }
#undef PEER_ACC
        {
            const u32x4 r0 = __builtin_amdgcn_raw_buffer_load_b128(Hr, voff, row * 2048, 0), r1 = __builtin_amdgcn_raw_buffer_load_b128(Hr, voff + 1024, row * 2048, 0);
#pragma unroll
            for (int j = 0; j < 4; ++j) { y[2 * j] += bflo(r0[j]); y[2 * j + 1] += bfhi(r0[j]); y[8 + 2 * j] += bflo(r1[j]); y[9 + 2 * j] += bfhi(r1[j]); }
        }
        if (FINAL) {
            const int v8 = lane * 32;
            __builtin_amdgcn_raw_buffer_store_b128(__builtin_bit_cast(u32x4, (f32x4){y[0], y[1], y[2], y[3]}), Or, v8, row * 4096, 0);
            __builtin_amdgcn_raw_buffer_store_b128(__builtin_bit_cast(u32x4, (f32x4){y[4], y[5], y[6], y[7]}), Or, v8 + 16, row * 4096, 0);
            __builtin_amdgcn_raw_buffer_store_b128(__builtin_bit_cast(u32x4, (f32x4){y[8], y[9], y[10], y[11]}), Or, v8 + 2048, row * 4096, 0);
            __builtin_amdgcn_raw_buffer_store_b128(__builtin_bit_cast(u32x4, (f32x4){y[12], y[13], y[14], y[15]}), Or, v8 + 2064, row * 4096, 0);
        } else {
            u32x4 w0, w1; float ss = 0.f;
#pragma unroll
            for (int j = 0; j < 4; ++j) { w0[j] = pk2(y[2 * j], y[2 * j + 1]); w1[j] = pk2(y[8 + 2 * j], y[9 + 2 * j]); }
#pragma unroll
            for (int j = 0; j < 4; ++j) { const float a0 = bflo(w0[j]), a1 = bfhi(w0[j]), b0 = bflo(w1[j]), b1 = bfhi(w1[j]); ss += a0 * a0 + a1 * a1 + b0 * b0 + b1 * b1; }
            ss = wave_sum(ss);
            __builtin_amdgcn_raw_buffer_store_b128(w0, Or, voff, row * 2048, 0); __builtin_amdgcn_raw_buffer_store_b128(w1, Or, voff + 1024, row * 2048, 0);
            if (lane == 0) RSout[row] = rsqrtf(ss * (1.f / D) + EPS);
        }
    }
}


typedef float f32x2 __attribute__((ext_vector_type(2)));
struct RowBatch8 { u32x4 r[16]; };
__device__ __forceinline__ void batch_load8(RowBatch8& B, __amdgpu_buffer_rsrc_t T, int iv0, int iv1, int c, int voff) {
#pragma unroll
    for (int j = 0; j < 16; ++j) {
        const int n = 16 * c + j;
        const int e = __builtin_amdgcn_readlane(n < 64 ? iv0 : iv1, n & 63);
        B.r[j] = __builtin_amdgcn_raw_buffer_load_b128(T, voff, e * 1024, 0);
    }
}
template <bool FINAL>
__device__ __forceinline__ void p6_peer8(const Args& a, int layer, const bf16_t* H, const float* SSQ, bf16_t* Hout, float* RSout, int nrows, int gw, int nw, int lane) {
    const __amdgpu_buffer_rsrc_t UB = MKRSRC(a.ws + WS_UB + (size_t)layer * NEXP * D, NEXP * D), VB = MKRSRC(a.ws + WS_VB + (size_t)layer * NEXP * D, NEXP * D);
    const __amdgpu_buffer_rsrc_t USr = MKRSRC(a.ws + WS_UB + 32 * MiB + (size_t)layer * NEXP * 4, NEXP * 4), VSr = MKRSRC(a.ws + WS_VB + 32 * MiB + (size_t)layer * NEXP * 4, NEXP * 4);
    const __amdgpu_buffer_rsrc_t IDXr = MKRSRC(a.ws + WS_IDX, RP * 128 * 4), GATEr = MKRSRC(a.ws + WS_GATE, RP * 128 * 4);
    const __amdgpu_buffer_rsrc_t Hr = MKRSRC(H, RP * D * 2), SSQr = MKRSRC(SSQ, RP * 16 * 4);
    const __amdgpu_buffer_rsrc_t Or = FINAL ? MKRSRC(a.out, XROWS * D * 4) : MKRSRC(Hout, RP * D * 2);
    const int voff = lane * 16, v4 = lane * 4, v32 = lane * 32;
    for (int row = gw; row < nrows; row += nw) {
        const int iv0 = __builtin_amdgcn_raw_buffer_load_b32(IDXr, v4, row * 512, 0), iv1 = __builtin_amdgcn_raw_buffer_load_b32(IDXr, v4 + 256, row * 512, 0);
        RowBatch8 A, B;
        batch_load8(A, UB, iv0, iv1, 0, voff);
        float gs0 = __builtin_bit_cast(float, __builtin_amdgcn_raw_buffer_load_b32(GATEr, v4, row * 512, 0)), gs1 = __builtin_bit_cast(float, __builtin_amdgcn_raw_buffer_load_b32(GATEr, v4 + 256, row * 512, 0));
        const float su0 = __builtin_bit_cast(float, __builtin_amdgcn_raw_buffer_load_b32(USr, iv0 * 4, 0, 0)), su1 = __builtin_bit_cast(float, __builtin_amdgcn_raw_buffer_load_b32(USr, iv1 * 4, 0, 0));
        gs0 *= __builtin_bit_cast(float, __builtin_amdgcn_raw_buffer_load_b32(VSr, iv0 * 4, 0, 0)); gs1 *= __builtin_bit_cast(float, __builtin_amdgcn_raw_buffer_load_b32(VSr, iv1 * 4, 0, 0));
        const u32x4 h0 = __builtin_amdgcn_raw_buffer_load_b128(Hr, v32, row * 2048, 0), h1 = __builtin_amdgcn_raw_buffer_load_b128(Hr, v32 + 16, row * 2048, 0);
        float hv[16];
#pragma unroll
        for (int j = 0; j < 4; ++j) { hv[2 * j] = bflo(h0[j]); hv[2 * j + 1] = bfhi(h0[j]); hv[8 + 2 * j] = bflo(h1[j]); hv[9 + 2 * j] = bfhi(h1[j]); }
        const float sq = __builtin_bit_cast(float, __builtin_amdgcn_raw_buffer_load_b32(SSQr, (lane & 15) * 4, row * 64, 0));
        const float rstd = rsqrtf(wave_sum(sq) * (0.25f / D) + EPS);
        const float rs0 = rstd * su0, rs1 = rstd * su1;
        float cc0 = 0.f, cc1 = 0.f;
        const bool b5 = (lane & 32) != 0, b4 = (lane & 16) != 0, b3 = (lane & 8) != 0, b2 = (lane & 4) != 0;
        const int el = (b5 ? 8 : 0) + (b4 ? 4 : 0) + (b3 ? 2 : 0) + (b2 ? 1 : 0);
        const int lsrc = ((lane >> 3) & 1) * 32 + ((lane >> 2) & 1) * 16 + ((lane >> 1) & 1) * 8 + (lane & 1) * 4;
#define PEER_DOTS8(BUF, c) do { float pd[16]; \
            _Pragma("unroll") for (int j = 0; j < 16; ++j) { float ds = 0.f; \
                u32x4 r0 = BUF.r[j]; if (j > 0) asm volatile("" : "+v"(r0), "+v"(pd[j - 1])); else asm volatile("" : "+v"(r0), "+v"(cc0), "+v"(cc1));     \
                _Pragma("unroll") for (int q = 0; q < 4; ++q) { const f32x2 lo = __builtin_amdgcn_cvt_pk_f32_fp8((int)r0[q], false), hh = __builtin_amdgcn_cvt_pk_f32_fp8((int)r0[q], true); \
                    ds += (hv[4 * q] * lo[0] + hv[4 * q + 1] * lo[1]) + (hv[4 * q + 2] * hh[0] + hv[4 * q + 3] * hh[1]); } \
                pd[j] = ds; } \
              \
            float q8[8], q4[4], q2[2]; \
            _Pragma("unroll") for (int j = 0; j < 8; ++j) { const float snd = b5 ? pd[j] : pd[j + 8], kp = b5 ? pd[j + 8] : pd[j]; q8[j] = kp + __shfl_xor(snd, 32); } \
            _Pragma("unroll") for (int j = 0; j < 4; ++j) { const float snd = b4 ? q8[j] : q8[j + 4], kp = b4 ? q8[j + 4] : q8[j]; q4[j] = kp + __shfl_xor(snd, 16); } \
            _Pragma("unroll") for (int j = 0; j < 2; ++j) { const float snd = b3 ? q4[j] : q4[j + 2], kp = b3 ? q4[j + 2] : q4[j]; q2[j] = kp + __shfl_xor(snd, 8); } \
            float q1 = (b2 ? q2[1] : q2[0]) + __shfl_xor(b2 ? q2[0] : q2[1], 4); \
            q1 += __shfl_xor(q1, 2); q1 += __shfl_xor(q1, 1); \
            const float rsv = __shfl((c) < 4 ? rs0 : rs1, 16 * ((c) & 3) + el);        \
            const float actv = __shfl(gelu_tanh(q1 * rsv), lsrc);                       \
            const bool mine = (lane >> 4) == ((c) & 3); \
            cc0 = (mine && (c) < 4) ? gs0 * actv : cc0; cc1 = (mine && (c) >= 4) ? gs1 * actv : cc1; } while (0)
#pragma unroll 1
        for (int c = 0; c < 8; c += 2) {
            batch_load8(B, UB, iv0, iv1, c + 1, voff);
            PEER_DOTS8(A, c);
            if (c + 2 < 8) batch_load8(A, UB, iv0, iv1, c + 2, voff); else batch_load8(A, VB, iv0, iv1, 0, voff);
            PEER_DOTS8(B, c + 1);
        }
#undef PEER_DOTS8
        float y[16];
#pragma unroll
        for (int j = 0; j < 16; ++j) y[j] = 0.f;
#define PEER_ACC8(BUF, c) do { _Pragma("unroll") for (int j = 0; j < 16; ++j) { const int n = 16 * (c) + j; \
            const float cf = __builtin_bit_cast(float, __builtin_amdgcn_readlane(__builtin_bit_cast(int, n < 64 ? cc0 : cc1), n & 63)); \
            u32x4 r0 = BUF.r[j]; \
            asm volatile("" : "+v"(r0), "+v"(y[0]), "+v"(y[1]), "+v"(y[2]), "+v"(y[3]), "+v"(y[4]), "+v"(y[5]), "+v"(y[6]), "+v"(y[7]), "+v"(y[8]), "+v"(y[9]), "+v"(y[10]), "+v"(y[11]), "+v"(y[12]), "+v"(y[13]), "+v"(y[14]), "+v"(y[15])); \
            _Pragma("unroll") for (int q = 0; q < 4; ++q) { const f32x2 lo = __builtin_amdgcn_cvt_pk_f32_fp8((int)r0[q], false), hh = __builtin_amdgcn_cvt_pk_f32_fp8((int)r0[q], true); \
                y[4 * q] += cf * lo[0]; y[4 * q + 1] += cf * lo[1]; y[4 * q + 2] += cf * hh[0]; y[4 * q + 3] += cf * hh[1]; } } } while (0)
#pragma unroll 1
        for (int c = 0; c < 8; c += 2) {
            batch_load8(B, VB, iv0, iv1, c + 1, voff);
            PEER_ACC8(A, c);
            if (c + 2 < 8) batch_load8(A, VB, iv0, iv1, c + 2, voff);
            PEER_ACC8(B, c + 1);
        }
#undef PEER_ACC8
        {
            const u32x4 r0 = __builtin_amdgcn_raw_buffer_load_b128(Hr, v32, row * 2048, 0), r1 = __builtin_amdgcn_raw_buffer_load_b128(Hr, v32 + 16, row * 2048, 0);
#pragma unroll
            for (int j = 0; j < 4; ++j) { y[2 * j] += bflo(r0[j]); y[2 * j + 1] += bfhi(r0[j]); y[8 + 2 * j] += bflo(r1[j]); y[9 + 2 * j] += bfhi(r1[j]); }
        }
        if (FINAL) {
            const int v64 = lane * 64;
#pragma unroll
            for (int q = 0; q < 4; ++q) __builtin_amdgcn_raw_buffer_store_b128(__builtin_bit_cast(u32x4, (f32x4){y[4 * q], y[4 * q + 1], y[4 * q + 2], y[4 * q + 3]}), Or, v64 + 16 * q, row * 4096, 0);
        } else {
            u32x4 w0, w1; float ss = 0.f;
#pragma unroll
            for (int j = 0; j < 4; ++j) { w0[j] = pk2(y[2 * j], y[2 * j + 1]); w1[j] = pk2(y[8 + 2 * j], y[9 + 2 * j]); }
#pragma unroll
            for (int j = 0; j < 4; ++j) { const float a0 = bflo(w0[j]), a1 = bfhi(w0[j]), b0 = bflo(w1[j]), b1 = bfhi(w1[j]); ss += a0 * a0 + a1 * a1 + b0 * b0 + b1 * b1; }
            ss = wave_sum(ss);
            __builtin_amdgcn_raw_buffer_store_b128(w0, Or, v32, row * 2048, 0); __builtin_amdgcn_raw_buffer_store_b128(w1, Or, v32 + 16, row * 2048, 0);
            if (lane == 0) RSout[row] = rsqrtf(ss * (1.f / D) + EPS);
        }
    }
}


struct RowBatch6 { u32x3 r[16]; };
template <bool F4> __device__ __forceinline__ void batch_load6(RowBatch6& B, __amdgpu_buffer_rsrc_t T, int iv0, int iv1, int c, int lane) {
#pragma unroll
    for (int j = 0; j < 16; ++j) {
        const int n = 16 * c + j;
        const int e = __builtin_amdgcn_readlane(n < 64 ? iv0 : iv1, n & 63);
        if (F4) { const u32x2 t = __builtin_amdgcn_raw_buffer_load_b64(T, lane * 8, e * 512, 0); B.r[j] = (u32x3){t[0], t[1], 0u}; }
        else B.r[j] = __builtin_amdgcn_raw_buffer_load_b96(T, lane * 12, e * 768, 0);
    }
}
template <bool FINAL>
__device__ __forceinline__ void p6_peer6(const Args& a, int layer, const bf16_t* H, const float* SSQ, bf16_t* Hout, float* RSout, int nrows, int gw, int nw, int lane) {
    const __amdgpu_buffer_rsrc_t UB = MKRSRC(a.ws + WS_UB + (size_t)layer * NEXP * USTRIDE, NEXP * USTRIDE), VB = MKRSRC(a.ws + WS_VB + (size_t)layer * NEXP * VSTRIDE, NEXP * VSTRIDE);
    const __amdgpu_buffer_rsrc_t USr = MKRSRC(a.ws + WS_UB + 32 * MiB + (size_t)layer * NEXP * 4, NEXP * 4), VSr = MKRSRC(a.ws + WS_VB + 32 * MiB + (size_t)layer * NEXP * 4, NEXP * 4);
    const __amdgpu_buffer_rsrc_t IDXr = MKRSRC(a.ws + WS_IDX, RP * 128 * 4), GATEr = MKRSRC(a.ws + WS_GATE, RP * 128 * 4);
    const __amdgpu_buffer_rsrc_t Hr = MKRSRC(H, RP * D * 2), SSQr = MKRSRC(SSQ, RP * 16 * 4);
    const __amdgpu_buffer_rsrc_t Or = FINAL ? MKRSRC(a.out, XROWS * D * 4) : MKRSRC(Hout, RP * D * 2);
    const int voff = lane, v4 = lane * 4, v32 = lane * 32;
    const bool b5 = (lane & 32) != 0, b4 = (lane & 16) != 0, b3 = (lane & 8) != 0, b2 = (lane & 4) != 0;
    const int el = (b5 ? 8 : 0) + (b4 ? 4 : 0) + (b3 ? 2 : 0) + (b2 ? 1 : 0);
    const int lsrc = ((lane >> 3) & 1) * 32 + ((lane >> 2) & 1) * 16 + ((lane >> 1) & 1) * 8 + (lane & 1) * 4;
    for (int row = gw; row < nrows; row += nw) {
        const int iv0 = __builtin_amdgcn_raw_buffer_load_b32(IDXr, v4, row * 512, 0), iv1 = __builtin_amdgcn_raw_buffer_load_b32(IDXr, v4 + 256, row * 512, 0);
        RowBatch6 A, B;
        batch_load6<U4>(A, UB, iv0, iv1, 0, voff);
        float gs0 = __builtin_bit_cast(float, __builtin_amdgcn_raw_buffer_load_b32(GATEr, v4, row * 512, 0)), gs1 = __builtin_bit_cast(float, __builtin_amdgcn_raw_buffer_load_b32(GATEr, v4 + 256, row * 512, 0));
        const float su0 = __builtin_bit_cast(float, __builtin_amdgcn_raw_buffer_load_b32(USr, iv0 * 4, 0, 0)), su1 = __builtin_bit_cast(float, __builtin_amdgcn_raw_buffer_load_b32(USr, iv1 * 4, 0, 0));
        gs0 *= __builtin_bit_cast(float, __builtin_amdgcn_raw_buffer_load_b32(VSr, iv0 * 4, 0, 0)); gs1 *= __builtin_bit_cast(float, __builtin_amdgcn_raw_buffer_load_b32(VSr, iv1 * 4, 0, 0));
        const u32x4 h0 = __builtin_amdgcn_raw_buffer_load_b128(Hr, v32, row * 2048, 0), h1 = __builtin_amdgcn_raw_buffer_load_b128(Hr, v32 + 16, row * 2048, 0);
        float hv[16];
#pragma unroll
        for (int j = 0; j < 4; ++j) { hv[2 * j] = bflo(h0[j]); hv[2 * j + 1] = bfhi(h0[j]); hv[8 + 2 * j] = bflo(h1[j]); hv[9 + 2 * j] = bfhi(h1[j]); }
        const float sq = __builtin_bit_cast(float, __builtin_amdgcn_raw_buffer_load_b32(SSQr, (lane & 15) * 4, row * 64, 0));
        const float rstd = rsqrtf(wave_sum(sq) * (0.25f / D) + EPS);
        const float rs0 = rstd * su0, rs1 = rstd * su1;
        float cc0 = 0.f, cc1 = 0.f;
#define PEER_DOTS6(BUF, c) do { float pd[16]; \
            _Pragma("unroll") for (int j = 0; j < 16; j += 2) { \
                u32x6 s6 = (u32x6){BUF.r[j][0], BUF.r[j][1], BUF.r[j][2], BUF.r[j + 1][0], BUF.r[j + 1][1], BUF.r[j + 1][2]}; \
                if (j > 0) asm volatile("" : "+v"(s6), "+v"(pd[j - 1])); else asm volatile("" : "+v"(s6), "+v"(cc0), "+v"(cc1));     \
                float d0 = 0.f, d1 = 0.f; \
                if (U4) { _Pragma("unroll") for (int w = 0; w < 2; ++w) { \
                        { const f32x2 e0 = __builtin_amdgcn_cvt_scalef32_pk_f32_fp4(s6[w], 1.0f, 0), e1 = __builtin_amdgcn_cvt_scalef32_pk_f32_fp4(s6[w], 1.0f, 1), e2 = __builtin_amdgcn_cvt_scalef32_pk_f32_fp4(s6[w], 1.0f, 2), e3 = __builtin_amdgcn_cvt_scalef32_pk_f32_fp4(s6[w], 1.0f, 3); \
                          d0 += (hv[8 * w] * e0[0] + hv[8 * w + 1] * e0[1]) + (hv[8 * w + 2] * e1[0] + hv[8 * w + 3] * e1[1]) + (hv[8 * w + 4] * e2[0] + hv[8 * w + 5] * e2[1]) + (hv[8 * w + 6] * e3[0] + hv[8 * w + 7] * e3[1]); } \
                        { const f32x2 e0 = __builtin_amdgcn_cvt_scalef32_pk_f32_fp4(s6[3 + w], 1.0f, 0), e1 = __builtin_amdgcn_cvt_scalef32_pk_f32_fp4(s6[3 + w], 1.0f, 1), e2 = __builtin_amdgcn_cvt_scalef32_pk_f32_fp4(s6[3 + w], 1.0f, 2), e3 = __builtin_amdgcn_cvt_scalef32_pk_f32_fp4(s6[3 + w], 1.0f, 3); \
                          d1 += (hv[8 * w] * e0[0] + hv[8 * w + 1] * e0[1]) + (hv[8 * w + 2] * e1[0] + hv[8 * w + 3] * e1[1]) + (hv[8 * w + 4] * e2[0] + hv[8 * w + 5] * e2[1]) + (hv[8 * w + 6] * e3[0] + hv[8 * w + 7] * e3[1]); } } \
                } else { const f32x32 dv = __builtin_amdgcn_cvt_scalef32_pk32_f32_fp6(s6, 1.0f); \
                    _Pragma("unroll") for (int i = 0; i < 16; ++i) { d0 += hv[i] * dv[i]; d1 += hv[i] * dv[16 + i]; } } \
                pd[j] = d0; pd[j + 1] = d1; } \
              \
            float q8[8], q4[4], q2[2]; \
            _Pragma("unroll") for (int j = 0; j < 8; ++j) { const float snd = b5 ? pd[j] : pd[j + 8], kp = b5 ? pd[j + 8] : pd[j]; q8[j] = kp + __shfl_xor(snd, 32); } \
            _Pragma("unroll") for (int j = 0; j < 4; ++j) { const float snd = b4 ? q8[j] : q8[j + 4], kp = b4 ? q8[j + 4] : q8[j]; q4[j] = kp + __shfl_xor(snd, 16); } \
            _Pragma("unroll") for (int j = 0; j < 2; ++j) { const float snd = b3 ? q4[j] : q4[j + 2], kp = b3 ? q4[j + 2] : q4[j]; q2[j] = kp + __shfl_xor(snd, 8); } \
            float q1 = (b2 ? q2[1] : q2[0]) + __shfl_xor(b2 ? q2[0] : q2[1], 4); \
            q1 += __shfl_xor(q1, 2); q1 += __shfl_xor(q1, 1); \
            const float rsv = __shfl((c) < 4 ? rs0 : rs1, 16 * ((c) & 3) + el);        \
            const float actv = __shfl(gelu_tanh(q1 * rsv), lsrc);                       \
            const bool mine = (lane >> 4) == ((c) & 3); \
            cc0 = (mine && (c) < 4) ? gs0 * actv : cc0; cc1 = (mine && (c) >= 4) ? gs1 * actv : cc1; } while (0)
#pragma unroll 1
        for (int c = 0; c < 8; c += 2) {
            batch_load6<U4>(B, UB, iv0, iv1, c + 1, voff);
            PEER_DOTS6(A, c);
            if (c + 2 < 8) batch_load6<U4>(A, UB, iv0, iv1, c + 2, voff); else batch_load6<V4>(A, VB, iv0, iv1, 0, voff);
            PEER_DOTS6(B, c + 1);
        }
#undef PEER_DOTS6
        float y[16];
#pragma unroll
        for (int j = 0; j < 16; ++j) y[j] = 0.f;
#define ACC4_BYTE(w, bb) do { const f32x2 e0 = __builtin_amdgcn_cvt_scalef32_pk_f32_fp4(s6[w], 1.0f, bb), e1 = __builtin_amdgcn_cvt_scalef32_pk_f32_fp4(s6[3 + w], 1.0f, bb); \
            y[8 * (w) + 2 * (bb)] += cf0 * e0[0] + cf1 * e1[0]; y[8 * (w) + 2 * (bb) + 1] += cf0 * e0[1] + cf1 * e1[1]; } while (0)
#define PEER_ACC6(BUF, c) do { _Pragma("unroll") for (int j = 0; j < 16; j += 2) { const int n = 16 * (c) + j; \
            const float cf0 = __builtin_bit_cast(float, __builtin_amdgcn_readlane(__builtin_bit_cast(int, n < 64 ? cc0 : cc1), n & 63)); \
            const float cf1 = __builtin_bit_cast(float, __builtin_amdgcn_readlane(__builtin_bit_cast(int, n < 64 ? cc0 : cc1), (n + 1) & 63)); \
            u32x6 s6 = (u32x6){BUF.r[j][0], BUF.r[j][1], BUF.r[j][2], BUF.r[j + 1][0], BUF.r[j + 1][1], BUF.r[j + 1][2]}; \
            asm volatile("" : "+v"(s6), "+v"(y[0]), "+v"(y[1]), "+v"(y[2]), "+v"(y[3]), "+v"(y[4]), "+v"(y[5]), "+v"(y[6]), "+v"(y[7]), "+v"(y[8]), "+v"(y[9]), "+v"(y[10]), "+v"(y[11]), "+v"(y[12]), "+v"(y[13]), "+v"(y[14]), "+v"(y[15])); \
            if (V4) { _Pragma("unroll") for (int w = 0; w < 2; ++w) { \
                    ACC4_BYTE(w, 0); ACC4_BYTE(w, 1); ACC4_BYTE(w, 2); ACC4_BYTE(w, 3); } \
            } else { const f32x32 dv = __builtin_amdgcn_cvt_scalef32_pk32_f32_fp6(s6, 1.0f); \
                _Pragma("unroll") for (int i = 0; i < 16; ++i) y[i] += cf0 * dv[i] + cf1 * dv[16 + i]; } } } while (0)
#pragma unroll 1
        for (int c = 0; c < 8; c += 2) {
            batch_load6<V4>(B, VB, iv0, iv1, c + 1, voff);
            PEER_ACC6(A, c);
            if (c + 2 < 8) batch_load6<V4>(A, VB, iv0, iv1, c + 2, voff);
            PEER_ACC6(B, c + 1);
        }
#undef PEER_ACC6
        {
            const u32x4 r0 = __builtin_amdgcn_raw_buffer_load_b128(Hr, v32, row * 2048, 0), r1 = __builtin_amdgcn_raw_buffer_load_b128(Hr, v32 + 16, row * 2048, 0);
#pragma unroll
            for (int j = 0; j < 4; ++j) { y[2 * j] += bflo(r0[j]); y[2 * j + 1] += bfhi(r0[j]); y[8 + 2 * j] += bflo(r1[j]); y[9 + 2 * j] += bfhi(r1[j]); }
        }
        if (FINAL) {
            const int v64 = lane * 64;
#pragma unroll
            for (int q = 0; q < 4; ++q) __builtin_amdgcn_raw_buffer_store_b128(__builtin_bit_cast(u32x4, (f32x4){y[4 * q], y[4 * q + 1], y[4 * q + 2], y[4 * q + 3]}), Or, v64 + 16 * q, row * 4096, 0);
        } else {
            u32x4 w0, w1; float ss = 0.f;
#pragma unroll
            for (int j = 0; j < 4; ++j) { w0[j] = pk2(y[2 * j], y[2 * j + 1]); w1[j] = pk2(y[8 + 2 * j], y[9 + 2 * j]); }
#pragma unroll
            for (int j = 0; j < 4; ++j) { const float a0 = bflo(w0[j]), a1 = bfhi(w0[j]), b0 = bflo(w1[j]), b1 = bfhi(w1[j]); ss += a0 * a0 + a1 * a1 + b0 * b0 + b1 * b1; }
            ss = wave_sum(ss);
            __builtin_amdgcn_raw_buffer_store_b128(w0, Or, v32, row * 2048, 0); __builtin_amdgcn_raw_buffer_store_b128(w1, Or, v32 + 16, row * 2048, 0);
            if (lane == 0) RSout[row] = rsqrtf(ss * (1.f / D) + EPS);
        }
    }
}


constexpr int CQ_MAXR = 17, CQ_WLDS = CQ_MAXR * 1024 + 128;
struct QBatch { u32x3 r[8]; };
template <bool FINAL>
__device__ __forceinline__ void p6_peer_cq(const Args& a, int layer, const bf16_t* H, const float* SSQ, bf16_t* Hout, float* RSout, int nrows, LAS unsigned char* lds) {
    const int tid = opaque_tid(), lane = tid & 63, wave = __builtin_amdgcn_readfirstlane(tid >> 6), slot = lane >> 4, chunk = lane & 15;
    const int gw = wave * (int)gridDim.x + (int)blockIdx.x, nw = (int)gridDim.x * 8;
    const int nk = gw < nrows ? (nrows - gw + nw - 1) / nw : 0;
    LAS int* IDXL = (LAS int*)(lds + wave * CQ_WLDS); LAS float* CL = (LAS float*)(lds + wave * CQ_WLDS + CQ_MAXR * 512); LAS float* RSL = (LAS float*)(lds + wave * CQ_WLDS + CQ_MAXR * 1024);
    const __amdgpu_buffer_rsrc_t USr = MKRSRC(a.ws + WS_UB + 32 * MiB + (size_t)layer * NEXP * 4, NEXP * 4), VSr = MKRSRC(a.ws + WS_VB + 32 * MiB + (size_t)layer * NEXP * 4, NEXP * 4);
    const __amdgpu_buffer_rsrc_t IDXr = MKRSRC(a.ws + WS_IDX, RP * 128 * 4), GATEr = MKRSRC(a.ws + WS_GATE, RP * 128 * 4);
    const __amdgpu_buffer_rsrc_t Hr = MKRSRC(H, RP * D * 2), SSQr = MKRSRC(SSQ, RP * 16 * 4);
    const __amdgpu_buffer_rsrc_t Or = FINAL ? MKRSRC(a.out, XROWS * D * 4) : MKRSRC(Hout, RP * D * 2);
    const bool b3 = (chunk & 8) != 0, b2 = (chunk & 4) != 0, b1 = (chunk & 2) != 0, b0 = (chunk & 1) != 0, s1 = (slot & 2) != 0, s0 = (slot & 1) != 0;
    const int c12 = chunk * 12;
    for (int k0 = 0; k0 < nk; k0 += 6) {
        int t0[6], t1[6];
#pragma unroll
        for (int j = 0; j < 6; ++j) { const int kk = k0 + j < nk ? k0 + j : nk - 1, row = gw + kk * nw;
            t0[j] = __builtin_amdgcn_raw_buffer_load_b32(IDXr, lane * 4, row * 512, 0); t1[j] = __builtin_amdgcn_raw_buffer_load_b32(IDXr, lane * 4 + 256, row * 512, 0); }
#pragma unroll
        for (int j = 0; j < 6; ++j) if (k0 + j < nk) { IDXL[(k0 + j) * 128 + lane] = t0[j]; IDXL[(k0 + j) * 128 + 64 + lane] = t1[j]; }
    }
#define CQ_LOAD(BUF, T, kk, bt) do { int ev[8]; _Pragma("unroll") for (int j = 0; j < 8; ++j) ev[j] = IDXL[(kk) * 128 + 32 * (bt) + 4 * j + slot]; \
        asm volatile("" : "+v"(ev[0]), "+v"(ev[1]), "+v"(ev[2]), "+v"(ev[3]), "+v"(ev[4]), "+v"(ev[5]), "+v"(ev[6]), "+v"(ev[7]));     \
        _Pragma("unroll") for (int j = 0; j < 8; ++j) BUF.r[j] = __builtin_amdgcn_raw_buffer_load_b96(T, ev[j] * 192 + c12, 0, 0); } while (0)
#define CQ_TAB(base, qq) MKRSRC(a.ws + (base) + ((size_t)layer * 4 + (qq)) * NEXP * 192, NEXP * 192)
    const int total = 4 * nk;
    if (U8 && nk > 0) {
        const int slot8 = lane >> 3, chunk8 = lane & 7;
        const bool c2 = (chunk8 & 4) != 0, c1 = (chunk8 & 2) != 0, c0 = (chunk8 & 1) != 0;
        const __amdgpu_buffer_rsrc_t H8r = MKRSRC(a.ws + WS_P1, RP * 1024);
        LAS int* CLI = (LAS int*)CL; LAS float* HSL = RSL;
        for (int k0 = 0; k0 < nk; k0 += 4) {
            u32x4 ha[4], hb[4];
#pragma unroll
            for (int j = 0; j < 4; ++j) { const int kk = k0 + j < nk ? k0 + j : nk - 1, row = gw + kk * nw;
                ha[j] = __builtin_amdgcn_raw_buffer_load_b128(Hr, lane * 32, row * 2048, 0); hb[j] = __builtin_amdgcn_raw_buffer_load_b128(Hr, lane * 32 + 16, row * 2048, 0); }
#pragma unroll
            for (int j = 0; j < 4; ++j) if (k0 + j < nk) { const int row = gw + (k0 + j) * nw;
                float hv[16], am = 0.f;
#pragma unroll
                for (int i = 0; i < 4; ++i) { hv[2 * i] = bflo(ha[j][i]); hv[2 * i + 1] = bfhi(ha[j][i]); hv[8 + 2 * i] = bflo(hb[j][i]); hv[9 + 2 * i] = bfhi(hb[j][i]); }
#pragma unroll
                for (int i = 0; i < 16; ++i) am = fmaxf(am, fabsf(hv[i]));
#pragma unroll
                for (int o = 1; o < 64; o <<= 1) am = fmaxf(am, __shfl_xor(am, o));
                const float sc = am > 0.f ? am * (UI4 ? 1.f / 119.f : 1.f / 127.f) : 1.f, inv = 1.f / sc;
                unsigned w[4] = {0u, 0u, 0u, 0u};
                if (UI4) {
#pragma unroll
                    for (int i = 0; i < 16; ++i) { const int q = (int)__builtin_rintf(hv[i] * inv), hl = ((q + 8) & 15) - 8, hh = (q - hl) >> 4;
                        w[i >> 3] |= ((unsigned)hh & 0xfu) << (4 * (i & 7)); w[2 + (i >> 3)] |= ((unsigned)hl & 0xfu) << (4 * (i & 7)); }
                    __builtin_amdgcn_raw_buffer_store_b64((u32x2){w[0], w[1]}, H8r, lane * 8, row * 1024, 0); __builtin_amdgcn_raw_buffer_store_b64((u32x2){w[2], w[3]}, H8r, 512 + lane * 8, row * 1024, 0);
                } else {
#pragma unroll
                    for (int i = 0; i < 16; ++i) { const int q = (int)__builtin_rintf(hv[i] * inv); w[i >> 2] |= ((unsigned)q & 0xffu) << (8 * (i & 3)); }
                    __builtin_amdgcn_raw_buffer_store_b128((u32x4){w[0], w[1], w[2], w[3]}, H8r, lane * 16, row * 1024, 0);
                }
                if (lane == 0) HSL[k0 + j] = sc; }
        }
        __threadfence_block();
        struct UB4 { u32x4 r[4]; };
        constexpr int NSW = UI4 ? 4 : 8;
#define U8_TAB(ee) MKRSRC(a.ws + WS_UB + ((size_t)layer * NSW + (ee)) * NEXP * 128, NEXP * 128)
#define U8_LOAD(BUF, T, kk, bt) do { int ev[4]; _Pragma("unroll") for (int j = 0; j < 4; ++j) ev[j] = IDXL[(kk) * 128 + 32 * (bt) + 8 * j + slot8]; \
            asm volatile("" : "+v"(ev[0]), "+v"(ev[1]), "+v"(ev[2]), "+v"(ev[3])); \
            _Pragma("unroll") for (int j = 0; j < 4; ++j) BUF.r[j] = __builtin_amdgcn_raw_buffer_load_b128(T, ev[j] * 128 + chunk8 * 16, 0, 0); } while (0)
#define U8_DOTS(BUF, bt) do { _Pragma("unroll") for (int j = 0; j < 4; ++j) { const u32x4 w4 = BUF.r[j]; \
            if (UI4) { const int ah = __builtin_amdgcn_sdot8((int)w4[3], (int)h8[3], __builtin_amdgcn_sdot8((int)w4[2], (int)h8[2], __builtin_amdgcn_sdot8((int)w4[1], (int)h8[1], __builtin_amdgcn_sdot8((int)w4[0], (int)h8[0], 0, false), false), false), false); \
                const int al = __builtin_amdgcn_sdot8((int)w4[3], (int)h8l[3], __builtin_amdgcn_sdot8((int)w4[2], (int)h8l[2], __builtin_amdgcn_sdot8((int)w4[1], (int)h8l[1], __builtin_amdgcn_sdot8((int)w4[0], (int)h8l[0], 0, false), false), false), false); \
                pd[4 * (bt) + j] = ah * 16 + al; } \
            else pd[4 * (bt) + j] = __builtin_amdgcn_sdot4((int)w4[3], (int)h8[3], __builtin_amdgcn_sdot4((int)w4[2], (int)h8[2], __builtin_amdgcn_sdot4((int)w4[1], (int)h8[1], __builtin_amdgcn_sdot4((int)w4[0], (int)h8[0], 0, false), false), false), false); } } while (0)
        UB4 A0, A1, A2, A3; u32x4 h8n, h8ln = (u32x4){0u, 0u, 0u, 0u};
        { const __amdgpu_buffer_rsrc_t T0 = U8_TAB(0);
          h8n = __builtin_amdgcn_raw_buffer_load_b128(H8r, chunk8 * 16, gw * 1024, 0);
          if (UI4) h8ln = __builtin_amdgcn_raw_buffer_load_b128(H8r, 512 + chunk8 * 16, gw * 1024, 0);
          U8_LOAD(A0, T0, 0, 0); U8_LOAD(A1, T0, 0, 1); U8_LOAD(A2, T0, 0, 2); U8_LOAD(A3, T0, 0, 3); }
        const int total8 = NSW * nk;
        int e = 0, k = 0;
#pragma unroll 1
        for (int f = 0; f < total8; ++f) {
            const int row = gw + k * nw;
            const u32x4 h8 = h8n, h8l = h8ln;
            const int ib = 8 * (c2 ? 1 : 0) + 4 * (c1 ? 1 : 0) + 2 * (c0 ? 1 : 0);
            float fus[2] = {0.f, 0.f}, fvs[2] = {0.f, 0.f}, fg[2] = {0.f, 0.f}, fsq = 0.f;
            if (e == NSW - 1) {
                fsq = __builtin_bit_cast(float, __builtin_amdgcn_raw_buffer_load_b32(SSQr, (lane & 15) * 4, row * 64, 0));
#pragma unroll
                for (int m = 0; m < 2; ++m) { const int n = 8 * (ib + m) + slot8, ex = IDXL[k * 128 + n];
                    fus[m] = __builtin_bit_cast(float, __builtin_amdgcn_raw_buffer_load_b32(USr, ex * 4, 0, 0)); fvs[m] = __builtin_bit_cast(float, __builtin_amdgcn_raw_buffer_load_b32(VSr, ex * 4, 0, 0));
                    fg[m] = __builtin_bit_cast(float, __builtin_amdgcn_raw_buffer_load_b32(GATEr, n * 4, row * 512, 0)); }
            }
            int kn = k + 1, en = e; if (kn == nk) { kn = 0; ++en; }
            if (f + 1 == total8) { kn = k; en = e; }
            const __amdgpu_buffer_rsrc_t TN = U8_TAB(en);
            int pd[16];
            U8_DOTS(A0, 0);
            h8n = __builtin_amdgcn_raw_buffer_load_b128(H8r, en * 128 + chunk8 * 16, (gw + kn * nw) * 1024, 0);
            if (UI4) h8ln = __builtin_amdgcn_raw_buffer_load_b128(H8r, 512 + en * 128 + chunk8 * 16, (gw + kn * nw) * 1024, 0);
            U8_LOAD(A0, TN, kn, 0);
            U8_DOTS(A1, 1); U8_LOAD(A1, TN, kn, 1);
            U8_DOTS(A2, 2); U8_LOAD(A2, TN, kn, 2);
            U8_DOTS(A3, 3); U8_LOAD(A3, TN, kn, 3);
            int q8[8], q4[4], q2[2];
#pragma unroll
            for (int j = 0; j < 8; ++j) { const int snd = c2 ? pd[j] : pd[j + 8], kp = c2 ? pd[j + 8] : pd[j]; q8[j] = kp + __shfl_xor(snd, 4); }
#pragma unroll
            for (int j = 0; j < 4; ++j) { const int snd = c1 ? q8[j] : q8[j + 4], kp = c1 ? q8[j + 4] : q8[j]; q4[j] = kp + __builtin_amdgcn_update_dpp(0, snd, 0x4E, 0xF, 0xF, true); }
#pragma unroll
            for (int j = 0; j < 2; ++j) { const int snd = c0 ? q4[j] : q4[j + 2], kp = c0 ? q4[j + 2] : q4[j]; q2[j] = kp + __builtin_amdgcn_update_dpp(0, snd, 0xB1, 0xF, 0xF, true); }
            if (e < NSW - 1) {
#pragma unroll
                for (int m = 0; m < 2; ++m) { const int ad = k * 128 + 8 * (ib + m) + slot8; CLI[ad] = e == 0 ? q2[m] : CLI[ad] + q2[m]; }
            } else {
                const float rstd = rsqrtf(wave_sum(fsq) * (0.25f / D) + EPS), hs = HSL[k];
#pragma unroll
                for (int m = 0; m < 2; ++m) { const int ad = k * 128 + 8 * (ib + m) + slot8;
                    const float dot = (float)(CLI[ad] + q2[m]) * hs;
                    CL[ad] = fg[m] * fvs[m] * gelu_tanh(dot * rstd * fus[m]); }
            }
            k = kn; e = en;
        }
#undef U8_TAB
#undef U8_LOAD
#undef U8_DOTS
    }
    if (!U8 && nk > 0) {
        QBatch A0, A1, A2, A3; u32x4 hn0, hn1;
        { const __amdgpu_buffer_rsrc_t T0 = CQ_TAB(WS_UB, 0);
          hn0 = __builtin_amdgcn_raw_buffer_load_b128(Hr, chunk * 32, gw * 2048, 0); hn1 = __builtin_amdgcn_raw_buffer_load_b128(Hr, chunk * 32 + 16, gw * 2048, 0);
          CQ_LOAD(A0, T0, 0, 0); CQ_LOAD(A1, T0, 0, 1); CQ_LOAD(A2, T0, 0, 2); CQ_LOAD(A3, T0, 0, 3); }
        int q = 0, k = 0;
#pragma unroll 1
        for (int f = 0; f < total; ++f) {
            const int row = gw + k * nw;
            float hv[16];
#pragma unroll
            for (int j = 0; j < 4; ++j) { hv[2 * j] = bflo(hn0[j]); hv[2 * j + 1] = bfhi(hn0[j]); hv[8 + 2 * j] = bflo(hn1[j]); hv[9 + 2 * j] = bfhi(hn1[j]); }
            float pd[16], chain = 0.f;
            float fus[2] = {0.f, 0.f}, fvs[2] = {0.f, 0.f}, fg[2] = {0.f, 0.f}, fsq = 0.f;
            if (q == 3) {
                fsq = __builtin_bit_cast(float, __builtin_amdgcn_raw_buffer_load_b32(SSQr, chunk * 4, row * 64, 0));
#pragma unroll
                for (int m = 0; m < 2; ++m) { const int n = 64 * m + 4 * chunk + slot, e = IDXL[k * 128 + n];
                    fus[m] = __builtin_bit_cast(float, __builtin_amdgcn_raw_buffer_load_b32(USr, e * 4, 0, 0)); fvs[m] = __builtin_bit_cast(float, __builtin_amdgcn_raw_buffer_load_b32(VSr, e * 4, 0, 0));
                    fg[m] = __builtin_bit_cast(float, __builtin_amdgcn_raw_buffer_load_b32(GATEr, n * 4, row * 512, 0)); }
            }
#define CQ_DOTS(BUF, base) do { _Pragma("unroll") for (int j = 0; j < 8; j += 2) { \
                u32x6 s6 = (u32x6){BUF.r[j][0], BUF.r[j][1], BUF.r[j][2], BUF.r[j + 1][0], BUF.r[j + 1][1], BUF.r[j + 1][2]}; \
                asm volatile("" : "+v"(s6), "+v"(chain));     \
                const f32x32 dv = __builtin_amdgcn_cvt_scalef32_pk32_f32_fp6(s6, 1.0f); f32x2 d0 = (f32x2){0.f, 0.f}, d1 = (f32x2){0.f, 0.f}; \
                _Pragma("unroll") for (int i = 0; i < 8; ++i) { const f32x2 h2 = (f32x2){hv[2 * i], hv[2 * i + 1]}; \
                    d0 = __builtin_elementwise_fma(h2, (f32x2){dv[2 * i], dv[2 * i + 1]}, d0); d1 = __builtin_elementwise_fma(h2, (f32x2){dv[16 + 2 * i], dv[17 + 2 * i]}, d1); } \
                pd[(base) + j] = d0[0] + d0[1]; pd[(base) + j + 1] = d1[0] + d1[1]; chain = pd[(base) + j + 1]; } } while (0)
#define CQ_REDUCE(m) do { float q8[8], q4[4], q2[2]; \
                _Pragma("unroll") for (int j = 0; j < 8; ++j) { const float snd = b3 ? pd[j] : pd[j + 8], kp = b3 ? pd[j + 8] : pd[j]; q8[j] = kp + dpp_xor8(snd); } \
                _Pragma("unroll") for (int j = 0; j < 4; ++j) { const float snd = b2 ? q8[j] : q8[j + 4], kp = b2 ? q8[j + 4] : q8[j]; q4[j] = kp + __shfl_xor(snd, 4); } \
                _Pragma("unroll") for (int j = 0; j < 2; ++j) { const float snd = b1 ? q4[j] : q4[j + 2], kp = b1 ? q4[j + 2] : q4[j]; q2[j] = kp + dpp_xor2(snd); } \
                const float q1 = (b0 ? q2[1] : q2[0]) + dpp_xor1(b0 ? q2[0] : q2[1]); \
                const int ad = k * 128 + 64 * (m) + 4 * chunk + slot; CL[ad] = q == 0 ? q1 : CL[ad] + q1; } while (0)
            int kn = k + 1, qn = q; if (kn == nk) { kn = 0; ++qn; }
            if (f + 1 == total) { kn = k; qn = q; }
            const __amdgpu_buffer_rsrc_t TN = CQ_TAB(WS_UB, qn);
            CQ_DOTS(A0, 0);
            { const int rn = gw + kn * nw; hn0 = __builtin_amdgcn_raw_buffer_load_b128(Hr, qn * 512 + chunk * 32, rn * 2048, 0); hn1 = __builtin_amdgcn_raw_buffer_load_b128(Hr, qn * 512 + chunk * 32 + 16, rn * 2048, 0); }
            CQ_LOAD(A0, TN, kn, 0);
            CQ_DOTS(A1, 8); CQ_LOAD(A1, TN, kn, 1); CQ_REDUCE(0);
            CQ_DOTS(A2, 0); CQ_LOAD(A2, TN, kn, 2);
            CQ_DOTS(A3, 8); CQ_LOAD(A3, TN, kn, 3); CQ_REDUCE(1);
            if (q == 3) {
                const float rstd = rsqrtf(wave_sum(fsq) * (0.25f / D) + EPS);
#pragma unroll
                for (int m = 0; m < 2; ++m) { const int ad = k * 128 + 64 * m + 4 * chunk + slot;
                    CL[ad] = fg[m] * fvs[m] * gelu_tanh(CL[ad] * rstd * fus[m]); }
            }
            k = kn; q = qn;
        }
#undef CQ_DOTS
#undef CQ_REDUCE
    }
    if (V4 && nk > 0) {
        const int slot8 = lane >> 3, chunk8 = lane & 7;
        const bool t2 = (slot8 & 4) != 0, t1 = (slot8 & 2) != 0, t0 = (slot8 & 1) != 0;
        struct VB4 { u32x4 r[4]; };
#define V4_TAB(qq) MKRSRC(a.ws + WS_VB + ((size_t)layer * 4 + (qq)) * NEXP * 128, NEXP * 128)
#define V4_LOAD(BUF, T, kk, bt) do { int ev[4]; _Pragma("unroll") for (int j = 0; j < 4; ++j) ev[j] = IDXL[(kk) * 128 + 32 * (bt) + 8 * j + slot8]; \
            asm volatile("" : "+v"(ev[0]), "+v"(ev[1]), "+v"(ev[2]), "+v"(ev[3])); \
            _Pragma("unroll") for (int j = 0; j < 4; ++j) BUF.r[j] = __builtin_amdgcn_raw_buffer_load_b128(T, ev[j] * 128 + chunk8 * 16, 0, 0); } while (0)
#define V4_DEC(W, E, o) do { E[(o) + 0] = __builtin_amdgcn_cvt_scalef32_pk_f32_fp4(W, 1.0f, 0); E[(o) + 1] = __builtin_amdgcn_cvt_scalef32_pk_f32_fp4(W, 1.0f, 1); E[(o) + 2] = __builtin_amdgcn_cvt_scalef32_pk_f32_fp4(W, 1.0f, 2); E[(o) + 3] = __builtin_amdgcn_cvt_scalef32_pk_f32_fp4(W, 1.0f, 3); } while (0)
#define V4_ACC(BUF, bt) do { float cf[4]; _Pragma("unroll") for (int j = 0; j < 4; ++j) cf[j] = CL[k * 128 + 32 * (bt) + 8 * j + slot8]; \
            asm volatile("" : "+v"(cf[0]), "+v"(cf[1]), "+v"(cf[2]), "+v"(cf[3])); \
            _Pragma("unroll") for (int j = 0; j < 4; ++j) { u32x4 w4 = BUF.r[j]; asm volatile("" : "+v"(w4), "+v"(y2[0]), "+v"(y2[15])); \
                f32x2 e[16]; V4_DEC(w4[0], e, 0); V4_DEC(w4[1], e, 4); V4_DEC(w4[2], e, 8); V4_DEC(w4[3], e, 12); const f32x2 c0 = (f32x2){cf[j], cf[j]}; \
                _Pragma("unroll") for (int i = 0; i < 16; ++i) y2[i] = __builtin_elementwise_fma(c0, e[i], y2[i]); } } while (0)
        VB4 A0, A1, A2, A3;
        { const __amdgpu_buffer_rsrc_t T0 = V4_TAB(0); V4_LOAD(A0, T0, 0, 0); V4_LOAD(A1, T0, 0, 1); V4_LOAD(A2, T0, 0, 2); V4_LOAD(A3, T0, 0, 3); }
        int q = 0, k = 0;
#pragma unroll 1
        for (int f = 0; f < total; ++f) {
            const int row = gw + k * nw;
            f32x2 y2[16];
#pragma unroll
            for (int j = 0; j < 16; ++j) y2[j] = (f32x2){0.f, 0.f};
            int kn = k + 1, qn = q; if (kn == nk) { kn = 0; ++qn; }
            if (f + 1 == total) { kn = k; qn = q; }
            const __amdgpu_buffer_rsrc_t TN = V4_TAB(qn);
            const int hoff = q * 512 + chunk8 * 64 + slot8 * 8;
            const u32x2 hr = __builtin_amdgcn_raw_buffer_load_b64(Hr, hoff, row * 2048, 0);
            V4_ACC(A0, 0); V4_LOAD(A0, TN, kn, 0);
            V4_ACC(A1, 1); V4_LOAD(A1, TN, kn, 1);
            V4_ACC(A2, 2); V4_LOAD(A2, TN, kn, 2);
            V4_ACC(A3, 3); V4_LOAD(A3, TN, kn, 3);
            float y16[16], y8[8], y4[4];
#pragma unroll
            for (int j = 0; j < 16; ++j) { const float ylo = y2[j >> 1][j & 1], yhi = y2[8 + (j >> 1)][j & 1]; const float snd = t2 ? ylo : yhi, kp = t2 ? yhi : ylo; y16[j] = kp + __shfl_xor(snd, 32); }
#pragma unroll
            for (int j = 0; j < 8; ++j) { const float snd = t1 ? y16[j] : y16[j + 8], kp = t1 ? y16[j + 8] : y16[j]; y8[j] = kp + __shfl_xor(snd, 16); }
#pragma unroll
            for (int j = 0; j < 4; ++j) { const float snd = t0 ? y8[j] : y8[j + 4], kp = t0 ? y8[j + 4] : y8[j]; y4[j] = kp + dpp_xor8(snd); }
            y4[0] += bflo(hr[0]); y4[1] += bfhi(hr[0]); y4[2] += bflo(hr[1]); y4[3] += bfhi(hr[1]);
            if (FINAL) {
                __builtin_amdgcn_raw_buffer_store_b128(__builtin_bit_cast(u32x4, (f32x4){y4[0], y4[1], y4[2], y4[3]}), Or, 2 * hoff, row * 4096, 0);
            } else {
                const unsigned w0 = pk2(y4[0], y4[1]), w1 = pk2(y4[2], y4[3]);
                const float a0 = bflo(w0), a1 = bfhi(w0), a2 = bflo(w1), a3 = bfhi(w1);
                const float ss = wave_sum((a0 * a0 + a1 * a1) + (a2 * a2 + a3 * a3));
                __builtin_amdgcn_raw_buffer_store_b64((u32x2){w0, w1}, Or, hoff, row * 2048, 0);
                if (lane == 0) { const float t = q == 0 ? ss : RSL[k] + ss; RSL[k] = t; if (q == 3) RSout[row] = rsqrtf(t * (1.f / D) + EPS); }
            }
            k = kn; q = qn;
        }
#undef V4_TAB
#undef V4_LOAD
#undef V4_DEC
#undef V4_ACC
    }
    if (!V4 && nk > 0) {
        QBatch A0, A1, A2, A3;
        { const __amdgpu_buffer_rsrc_t T0 = CQ_TAB(WS_VB, 0); CQ_LOAD(A0, T0, 0, 0); CQ_LOAD(A1, T0, 0, 1); CQ_LOAD(A2, T0, 0, 2); CQ_LOAD(A3, T0, 0, 3); }
        int q = 0, k = 0;
#pragma unroll 1
        for (int f = 0; f < total; ++f) {
            const int row = gw + k * nw;
            f32x2 y2[8];
#pragma unroll
            for (int j = 0; j < 8; ++j) y2[j] = (f32x2){0.f, 0.f};
#define CQ_ACC(BUF, bt) do { float cf[8]; _Pragma("unroll") for (int j = 0; j < 8; ++j) cf[j] = CL[k * 128 + 32 * (bt) + 4 * j + slot]; \
            asm volatile("" : "+v"(cf[0]), "+v"(cf[1]), "+v"(cf[2]), "+v"(cf[3]), "+v"(cf[4]), "+v"(cf[5]), "+v"(cf[6]), "+v"(cf[7]));     \
            _Pragma("unroll") for (int j = 0; j < 8; j += 2) { \
                u32x6 s6 = (u32x6){BUF.r[j][0], BUF.r[j][1], BUF.r[j][2], BUF.r[j + 1][0], BUF.r[j + 1][1], BUF.r[j + 1][2]}; \
                asm volatile("" : "+v"(s6), "+v"(y2[0]), "+v"(y2[1]), "+v"(y2[2]), "+v"(y2[3]), "+v"(y2[4]), "+v"(y2[5]), "+v"(y2[6]), "+v"(y2[7])); \
                const f32x32 dv = __builtin_amdgcn_cvt_scalef32_pk32_f32_fp6(s6, 1.0f); const f32x2 c0 = (f32x2){cf[j], cf[j]}, c1 = (f32x2){cf[j + 1], cf[j + 1]}; \
                _Pragma("unroll") for (int i = 0; i < 8; ++i) { y2[i] = __builtin_elementwise_fma(c0, (f32x2){dv[2 * i], dv[2 * i + 1]}, y2[i]); y2[i] = __builtin_elementwise_fma(c1, (f32x2){dv[16 + 2 * i], dv[17 + 2 * i]}, y2[i]); } } } while (0)
            int kn = k + 1, qn = q; if (kn == nk) { kn = 0; ++qn; }
            if (f + 1 == total) { kn = k; qn = q; }
            const __amdgpu_buffer_rsrc_t TN = CQ_TAB(WS_VB, qn);
            const int hoff = q * 512 + chunk * 32 + slot * 8;
            const u32x2 hr = __builtin_amdgcn_raw_buffer_load_b64(Hr, hoff, row * 2048, 0);
            CQ_ACC(A0, 0); CQ_LOAD(A0, TN, kn, 0);
            CQ_ACC(A1, 1); CQ_LOAD(A1, TN, kn, 1);
            CQ_ACC(A2, 2); CQ_LOAD(A2, TN, kn, 2);
            CQ_ACC(A3, 3); CQ_LOAD(A3, TN, kn, 3);
#undef CQ_ACC
            float y8[8], y4[4];
#pragma unroll
            for (int j = 0; j < 8; ++j) { const float ylo = y2[j >> 1][j & 1], yhi = y2[4 + (j >> 1)][j & 1]; const float snd = s1 ? ylo : yhi, kp = s1 ? yhi : ylo; y8[j] = kp + __shfl_xor(snd, 32); }
#pragma unroll
            for (int j = 0; j < 4; ++j) { const float snd = s0 ? y8[j] : y8[j + 4], kp = s0 ? y8[j + 4] : y8[j]; y4[j] = kp + __shfl_xor(snd, 16); }
            y4[0] += bflo(hr[0]); y4[1] += bfhi(hr[0]); y4[2] += bflo(hr[1]); y4[3] += bfhi(hr[1]);
            if (FINAL) {
                __builtin_amdgcn_raw_buffer_store_b128(__builtin_bit_cast(u32x4, (f32x4){y4[0], y4[1], y4[2], y4[3]}), Or, 2 * hoff, row * 4096, 0);
            } else {
                const unsigned w0 = pk2(y4[0], y4[1]), w1 = pk2(y4[2], y4[3]);
                const float a0 = bflo(w0), a1 = bfhi(w0), a2 = bflo(w1), a3 = bfhi(w1);
                const float ss = wave_sum((a0 * a0 + a1 * a1) + (a2 * a2 + a3 * a3));
                __builtin_amdgcn_raw_buffer_store_b64((u32x2){w0, w1}, Or, hoff, row * 2048, 0);
                if (lane == 0) { const float t = q == 0 ? ss : RSL[k] + ss; RSL[k] = t; if (q == 3) RSout[row] = rsqrtf(t * (1.f / D) + EPS); }
            }
            k = kn; q = qn;
        }
    }
#undef CQ_TAB
#undef CQ_LOAD
}

typedef short bf16x8_t __attribute__((ext_vector_type(8)));
__device__ __forceinline__ float fmax_asm(float a, float b) { float r; asm("v_max_f32 %0, %1, %2" : "=v"(r) : "v"(a), "v"(b)); return r; }
__device__ __forceinline__ float fmin_asm(float a, float b) { float r; asm("v_min_f32 %0, %1, %2" : "=v"(r) : "v"(a), "v"(b)); return r; }
#define CEF(a, b) do { const float _mx = fmax_asm(a, b), _mn = fmin_asm(a, b); a = _mx; b = _mn; } while (0)
template <int BASE, int N> __device__ __forceinline__ void sort16_desc(float (&x)[N]) {
#pragma unroll
    for (int p = 1; p < 16; p <<= 1)
#pragma unroll
        for (int k = p; k >= 1; k >>= 1)
#pragma unroll
            for (int j = k % p; j + k < 16; j += 2 * k)
#pragma unroll
                for (int i = 0; i < (k < 16 - j - k ? k : 16 - j - k); ++i)
                    if ((i + j) / (2 * p) == (i + j + k) / (2 * p)) CEF(x[BASE + i + j], x[BASE + i + j + k]);
}
template <int BASE, int N> __device__ __forceinline__ void bitonic_merge16_desc(float (&x)[N]) {
#pragma unroll
    for (int j = 8; j > 0; j >>= 1)
#pragma unroll
        for (int i = 0; i < 16; ++i) { const int l = i ^ j; if (l > i) CEF(x[BASE + i], x[BASE + l]); }
}
template <int A, int B, int N> __device__ __forceinline__ void merge_top16(float (&x)[N]) {
#pragma unroll
    for (int i = 0; i < 16; ++i) x[A + i] = fmax_asm(x[A + i], x[B + 15 - i]);
    bitonic_merge16_desc<A>(x);
}
__device__ __forceinline__ void xlane_merge16(float (&x)[16]) {
    float p[16];
#pragma unroll
    for (int i = 0; i < 16; ++i) p[i] = __shfl_xor(x[i], 32);
#pragma unroll
    for (int i = 0; i < 16; ++i) x[i] = fmax_asm(x[i], p[15 - i]);
    bitonic_merge16_desc<0>(x);
}
constexpr int cand_ai(int s) { return s < 16 ? 0 : s < 24 ? 1 : s < 25 ? 2 : -1; }
constexpr int cand_aj(int s) { return s < 16 ? s : s < 24 ? s - 16 : s < 25 ? 0 : -1; }
constexpr int cand_bi(int s) { return s < 4 ? 2 : s < 8 ? 3 : s < 11 ? 4 : s < 13 ? 5 : s < 15 ? 6 : s < 17 ? 7 : s < 25 ? s - 9 : -1; }
constexpr int cand_bj(int s) { return s < 4 ? s + 1 : s < 8 ? s - 4 : s < 11 ? s - 8 : s < 13 ? s - 11 : s < 15 ? s - 13 : s < 17 ? s - 15 : s < 25 ? 0 : -1; }
constexpr int KLDS_ROW = 272, KLDS_P = 128 * KLDS_ROW;

__device__ __forceinline__ void p5_topk_opt(const Args& a, int layer, const float* SSQ, int ntiles, LAS unsigned char* lds) {
    const int tid = opaque_tid(), lane = tid & 63, wave = __builtin_amdgcn_readfirstlane(tid >> 6), r32 = lane & 31, hi = lane >> 5;
    const int h = blockIdx.x & 7;
    const bf16_t* QP = (const bf16_t*)(a.ws + WS_P1);
    const bf16_t* KeysB = (const bf16_t*)(a.ws + WS_KEYS) + (size_t)layer * 2 * 8 * 128 * 128;
    int* IDX = (int*)(a.ws + WS_IDX); float* GATE = (float*)(a.ws + WS_GATE);
#pragma unroll
    for (int p = 0; p < 2; ++p)
#pragma unroll
        for (int i = 0; i < 4; ++i) { const int chunk = tid + 512 * i, key = chunk >> 4, c16 = chunk & 15;
            const u32x4 v = *(const u32x4*)(KeysB + ((size_t)(p * 8 + h) * 128 + key) * 128 + c16 * 8);
            *(LAS u32x4*)(lds + p * KLDS_P + key * KLDS_ROW + c16 * 16) = v; }
    __syncthreads();
    const int hi4 = hi * 4;
    for (int t = (int)(blockIdx.x >> 3); t < ntiles; t += (int)(gridDim.x >> 3)) {
        const int row = t * 256 + wave * 32 + r32;
        if (t * 256 + wave * 32 >= NROWS) continue;
        asm volatile("" ::: "memory");
        float T[2][16];
#pragma unroll
        for (int p = 0; p < 2; ++p) {
            bf16x8_t qf[8];
            const bf16_t* qp = QP + (size_t)row * 2048 + h * 256 + p * 128 + hi * 8;
#pragma unroll
            for (int ks = 0; ks < 8; ++ks) qf[ks] = *(const bf16x8_t*)(qp + ks * 16);
            f32x16 acc[4];
#pragma unroll
            for (int mt = 0; mt < 4; ++mt) {
                acc[mt] = (f32x16){0.f, 0.f, 0.f, 0.f, 0.f, 0.f, 0.f, 0.f, 0.f, 0.f, 0.f, 0.f, 0.f, 0.f, 0.f, 0.f};
#pragma unroll
                for (int ks = 0; ks < 8; ++ks) {
                    const bf16x8_t kf = *(const LAS bf16x8_t*)(lds + p * KLDS_P + (32 * mt + r32) * KLDS_ROW + ks * 32 + hi * 16);
                    acc[mt] = __builtin_amdgcn_mfma_f32_32x32x16_bf16(kf, qf[ks], acc[mt], 0, 0, 0);
                }
            }
            float x[64];
#pragma unroll
            for (int mt = 0; mt < 4; ++mt)
#pragma unroll
                for (int rg = 0; rg < 16; ++rg) {
                    const unsigned code = 127u - (unsigned)(32 * mt + (rg & 3) + 8 * (rg >> 2));
                    x[16 * mt + rg] = __uint_as_float((__float_as_uint(acc[mt][rg]) & ~127u) | code);
                }
            sort16_desc<0>(x); sort16_desc<16>(x); sort16_desc<32>(x); sort16_desc<48>(x);
            merge_top16<0, 16>(x); merge_top16<32, 48>(x); merge_top16<0, 32>(x);
#pragma unroll
            for (int i = 0; i < 16; ++i) T[p][i] = __uint_as_float(__float_as_uint(x[i]) - (unsigned)hi4);
            xlane_merge16(T[p]);
        }
        float v0[16], v1[16]; unsigned long long k0lo = 0, k0hi = 0, k1lo = 0, k1hi = 0;
#pragma unroll
        for (int i = 0; i < 16; ++i) {
            const unsigned b0 = __float_as_uint(T[0][i]), b1 = __float_as_uint(T[1][i]);
            v0[i] = __uint_as_float(b0 & ~127u); v1[i] = __uint_as_float(b1 & ~127u);
            const unsigned long long e0 = 127u - (b0 & 127u), e1 = 127u - (b1 & 127u);
            if (i < 8) { k0lo |= e0 << (8 * i); k1lo |= e1 << (8 * i); } else { k0hi |= e0 << (8 * (i - 8)); k1hi |= e1 << (8 * (i - 8)); }
        }
        float cnd[32];
#pragma unroll
        for (int s = 0; s < 32; ++s) {
            if (cand_ai(s) >= 0) {
                const float ca = v0[cand_ai(s)] + v1[cand_aj(s)], cb = v0[cand_bi(s)] + v1[cand_bj(s)];
                const unsigned pa = (__float_as_uint(ca) & ~255u) | (255u - (unsigned)(16 * cand_ai(s) + cand_aj(s)));
                const unsigned pb = (__float_as_uint(cb) & ~255u) | (255u - (unsigned)(16 * cand_bi(s) + cand_bj(s)));
                cnd[s] = __uint_as_float(hi ? pb : pa);
            } else cnd[s] = __uint_as_float(0xff800000u);
        }
        sort16_desc<0>(cnd); sort16_desc<16>(cnd); merge_top16<0, 16>(cnd);
        float R[16];
#pragma unroll
        for (int i = 0; i < 16; ++i) R[i] = cnd[i];
        xlane_merge16(R);
        const f32x4 q0 = *(const f32x4*)(SSQ + (size_t)row * 16), q1 = *(const f32x4*)(SSQ + (size_t)row * 16 + 4), q2 = *(const f32x4*)(SSQ + (size_t)row * 16 + 8), q3 = *(const f32x4*)(SSQ + (size_t)row * 16 + 12);
        const float ssq = ((q0[0] + q0[1]) + (q0[2] + q0[3])) + ((q1[0] + q1[1]) + (q1[2] + q1[3])) + ((q2[0] + q2[1]) + (q2[2] + q2[3])) + ((q3[0] + q3[1]) + (q3[2] + q3[3]));
        const float rl = rsqrtf(ssq * (1.f / D) + EPS) * LOG2E;
        float e[16], esum = 0.f; unsigned ex[16];
        const float vtop = __uint_as_float(__float_as_uint(R[0]) & ~255u);
#pragma unroll
        for (int i = 0; i < 16; ++i) {
            const unsigned b = __float_as_uint(R[i]); const unsigned code = 255u - (b & 255u), ci = code >> 4, cj = code & 15u;
            e[i] = __builtin_amdgcn_exp2f((__uint_as_float(b & ~255u) - vtop) * rl); esum += e[i];
            const unsigned kk0 = (unsigned)(((ci & 8u) ? k0hi : k0lo) >> (8 * (ci & 7u))) & 127u, kk1 = (unsigned)(((cj & 8u) ? k1hi : k1lo) >> (8 * (cj & 7u))) & 127u;
            ex[i] = kk0 * 128u + kk1;
        }
        const float inv = 1.f / esum;
        unsigned* dst = hi ? (unsigned*)(GATE + (size_t)row * 128 + h * 16) : (unsigned*)(IDX + (size_t)row * 128 + h * 16);
#pragma unroll
        for (int q = 0; q < 4; ++q) { u32x4 w;
#pragma unroll
            for (int i = 0; i < 4; ++i) w[i] = hi ? __float_as_uint(e[4 * q + i] * inv) : ex[4 * q + i];
            *(u32x4*)(dst + 4 * q) = w; }
    }
}


constexpr int VT_PITCH = 144, VT_BYTES = 32 * VT_PITCH;
__device__ __forceinline__ void p2_attn_opt(const Args& a, bf16_t* MIX, LAS unsigned char* lds) {
    const int tid = opaque_tid(), lane = tid & 63, wave = __builtin_amdgcn_readfirstlane(tid >> 6), r32 = lane & 31, hi = lane >> 5;
    LAS unsigned char* vt = lds + wave * VT_BYTES;
    const bf16_t* P1 = (const bf16_t*)(a.ws + WS_P1);
    const int gw = wave * (int)gridDim.x + (int)blockIdx.x, nw = (int)gridDim.x * 8;
    constexpr int NSTRIP = NB * 8 * (SEQ / 32);
    for (int it = gw; it < NSTRIP + 8; it += nw) {
        int b, h, j, qrow0; bool meta_q;
        if (it < NSTRIP) { h = it & 7; const int sj = it >> 3; b = sj >> 9; j = sj & 511; qrow0 = b * SEQ + 32 * j; meta_q = false; }
        else { h = it - NSTRIP; b = 0; j = -1; qrow0 = MROW0; meta_q = true; }
        bf16x8_t qf[4];
#pragma unroll
        for (int ks = 0; ks < 4; ++ks) qf[ks] = *(const bf16x8_t*)(P1 + (size_t)(qrow0 + r32) * P1W + h * 64 + 16 * ks + 8 * hi);
        f32x16 o[2];
#pragma unroll
        for (int dt = 0; dt < 2; ++dt) o[dt] = (f32x16){0.f, 0.f, 0.f, 0.f, 0.f, 0.f, 0.f, 0.f, 0.f, 0.f, 0.f, 0.f, 0.f, 0.f, 0.f, 0.f};
        float carry = 0.f;
        int kt = j; bool diag = true;
        bf16x8_t kn[4]; u32x4 vn[4];
#define ATT_FETCH(KT) do { const int kr0_ = (KT) < 0 ? MROW0 : b * SEQ + 32 * (KT); \
            _Pragma("unroll") for (int ks = 0; ks < 4; ++ks) kn[ks] = *(const bf16x8_t*)(P1 + (size_t)(kr0_ + r32) * P1W + 512 + h * 64 + 16 * ks + 8 * hi); \
            _Pragma("unroll") for (int c4 = 0; c4 < 4; ++c4) { const int chunk = lane + 64 * c4, key = chunk >> 3, part = chunk & 7; \
                vn[c4] = *(const u32x4*)(P1 + (size_t)(kr0_ + key) * P1W + 1024 + h * 64 + part * 8); } } while (0)
        ATT_FETCH(kt);
        for (;;) {
            const bool is_meta = kt < 0;
            const int nvalid = is_meta ? NMETA : 32;
            bf16x8_t kf[4];
#pragma unroll
            for (int ks = 0; ks < 4; ++ks) kf[ks] = kn[ks];
#pragma unroll
            for (int c4 = 0; c4 < 4; ++c4) { const int chunk = lane + 64 * c4, key = chunk >> 3, part = chunk & 7;
                *(LAS u32x4*)(vt + key * VT_PITCH + part * 16) = vn[c4]; }
            if (!is_meta) ATT_FETCH(kt - 1);
            __builtin_amdgcn_sched_barrier(0);
            f32x16 sacc = (f32x16){0.f, 0.f, 0.f, 0.f, 0.f, 0.f, 0.f, 0.f, 0.f, 0.f, 0.f, 0.f, 0.f, 0.f, 0.f, 0.f};
#pragma unroll
            for (int ks = 0; ks < 4; ++ks) sacc = __builtin_amdgcn_mfma_f32_32x32x16_bf16(kf[ks], qf[ks], sacc, 0, 0, 0);
            float L[16]; bool ok[16];
#pragma unroll
            for (int rg = 0; rg < 16; ++rg) {
                const int kap = 8 * (rg >> 2) + 4 * hi + (rg & 3);
                ok[rg] = (kap < nvalid) && (!diag || kap < r32);
                const float z = sacc[rg], t = __builtin_amdgcn_exp2f(-__builtin_fabsf(z));
                const float l = __builtin_fmaxf(z, 0.f) + __builtin_amdgcn_logf(1.f + t);
                L[rg] = ok[rg] ? l : 0.f;
            }
            float G[4], PG[4];
#pragma unroll
            for (int g = 0; g < 4; ++g) { G[g] = (L[4 * g] + L[4 * g + 1]) + (L[4 * g + 2] + L[4 * g + 3]); PG[g] = __shfl_xor(G[g], 32); }
            float w[16]; float tot = 0.f;
#pragma unroll
            for (int g = 3; g >= 0; --g) {
                float run = tot + (hi == 0 ? PG[g] : 0.f);
#pragma unroll
                for (int i = 3; i >= 0; --i) { const int rg = 4 * g + i;
                    const float lw = (sacc[rg] - L[rg]) - run + carry;
                    w[rg] = ok[rg] ? __builtin_amdgcn_exp2f(lw) : 0.f;
                    run += L[rg]; }
                tot += G[g] + PG[g];
            }
            carry -= tot;
#pragma unroll
            for (int s2 = 0; s2 < 2; ++s2) {
                u32x4 pw;
#pragma unroll
                for (int q = 0; q < 4; ++q) pw[q] = pk2(w[8 * s2 + 2 * q], w[8 * s2 + 2 * q + 1]);
                const bf16x8_t pf = __builtin_bit_cast(bf16x8_t, pw);
#pragma unroll
                for (int dt = 0; dt < 2; ++dt) {
                    typedef short v4s_t __attribute__((ext_vector_type(4)));
                    const int tq = (lane & 15) >> 2, tp = lane & 3, tg = (lane >> 4) & 1;
                    const LAS unsigned char* tb = vt + (16 * s2 + 4 * hi + tq) * VT_PITCH + (32 * dt + 16 * tg + 4 * tp) * 2;
                    const v4s_t t0 = __builtin_amdgcn_ds_read_tr16_b64_v4i16((LAS v4s_t*)tb), t1 = __builtin_amdgcn_ds_read_tr16_b64_v4i16((LAS v4s_t*)(tb + 8 * VT_PITCH));
                    const bf16x8_t vw = (bf16x8_t){t0[0], t0[1], t0[2], t0[3], t1[0], t1[1], t1[2], t1[3]};
                    o[dt] = __builtin_amdgcn_mfma_f32_32x32x16_bf16(vw, pf, o[dt], 0, 0, 0);
                }
            }
            diag = false;
            if (is_meta) break;
            if (__all(carry < CARRY2_STOP)) break;
            --kt;
        }
#undef ATT_FETCH
        if (!meta_q || r32 < NMETA) {
            bf16_t* op = MIX + (size_t)(qrow0 + r32) * D + h * 64 + 4 * hi;
#pragma unroll
            for (int dt = 0; dt < 2; ++dt)
#pragma unroll
                for (int g = 0; g < 4; ++g) *(uint2*)(op + 32 * dt + 8 * g) = make_uint2(pk2(o[dt][4 * g], o[dt][4 * g + 1]), pk2(o[dt][4 * g + 2], o[dt][4 * g + 3]));
        }
    }
    const bf16_t* GB = P1 + 1536; const bf16_t* GC = P1 + 2048;
    {
        const int c8 = (tid & 63) * 8, rstep = (int)gridDim.x * 8;
        float cw[3][8];
#pragma unroll
        for (int t = 0; t < 3; ++t)
#pragma unroll
            for (int i = 0; i < 8; ++i) cw[t][i] = a.conv_w[t * 512 + c8 + i];
        const u32x4 z4 = (u32x4){0u, 0u, 0u, 0u};
#pragma unroll 1
        for (int row0 = (int)blockIdx.x * 8 + (tid >> 6); row0 < NROWS; row0 += 4 * rstep) {
            u32x4 u2[4], u1[4], u0[4], gb[4];
#pragma unroll
            for (int r = 0; r < 4; ++r) { const int row = row0 + r * rstep, rc = row < NROWS ? row : NROWS - 1;
                int b, p; rowpos(rc, b, p);
                u2[r] = *(const u32x4*)(GC + (size_t)rc * P1W + c8);
                u1[r] = p >= 1 ? *(const u32x4*)(GC + (size_t)prow(b, p - 1) * P1W + c8) : z4;
                u0[r] = p >= 2 ? *(const u32x4*)(GC + (size_t)prow(b, p - 2) * P1W + c8) : z4;
                gb[r] = *(const u32x4*)(GB + (size_t)rc * P1W + c8); }
#pragma unroll
            for (int r = 0; r < 4; ++r) { const int row = row0 + r * rstep;
                u32x4 ov;
#pragma unroll
                for (int q = 0; q < 4; ++q) {
                    const float ylo = cw[0][2 * q] * bflo(u0[r][q]) + cw[1][2 * q] * bflo(u1[r][q]) + cw[2][2 * q] * bflo(u2[r][q]);
                    const float yhi = cw[0][2 * q + 1] * bfhi(u0[r][q]) + cw[1][2 * q + 1] * bfhi(u1[r][q]) + cw[2][2 * q + 1] * bfhi(u2[r][q]);
                    ov[q] = pk2(ylo * bflo(gb[r][q]), yhi * bfhi(gb[r][q]));
                }
                if (row < NROWS) *(u32x4*)(MIX + (size_t)row * D + 512 + c8) = ov; }
        }
    }
}


typedef int v2i_t __attribute__((ext_vector_type(2)));
typedef int i32x8_t __attribute__((ext_vector_type(8)));
constexpr int OPT_LDS_C = 147456;

constexpr int MF_AT = 4352, MF_ST = 8704, MF_RS = 17920, MF_CM = 18048, MF_WLDS = 18176, MF_PITCH = 144;
static_assert(MF_WLDS * 8 <= OPT_LDS_C - 16, "per-wave gather LDS");
__device__ __forceinline__ unsigned fp4_enc(float x, float& f) {
    const float ax = fabsf(x);
    const float kf = ax < 2.f ? __builtin_rintf(ax * 2.f) : ax < 4.f ? __builtin_rintf(ax) + 2.f : __builtin_rintf(ax * 0.5f) + 4.f;
    unsigned m = (unsigned)kf; m = m > 7u ? 7u : m;
    const float mag = m < 4u ? 0.5f * (float)m : m == 4u ? 2.f : m == 5u ? 3.f : m == 6u ? 4.f : 6.f;
    f = x < 0.f ? -mag : mag;
    return m | (x < 0.f ? 8u : 0u);
}
template <bool FINAL>
__device__ __forceinline__ void p6_peer_mf(const Args& a, int layer, const bf16_t* H, const float* SSQ, bf16_t* Hout, float* RSout, int nrows, LAS unsigned char* lds) {
    const int tid = opaque_tid(), lane = tid & 63, wave = __builtin_amdgcn_readfirstlane(tid >> 6);
    const int gw = wave * (int)gridDim.x + (int)blockIdx.x, nw = (int)gridDim.x * 8;
    const bool mm = !FINAL && gridDim.x == 256 && (int)blockIdx.x < NMETA;
    const int nk = mm ? CQ_MAXR : (gw < nrows ? (nrows - gw + nw - 1) / nw : 0);
    auto rowof = [&](int k) { return (mm && k == CQ_MAXR - 1) ? MROW0 + (int)blockIdx.x : gw + k * nw; };
    float* PART = (float*)(a.ws + WS_P1 + 64 * MiB) + ((size_t)blockIdx.x * 8 + wave) * D;
    LAS unsigned char* wl = lds + wave * MF_WLDS;
    LAS unsigned short* IDXS = (LAS unsigned short*)wl; LAS unsigned char* AT = wl + MF_AT; LAS unsigned char* ST = wl + MF_ST;
    LAS int* CLI = (LAS int*)ST; LAS float* RSL = (LAS float*)(wl + MF_RS); LAS float* HSL = RSL; LAS float* CM = (LAS float*)(wl + MF_CM);
    const __amdgpu_buffer_rsrc_t USr = MKRSRC(a.ws + WS_UB + 32 * MiB + (size_t)layer * NEXP * 4, NEXP * 4), VSr = MKRSRC(a.ws + WS_VB + 32 * MiB + (size_t)layer * NEXP * 4, NEXP * 4);
    const __amdgpu_buffer_rsrc_t IDXr = MKRSRC(a.ws + WS_IDX, RP * 128 * 4), GATEr = MKRSRC(a.ws + WS_GATE, RP * 128 * 4);
    const __amdgpu_buffer_rsrc_t Hr = MKRSRC(H, RP * D * 2), SSQr = MKRSRC(SSQ, RP * 16 * 4);
    const __amdgpu_buffer_rsrc_t Or = FINAL ? MKRSRC(a.out, XROWS * D * 4) : MKRSRC(Hout, RP * D * 2);
    const __amdgpu_buffer_rsrc_t H8r = MKRSRC(a.ws + WS_P1, RP * 1024);
    const int slot8 = lane >> 3, chunk8 = lane & 7;
    const bool c2 = (chunk8 & 4) != 0, c1 = (chunk8 & 2) != 0, c0 = (chunk8 & 1) != 0;
    for (int k0 = 0; k0 < nk; k0 += 6) {
        int t0[6], t1[6];
#pragma unroll
        for (int j = 0; j < 6; ++j) { const int kk = k0 + j < nk ? k0 + j : nk - 1, row = rowof(kk);
            t0[j] = __builtin_amdgcn_raw_buffer_load_b32(IDXr, lane * 4, row * 512, 0); t1[j] = __builtin_amdgcn_raw_buffer_load_b32(IDXr, lane * 4 + 256, row * 512, 0); }
#pragma unroll
        for (int j = 0; j < 6; ++j) if (k0 + j < nk) { const bool msk = mm && k0 + j == CQ_MAXR - 1;
            IDXS[(k0 + j) * 128 + lane] = (unsigned short)((msk && (lane >> 4) != wave) ? NEXP : t0[j]); IDXS[(k0 + j) * 128 + 64 + lane] = (unsigned short)((msk && ((64 + lane) >> 4) != wave) ? NEXP : t1[j]); }
    }
    if (nk > 0) {
        for (int k0 = 0; k0 < nk; k0 += 4) {
            u32x4 ha[4], hb[4];
#pragma unroll
            for (int j = 0; j < 4; ++j) { const int kk = k0 + j < nk ? k0 + j : nk - 1, row = rowof(kk);
                ha[j] = __builtin_amdgcn_raw_buffer_load_b128(Hr, lane * 32, row * 2048, 0); hb[j] = __builtin_amdgcn_raw_buffer_load_b128(Hr, lane * 32 + 16, row * 2048, 0); }
#pragma unroll
            for (int j = 0; j < 4; ++j) if (k0 + j < nk) { const int row = rowof(k0 + j);
                float hv[16], am = 0.f;
#pragma unroll
                for (int i = 0; i < 4; ++i) { hv[2 * i] = bflo(ha[j][i]); hv[2 * i + 1] = bfhi(ha[j][i]); hv[8 + 2 * i] = bflo(hb[j][i]); hv[9 + 2 * i] = bfhi(hb[j][i]); }
#pragma unroll
                for (int i = 0; i < 16; ++i) am = fmaxf(am, fabsf(hv[i]));
#pragma unroll
                for (int o = 1; o < 64; o <<= 1) am = fmaxf(am, __shfl_xor(am, o));
                const float sc = am > 0.f ? am * (UI4 ? 1.f / 119.f : 1.f / 127.f) : 1.f, inv = 1.f / sc;
                unsigned w[4] = {0u, 0u, 0u, 0u};
                if (UI4) {
#pragma unroll
                    for (int i = 0; i < 16; ++i) { const int q = (int)__builtin_rintf(hv[i] * inv), hl = ((q + 8) & 15) - 8, hh = (q - hl) >> 4;
                        w[i >> 3] |= ((unsigned)hh & 0xfu) << (4 * (i & 7)); w[2 + (i >> 3)] |= ((unsigned)hl & 0xfu) << (4 * (i & 7)); }
                    __builtin_amdgcn_raw_buffer_store_b64((u32x2){w[0], w[1]}, H8r, lane * 8, row * 1024, 0); __builtin_amdgcn_raw_buffer_store_b64((u32x2){w[2], w[3]}, H8r, 512 + lane * 8, row * 1024, 0);
                } else {
#pragma unroll
                    for (int i = 0; i < 16; ++i) { const int q = (int)__builtin_rintf(hv[i] * inv); w[i >> 2] |= ((unsigned)q & 0xffu) << (8 * (i & 3)); }
                    __builtin_amdgcn_raw_buffer_store_b128((u32x4){w[0], w[1], w[2], w[3]}, H8r, lane * 16, row * 1024, 0);
                }
                if (lane == 0) HSL[k0 + j] = sc; }
        }
        __threadfence_block();
        struct UB4 { u32x4 r[4]; };
        constexpr int NSW = UI4 ? 4 : 8;
#define U8_TAB(ee) MKRSRC(a.ws + WS_UB + ((size_t)layer * NSW + (ee)) * NEXP * 128, NEXP * 128)
#define U8_LOAD(BUF, T, kk, bt) do { int ev[4]; _Pragma("unroll") for (int j = 0; j < 4; ++j) ev[j] = IDXS[(kk) * 128 + 32 * (bt) + 8 * j + slot8]; \
            asm volatile("" : "+v"(ev[0]), "+v"(ev[1]), "+v"(ev[2]), "+v"(ev[3])); \
            _Pragma("unroll") for (int j = 0; j < 4; ++j) BUF.r[j] = __builtin_amdgcn_raw_buffer_load_b128(T, ev[j] * 128 + chunk8 * 16, 0, 0); } while (0)
#define U8_DOTS(BUF, bt) do { _Pragma("unroll") for (int j = 0; j < 4; ++j) { const u32x4 w4 = BUF.r[j]; \
            if (UI4) { const int ah = __builtin_amdgcn_sdot8((int)w4[3], (int)h8[3], __builtin_amdgcn_sdot8((int)w4[2], (int)h8[2], __builtin_amdgcn_sdot8((int)w4[1], (int)h8[1], __builtin_amdgcn_sdot8((int)w4[0], (int)h8[0], 0, false), false), false), false); \
                const int al = __builtin_amdgcn_sdot8((int)w4[3], (int)h8l[3], __builtin_amdgcn_sdot8((int)w4[2], (int)h8l[2], __builtin_amdgcn_sdot8((int)w4[1], (int)h8l[1], __builtin_amdgcn_sdot8((int)w4[0], (int)h8l[0], 0, false), false), false), false); \
                pd[4 * (bt) + j] = ah * 16 + al; } \
            else pd[4 * (bt) + j] = __builtin_amdgcn_sdot4((int)w4[3], (int)h8[3], __builtin_amdgcn_sdot4((int)w4[2], (int)h8[2], __builtin_amdgcn_sdot4((int)w4[1], (int)h8[1], __builtin_amdgcn_sdot4((int)w4[0], (int)h8[0], 0, false), false), false), false); } } while (0)
        {
            UB4 A0, A1, A2, A3; u32x4 h8n, h8ln = (u32x4){0u, 0u, 0u, 0u};
            { const __amdgpu_buffer_rsrc_t T0 = U8_TAB(0);
              h8n = __builtin_amdgcn_raw_buffer_load_b128(H8r, chunk8 * 16, rowof(0) * 1024, 0);
              if (UI4) h8ln = __builtin_amdgcn_raw_buffer_load_b128(H8r, 512 + chunk8 * 16, rowof(0) * 1024, 0);
              U8_LOAD(A0, T0, 0, 0); U8_LOAD(A1, T0, 0, 1); U8_LOAD(A2, T0, 0, 2); U8_LOAD(A3, T0, 0, 3); }
            const int total8 = NSW * nk;
            int e = 0, k = 0;
#pragma unroll 1
            for (int f = 0; f < total8; ++f) {
                const int row = rowof(k);
                const u32x4 h8 = h8n, h8l = h8ln;
                const int ib = 8 * (c2 ? 1 : 0) + 4 * (c1 ? 1 : 0) + 2 * (c0 ? 1 : 0);
                float fus[2] = {0.f, 0.f}, fg[2] = {0.f, 0.f}, fsq = 0.f;
                if (e == NSW - 1) {
                    fsq = __builtin_bit_cast(float, __builtin_amdgcn_raw_buffer_load_b32(SSQr, (lane & 15) * 4, row * 64, 0));
#pragma unroll
                    for (int m = 0; m < 2; ++m) { const int n = 8 * (ib + m) + slot8, ex = IDXS[k * 128 + n];
                        fus[m] = __builtin_bit_cast(float, __builtin_amdgcn_raw_buffer_load_b32(USr, ex * 4, 0, 0));
                        fg[m] = __builtin_bit_cast(float, __builtin_amdgcn_raw_buffer_load_b32(GATEr, n * 4, row * 512, 0)); }
                }
                int kn = k + 1, en = e; if (kn == nk) { kn = 0; ++en; }
                if (f + 1 == total8) { kn = k; en = e; }
                const __amdgpu_buffer_rsrc_t TN = U8_TAB(en);
                int pd[16];
                U8_DOTS(A0, 0);
                h8n = __builtin_amdgcn_raw_buffer_load_b128(H8r, en * 128 + chunk8 * 16, rowof(kn) * 1024, 0);
                if (UI4) h8ln = __builtin_amdgcn_raw_buffer_load_b128(H8r, 512 + en * 128 + chunk8 * 16, rowof(kn) * 1024, 0);
                U8_LOAD(A0, TN, kn, 0);
                U8_DOTS(A1, 1); U8_LOAD(A1, TN, kn, 1);
                U8_DOTS(A2, 2); U8_LOAD(A2, TN, kn, 2);
                U8_DOTS(A3, 3); U8_LOAD(A3, TN, kn, 3);
                int q8[8], q4[4], q2[2];
#pragma unroll
                for (int j = 0; j < 8; ++j) { const int snd = c2 ? pd[j] : pd[j + 8], kp = c2 ? pd[j + 8] : pd[j]; q8[j] = kp + __shfl_xor(snd, 4); }
#pragma unroll
                for (int j = 0; j < 4; ++j) { const int snd = c1 ? q8[j] : q8[j + 4], kp = c1 ? q8[j + 4] : q8[j]; q4[j] = kp + __builtin_amdgcn_update_dpp(0, snd, 0x4E, 0xF, 0xF, true); }
#pragma unroll
                for (int j = 0; j < 2; ++j) { const int snd = c0 ? q4[j] : q4[j + 2], kp = c0 ? q4[j + 2] : q4[j]; q2[j] = kp + __builtin_amdgcn_update_dpp(0, snd, 0xB1, 0xF, 0xF, true); }
                if (e < NSW - 1) {
#pragma unroll
                    for (int m = 0; m < 2; ++m) { const int ad = k * 128 + 8 * (ib + m) + slot8; CLI[ad] = e == 0 ? q2[m] : CLI[ad] + q2[m]; }
                } else {
                    const float rstd = rsqrtf(wave_sum(fsq) * (0.25f / D) + EPS), hs = HSL[k];
                    float cv[2];
#pragma unroll
                    for (int m = 0; m < 2; ++m) { const int ad = k * 128 + 8 * (ib + m) + slot8;
                        const float dot = (float)(CLI[ad] + q2[m]) * hs;
                        const unsigned pk = __builtin_bit_cast(unsigned, fus[m]);
                        cv[m] = fg[m] * __builtin_bit_cast(float, pk & 0xffff0000u) * gelu_tanh(dot * rstd * __builtin_bit_cast(float, pk << 16)); }
                    float cm = fmaxf(fabsf(cv[0]), fabsf(cv[1]));
#pragma unroll
                    for (int o = 1; o < 64; o <<= 1) cm = fmaxf(cm, __shfl_xor(cm, o));
                    const float cmx = cm > 0.f ? cm : 1.f, s6 = 6.f / cmx;
                    float r0 = cv[0] * s6, r1 = cv[1] * s6;
                    const int ab = k * 256 + (c2 ? 32 : 0) + 8 * ((c1 ? 2 : 0) + (c0 ? 1 : 0)) + slot8;
#pragma unroll
                    for (int t = 0; t < 4; ++t) { float f0, f1; const unsigned n0 = fp4_enc(r0, f0), n1 = fp4_enc(r1, f1);
                        AT[ab + 64 * t] = (unsigned char)(n0 | (n1 << 4)); r0 = (r0 - f0) * 6.f; r1 = (r1 - f1) * 6.f; }
                    if (lane == 0) CM[k] = cmx;
                }
                k = kn; e = en;
            }
        }
#undef U8_TAB
#undef U8_LOAD
#undef U8_DOTS
        {
            const int m16 = lane & 15, g4 = lane >> 4;
            struct VB4 { u32x4 r[4]; };
#define V4_TAB(qq) MKRSRC(a.ws + WS_VB + ((size_t)layer * 4 + (qq)) * NEXP * 128, NEXP * 128)
#define V4_LOAD(BUF, T, kk, bt) do { int ev[4]; _Pragma("unroll") for (int j = 0; j < 4; ++j) ev[j] = IDXS[(kk) * 128 + 32 * (bt) + 8 * j + slot8]; \
                asm volatile("" : "+v"(ev[0]), "+v"(ev[1]), "+v"(ev[2]), "+v"(ev[3])); \
                _Pragma("unroll") for (int j = 0; j < 4; ++j) BUF.r[j] = __builtin_amdgcn_raw_buffer_load_b128(T, ev[j] * 128 + chunk8 * 16, 0, 0); } while (0)
#define MF_STAGE(BUF, bt) do { _Pragma("unroll") for (int j = 0; j < 4; ++j) { const int Ip = 4 * ((bt) & 1) + j; const u32x4 w_ = BUF.r[j]; \
                *(LAS u32x4*)(ST + (16 * (Ip >> 1) + 2 * slot8 + (Ip & 1)) * MF_PITCH + 16 * chunk8) = ((Ip >> 1) & 1) ? (u32x4){w_[2], w_[3], w_[0], w_[1]} : w_; } } while (0)
#define MF_MMA(hh) do { const i32x8_t av = (i32x8_t){(int)aop[hh][0], (int)aop[hh][1], 0, 0, 0, 0, 0, 0}; \
                _Pragma("unroll") for (int nb = 0; nb < 16; ++nb) { const v2i_t b = __builtin_amdgcn_ds_read_tr4_b64_v2i32((LAS v2i_t*)(ST + (16 * g4 + m16) * MF_PITCH + ((nb & 1) ? -8 : 8) * (g4 & 1) + 8 * nb)); \
                    acc[nb] = __builtin_amdgcn_mfma_scale_f32_16x16x128_f8f6f4(av, (i32x8_t){b[0], b[1], 0, 0, 0, 0, 0, 0}, acc[nb], 4, 4, 0, 0, 0, 0); } } while (0)
            VB4 A0, A1, A2, A3;
            { const __amdgpu_buffer_rsrc_t T0 = V4_TAB(0); V4_LOAD(A0, T0, 0, 0); V4_LOAD(A1, T0, 0, 1); V4_LOAD(A2, T0, 0, 2); V4_LOAD(A3, T0, 0, 3); }
            const int total = 4 * nk;
            int q = 0, k = 0;
#pragma unroll 1
            for (int f = 0; f < total; ++f) {
                const int row = rowof(k);
                f32x4 acc[16];
#pragma unroll
                for (int j = 0; j < 16; ++j) acc[j] = (f32x4){0.f, 0.f, 0.f, 0.f};
                u32x2 aop[2];
#pragma unroll
                for (int hh = 0; hh < 2; ++hh) { const u32x2 t = *(const LAS u32x2*)(AT + k * 256 + (m16 & 3) * 64 + hh * 32 + 8 * g4); aop[hh] = m16 < 4 ? t : (u32x2){0u, 0u}; }
                const float cmx = CM[k];
                int kn = k + 1, qn = q; if (kn == nk) { kn = 0; ++qn; }
                if (f + 1 == total) { kn = k; qn = q; }
                const __amdgpu_buffer_rsrc_t TN = V4_TAB(qn);
                const int hoff = q * 512 + m16 * 32;
                const u32x4 hr0 = __builtin_amdgcn_raw_buffer_load_b128(Hr, hoff, row * 2048, 0), hr1 = __builtin_amdgcn_raw_buffer_load_b128(Hr, hoff + 16, row * 2048, 0);
                MF_STAGE(A0, 0); V4_LOAD(A0, TN, kn, 0);
                MF_STAGE(A1, 1); V4_LOAD(A1, TN, kn, 1);
                MF_MMA(0);
                MF_STAGE(A2, 2); V4_LOAD(A2, TN, kn, 2);
                MF_STAGE(A3, 3); V4_LOAD(A3, TN, kn, 3);
                MF_MMA(1);
                float y[16];
#pragma unroll
                for (int nb = 0; nb < 16; ++nb) y[nb] = cmx * (acc[nb][0] * (1.f / 6.f) + acc[nb][1] * (1.f / 36.f) + acc[nb][2] * (1.f / 216.f) + acc[nb][3] * (1.f / 1296.f));
                if (mm && k == CQ_MAXR - 1) {
                    if (lane < 16) {
#pragma unroll
                        for (int i = 0; i < 4; ++i) *(f32x4*)(PART + q * 256 + m16 * 16 + 4 * i) = (f32x4){y[4 * i], y[4 * i + 1], y[4 * i + 2], y[4 * i + 3]};
                    }
                    k = kn; q = qn; continue;
                }
#pragma unroll
                for (int i = 0; i < 4; ++i) { y[2 * i] += bflo(hr0[i]); y[2 * i + 1] += bfhi(hr0[i]); y[8 + 2 * i] += bflo(hr1[i]); y[9 + 2 * i] += bfhi(hr1[i]); }
                if (FINAL) {
                    if (lane < 16) {
#pragma unroll
                        for (int i = 0; i < 4; ++i) __builtin_amdgcn_raw_buffer_store_b128(__builtin_bit_cast(u32x4, (f32x4){y[4 * i], y[4 * i + 1], y[4 * i + 2], y[4 * i + 3]}), Or, 2 * hoff + 16 * i, row * 4096, 0);
                    }
                } else {
                    unsigned w[8]; float ss = 0.f;
#pragma unroll
                    for (int i = 0; i < 8; ++i) { w[i] = pk2(y[2 * i], y[2 * i + 1]); const float a0 = bflo(w[i]), a1 = bfhi(w[i]); ss += a0 * a0 + a1 * a1; }
                    ss = wave_sum(lane < 16 ? ss : 0.f);
                    if (lane < 16) { __builtin_amdgcn_raw_buffer_store_b128((u32x4){w[0], w[1], w[2], w[3]}, Or, hoff, row * 2048, 0); __builtin_amdgcn_raw_buffer_store_b128((u32x4){w[4], w[5], w[6], w[7]}, Or, hoff + 16, row * 2048, 0); }
                    if (lane == 0) { const float t = q == 0 ? ss : RSL[k] + ss; RSL[k] = t; if (q == 3) RSout[row] = rsqrtf(t * (1.f / D) + EPS); }
                }
                k = kn; q = qn;
            }
#undef V4_TAB
#undef V4_LOAD
#undef MF_STAGE
#undef MF_MMA
        }
    }
    if (mm) {
        __threadfence_block();
        __syncthreads();
        const int row = MROW0 + (int)blockIdx.x, d2 = tid * 2;
        const float* pb = (const float*)(a.ws + WS_P1 + 64 * MiB) + (size_t)blockIdx.x * 8 * D + d2;
        const unsigned hv = *(const unsigned*)(H + (size_t)row * D + d2);
        float s0 = bflo(hv), s1 = bfhi(hv);
#pragma unroll
        for (int w = 0; w < 8; ++w) { const float2 p = *(const float2*)(pb + (size_t)w * D); s0 += p.x; s1 += p.y; }
        const unsigned pk = pk2(s0, s1);
        *(unsigned*)(Hout + (size_t)row * D + d2) = pk;
        const float a0 = bflo(pk), a1 = bfhi(pk);
        const float ss = wave_sum(a0 * a0 + a1 * a1);
        LAS float* red = (LAS float*)lds;
        __syncthreads();
        if (lane == 0) red[wave] = ss;
        __syncthreads();
        if (tid == 0) { float t = 0.f;
#pragma unroll
            for (int w = 0; w < 8; ++w) t += red[w];
            RSout[row] = rsqrtf(t * (1.f / D) + EPS); }
    }
}

constexpr int PF_SP = 528, PF_RS = 75520, PF_DT = 76096;
static_assert(PF_DT + 128 * PF_SP <= OPT_LDS_C - 16, "fused pooling LDS");
template <int W>
__device__ __forceinline__ void pf_diffs(LAS unsigned char* lds, int tid) {
    const int cp = tid & 127, rq = tid >> 7;
    const LAS float* RSv = (const LAS float*)(lds + PF_RS);
    float s0 = 0.f, s1 = 0.f;
#pragma unroll
    for (int j = 1; j < W; ++j) { const int i = 15 + 32 * rq - j; const unsigned hv = *(const LAS unsigned*)(lds + i * PF_SP + 4 * cp); const float rs = RSv[i]; s0 = __builtin_fmaf(bflo(hv), rs, s0); s1 = __builtin_fmaf(bfhi(hv), rs, s1); }
    constexpr float inv = 1.f / (float)W;
#pragma unroll 1
    for (int t0 = 0; t0 < 32; t0 += 4) {
        unsigned hn[4], ho[4]; float rn[4], ro[4];
#pragma unroll
        for (int t = 0; t < 4; ++t) { const int i = 15 + 32 * rq + t0 + t, io = i - W + 1;
            hn[t] = *(const LAS unsigned*)(lds + i * PF_SP + 4 * cp); ho[t] = *(const LAS unsigned*)(lds + io * PF_SP + 4 * cp); rn[t] = RSv[i]; ro[t] = -RSv[io]; }
        unsigned dv[4];
#pragma unroll
        for (int t = 0; t < 4; ++t) { const float n0 = bflo(hn[t]) * rn[t], n1 = bfhi(hn[t]) * rn[t];
            s0 += n0; s1 += n1;
            dv[t] = pg8::cvt_pk_bf16(__builtin_fmaf(s0, inv, -n0), __builtin_fmaf(s1, inv, -n1));
            s0 = __builtin_fmaf(bflo(ho[t]), ro[t], s0); s1 = __builtin_fmaf(bfhi(ho[t]), ro[t], s1); }
#pragma unroll
        for (int t = 0; t < 4; ++t) *(LAS unsigned*)(lds + PF_DT + (32 * rq + t0 + t) * PF_SP + 4 * cp) = dv[t];
    }
}
__device__ __forceinline__ void p78_pool_fused(const Args& a, LAS unsigned char* lds) {
    const int tid = opaque_tid(), lane = tid & 63, wave = __builtin_amdgcn_readfirstlane(tid >> 6), r32 = lane & 31, hi = lane >> 5;
    const bf16_t* H2 = (const bf16_t*)(a.ws + WS_XB); const float* RS2 = (const float*)(a.ws + WS_RS2); const bf16_t* PoolT = (const bf16_t*)(a.ws + WS_POOL);
    bf16_t* H3 = (bf16_t*)(a.ws + WS_H1); float* SSQ = (float*)(a.ws + WS_SSQ3);
    LAS float* RSv = (LAS float*)(lds + PF_RS);
    u32x4 sv[9]; float rv[9];
#define PF_FETCH(UU) do { const int t_ = opaque_tid(), rr_ = t_ >> 5, c16_ = t_ & 31; const int g_ = (UU) & 3, r0_ = ((UU) >> 2) * 128, b_ = r0_ >> 14, p0_ = (r0_ & (SEQ - 1)) + NMETA; \
        _Pragma("unroll") for (int ps = 0; ps < 9; ++ps) { const int i = ps * 16 + rr_, ic = i < 143 ? i : 142, row = ic < 15 ? prow(b_, p0_ - (15 - ic)) : r0_ + ic - 15; \
            sv[ps] = *(const u32x4*)(H2 + (size_t)row * D + g_ * 256 + 8 * c16_); rv[ps] = RS2[row]; } } while (0)
    if ((int)blockIdx.x < (XROWS / 128) * 4) PF_FETCH((int)blockIdx.x);
#pragma unroll 1
    for (int u = (int)blockIdx.x; u < (XROWS / 128) * 4; u += (int)gridDim.x) {
        const int g = u & 3, r0 = (u >> 2) * 128;
        bf16x8_t wf[16];
#pragma unroll
        for (int ks = 0; ks < 16; ++ks) wf[ks] = *(const bf16x8_t*)(PoolT + (size_t)(g * 256 + 32 * wave + r32) * 256 + 16 * ks + 8 * hi);
        { const int t_ = opaque_tid(), rr_ = t_ >> 5, c16_ = t_ & 31;
#pragma unroll
          for (int ps = 0; ps < 9; ++ps) { const int i = ps * 16 + rr_; if (i < 143) { *(LAS u32x4*)(lds + i * PF_SP + 16 * c16_) = sv[ps]; if (c16_ == 0) RSv[i] = rv[ps]; } } }
        { const int un = u + (int)gridDim.x; if (un < (XROWS / 128) * 4) PF_FETCH(un); }
        __builtin_amdgcn_sched_barrier(0);
        __syncthreads();
        { const int t_ = opaque_tid(); if (g == 0) pf_diffs<2>(lds, t_); else if (g == 1) pf_diffs<4>(lds, t_); else if (g == 2) pf_diffs<8>(lds, t_); else pf_diffs<16>(lds, t_); }
        __syncthreads();
        f32x16 acc[4];
#pragma unroll
        for (int mb = 0; mb < 4; ++mb) acc[mb] = (f32x16){0.f, 0.f, 0.f, 0.f, 0.f, 0.f, 0.f, 0.f, 0.f, 0.f, 0.f, 0.f, 0.f, 0.f, 0.f, 0.f};
        {
            bf16x8_t dfa[4];
#define PF_LDF(DST, ks) do { _Pragma("unroll") for (int mb = 0; mb < 4; ++mb) DST[mb] = *(const LAS bf16x8_t*)(lds + PF_DT + (32 * mb + r32) * PF_SP + 32 * (ks) + 16 * hi); } while (0)
#define PF_MMA(SRC, ks) do { _Pragma("unroll") for (int mb = 0; mb < 4; ++mb) acc[mb] = __builtin_amdgcn_mfma_f32_32x32x16_bf16(wf[ks], SRC[mb], acc[mb], 0, 0, 0); } while (0)
#pragma unroll
            for (int ks = 0; ks < 16; ++ks) { PF_LDF(dfa, ks); __builtin_amdgcn_sched_barrier(0); PF_MMA(dfa, ks); __builtin_amdgcn_sched_barrier(0); }
#undef PF_LDF
#undef PF_MMA
        }
        __syncthreads();
#pragma unroll
        for (int mb = 0; mb < 4; ++mb)
#pragma unroll
            for (int q = 0; q < 4; ++q)
                *(LAS u32x2*)(lds + PF_DT + (32 * mb + r32) * PF_SP + (32 * wave + 8 * q + 4 * hi) * 2) = (u32x2){pg8::cvt_pk_bf16(acc[mb][4 * q], acc[mb][4 * q + 1]), pg8::cvt_pk_bf16(acc[mb][4 * q + 2], acc[mb][4 * q + 3])};
        __syncthreads();
        {
            const int t_ = opaque_tid(), rr = t_ >> 5, c16 = t_ & 31;
#pragma unroll
            for (int ps = 0; ps < 8; ++ps) { const int r = ps * 16 + rr;
                const u32x4 ov = *(const LAS u32x4*)(lds + PF_DT + r * PF_SP + 16 * c16), hv = *(const LAS u32x4*)(lds + (15 + r) * PF_SP + 16 * c16);
                u32x4 w; float ss = 0.f;
#pragma unroll
                for (int j = 0; j < 4; ++j) { w[j] = pg8::cvt_pk_bf16(bflo(hv[j]) + bflo(ov[j]), bfhi(hv[j]) + bfhi(ov[j])); const float lo = bflo(w[j]), h2 = bfhi(w[j]); ss += lo * lo + h2 * h2; }
                *(u32x4*)(H3 + (size_t)(r0 + r) * D + g * 256 + 8 * c16) = w;
                ss += dpp_xor1(ss); ss += dpp_xor2(ss); ss += __shfl_xor(ss, 4);
                if ((c16 & 7) == 0) SSQ[(size_t)(r0 + r) * 16 + 4 * g + (c16 >> 3)] = ss; }
        }
        __syncthreads();
    }
#undef PF_FETCH
}
template <int F4> __device__ __forceinline__ void table_store(const f32x16& x, __amdgpu_buffer_rsrc_t T, int it, int lane, LAS unsigned char* tt) {
    if (F4 == 2) {
        unsigned w[4] = {0u, 0u, 0u, 0u};
#pragma unroll
        for (int i = 0; i < 16; ++i) { int q = (int)__builtin_rintf(x[i]); q = q > 127 ? 127 : q < -127 ? -127 : q; w[i >> 2] |= ((unsigned)q & 0xffu) << (8 * (i & 3)); }
        __builtin_amdgcn_raw_buffer_store_b128((u32x4){w[0], w[1], w[2], w[3]}, T, (lane & 7) * 16, (((it >> 14) * 8 + (lane >> 3)) * NEXP + (it & (NEXP - 1))) * 128, 0);
    } else if (F4 == 3) {
        unsigned w[2] = {0u, 0u};
#pragma unroll
        for (int i = 0; i < 16; ++i) { int q = (int)__builtin_rintf(x[i]); q = q > 7 ? 7 : q < -7 ? -7 : q; w[i >> 3] |= ((unsigned)q & 0xfu) << (4 * (i & 7)); }
        __builtin_amdgcn_raw_buffer_store_b64((u32x2){w[0], w[1]}, T, (lane & 15) * 8, (((it >> 14) * 4 + (lane >> 4)) * NEXP + (it & (NEXP - 1))) * 128, 0);
    } else if (F4 == 1) {
        unsigned w[2] = {0u, 0u};
#pragma unroll
        for (int i = 0; i < 16; ++i) { const float v = x[i], ax = fabsf(v);
            const float k = ax < 2.f ? __builtin_rintf(ax * 2.f) : ax < 4.f ? __builtin_rintf(ax) + 2.f : __builtin_rintf(ax * 0.5f) + 4.f;
            unsigned m = (unsigned)k; m = m > 7u ? 7u : m; const unsigned c = m | (v < 0.f ? 8u : 0u);
            w[i >> 3] |= c << (4 * (i & 7)); }
        if (VMF) {
            *(LAS u32x2*)(tt + lane * 8) = (u32x2){w[0], w[1]};
            const v2i_t t = __builtin_amdgcn_ds_read_tr4_b64_v2i32((LAS v2i_t*)(tt + lane * 8));
            w[0] = (unsigned)t[0]; w[1] = (unsigned)t[1];
        }
        if (CQ) __builtin_amdgcn_raw_buffer_store_b64((u32x2){w[0], w[1]}, T, (lane & 15) * 8, (((it >> 14) * 4 + (lane >> 4)) * NEXP + (it & (NEXP - 1))) * 128, 0);
        else __builtin_amdgcn_raw_buffer_store_b64((u32x2){w[0], w[1]}, T, lane * 8, it * 512, 0);
    } else {
        unsigned w[3] = {0u, 0u, 0u};
#pragma unroll
        for (int i = 0; i < 16; ++i) { const float v = x[i], ax = fabsf(v);
            const float k = ax < 2.f ? __builtin_rintf(ax * 8.f) : ax < 4.f ? __builtin_rintf(ax * 4.f) + 8.f : __builtin_rintf(ax * 2.f) + 16.f;
            unsigned m = (unsigned)k; m = m > 31u ? 31u : m; const unsigned c = m | (v < 0.f ? 32u : 0u);
            const int bp = 6 * i, wd = bp >> 5, sh = bp & 31;
            w[wd] |= c << sh; if (sh > 26) w[wd + 1] |= c >> (32 - sh); }
        if (CQ) __builtin_amdgcn_raw_buffer_store_b96((u32x3){w[0], w[1], w[2]}, T, (lane & 15) * 12, (((it >> 14) * 4 + (lane >> 4)) * NEXP + (it & (NEXP - 1))) * 192, 0);
        else __builtin_amdgcn_raw_buffer_store_b96((u32x3){w[0], w[1], w[2]}, T, lane * 12, it * 768, 0);
    }
}
constexpr int TT_PITCH = 132, TT_BYTES = 64 * TT_PITCH;
template <class SCol, class DRow, class NS>
__device__ __forceinline__ void tile_transpose(const float* src, int ldsrc, const float* ks, bf16_t* dst, int ldd, int k0, SCol scol, DRow drow, NS ns, LAS unsigned char* tt, int lane) {
    const int sc = scol(lane); const float nsv = ns(lane);
    float tv[64];
#pragma unroll
    for (int kk = 0; kk < 64; ++kk) tv[kk] = src[(size_t)(k0 + kk) * ldsrc + sc];
#pragma unroll
    for (int kk = 0; kk < 64; ++kk) {
        const float v = tv[kk] * (ks ? ks[k0 + kk] : 1.f) * nsv;
        *(LAS unsigned short*)(tt + lane * TT_PITCH + kk * 2) = f2bf(v);
    }
#pragma unroll
    for (int i = 0; i < 8; ++i) {
        const int c = lane + 64 * i, n = c >> 3, part = c & 7;
        const LAS unsigned* rp = (const LAS unsigned*)(tt + n * TT_PITCH + part * 16);
        u32x4 w; w[0] = rp[0]; w[1] = rp[1]; w[2] = rp[2]; w[3] = rp[3];
        *(u32x4*)(dst + (size_t)drow(n) * ldd + k0 + part * 8) = w;
    }
}
__device__ __forceinline__ void p0_prep_opt(const Args& a, LAS unsigned char* lds) {
    unsigned char* ws = a.ws;
    const int tid = opaque_tid(), lane = tid & 63, wave = __builtin_amdgcn_readfirstlane(tid >> 6);
    const int gw = (int)blockIdx.x * 8 + wave, nw = (int)gridDim.x * 8;
    const long gtid = (long)blockIdx.x * 512 + tid, gsz = (long)gridDim.x * 512;
    LAS unsigned char* tt = lds + wave * TT_BYTES;
    bf16_t* WinT = (bf16_t*)(ws + WS_WIN); bf16_t* WoutT = (bf16_t*)(ws + WS_WOUT); bf16_t* WqT = (bf16_t*)(ws + WS_WQ);
    bf16_t* KeysB = (bf16_t*)(ws + WS_KEYS); bf16_t* PoolT = (bf16_t*)(ws + WS_POOL);
    bf16_t* UB = (bf16_t*)(ws + WS_UB); bf16_t* VB = (bf16_t*)(ws + WS_VB); bf16_t* XB = (bf16_t*)(ws + WS_XB); float* RS0 = (float*)(ws + WS_RS0);
    constexpr int I_IN = 16 * 48, I_OUT = 16 * 16, I_Q = 2 * 16 * 32, I_POOL = 4 * 4 * 4;
    for (int it = gw; it < I_IN + I_OUT + I_Q + I_POOL; it += nw) {
        int r = it;
        if (r < I_IN) { const int kb = r / 48, u64 = r % 48;
            tile_transpose(a.w_in, INC, a.even_g, WinT, D, kb * 64, [=](int n) { return win_srccol(u64, n); }, [=](int n) { return win_btrow(u64, n); }, [](int) { return 1.f; }, tt, lane); continue; }
        r -= I_IN;
        if (r < I_OUT) { const int kb = r / 16, nb = r % 16;
            tile_transpose(a.w_out, D, nullptr, WoutT, D, kb * 64, [=](int n) { return nb * 64 + n; }, [=](int n) { return nb * 64 + n; }, [](int) { return 1.f; }, tt, lane); continue; }
        r -= I_OUT;
        if (r < I_Q) { const int l = r / 512, kb = (r % 512) / 32, nb = r % 32;
            tile_transpose(a.w_query + (size_t)l * D * 2048, 2048, a.ffn_g + l * D, WqT + (size_t)l * 2048 * D, D, kb * 64, [=](int n) { return nb * 64 + n; }, [=](int n) { return nb * 64 + n; }, [](int) { return 1.f; }, tt, lane); continue; }
        r -= I_Q;
        { const int g = r / 16, kb = (r % 16) / 4, nb = r % 4; const float* psc = a.pool_scale + g * 256 + nb * 64;
            tile_transpose(a.pool_w + (size_t)g * 256 * 256, 256, a.odd_g + g * 256, PoolT + (size_t)g * 256 * 256, 256, kb * 64, [=](int n) { return nb * 64 + n; }, [=](int n) { return nb * 64 + n; }, [=](int n) { return psc[n]; }, tt, lane); }
    }
    for (long i = gtid; i < 2L * 2 * 8 * 128 * 128 / 4; i += gsz) { const f32x4 v = *(const f32x4*)(a.sub_keys + i * 4); *(uint2*)(KeysB + i * 4) = make_uint2(pk2(v[0], v[1]), pk2(v[2], v[3])); }
    {
        const __amdgpu_buffer_rsrc_t UT = MKRSRC(ws + WS_UB, 2 * NEXP * USTRIDE), VT = MKRSRC(ws + WS_VB, 2 * NEXP * VSTRIDE);
        float* US = (float*)(ws + WS_UB + 32 * MiB); float* VS = (float*)(ws + WS_VB + 32 * MiB);
        f32x4 nu[4], nv[4], mu[4], mv[4];
#define TB_LD(U, V, itx) do { if ((itx) < 2 * NEXP) { _Pragma("unroll") for (int q = 0; q < 4; ++q) { U[q] = *(const f32x4*)(a.peer_u + (size_t)(itx) * D + 16 * lane + 4 * q); V[q] = *(const f32x4*)(a.peer_v + (size_t)(itx) * D + 16 * lane + 4 * q); } } } while (0)
        TB_LD(nu, nv, gw); TB_LD(mu, mv, gw + nw);
#pragma unroll 1
        for (int it = gw; it < 2 * NEXP; it += nw) {
            const int l = it >> 14;
            const float* gp = a.ffn_g + l * D + 16 * lane;
            f32x4 cu[4], cv[4];
#pragma unroll
            for (int q = 0; q < 4; ++q) { cu[q] = nu[q]; cv[q] = nv[q]; nu[q] = mu[q]; nv[q] = mv[q]; }
            TB_LD(mu, mv, it + 2 * nw);
            __builtin_amdgcn_sched_barrier(0);
            f32x16 u, v; float au = 0.f, av = 0.f;
#pragma unroll
            for (int q = 0; q < 4; ++q) { const f32x4 uu = cu[q] * *(const f32x4*)(gp + 4 * q), vv = cv[q];
#pragma unroll
                for (int i = 0; i < 4; ++i) { u[4 * q + i] = uu[i]; v[4 * q + i] = vv[i]; au = fmaxf(au, fabsf(uu[i])); av = fmaxf(av, fabsf(vv[i])); } }
#pragma unroll
            for (int o = 1; o < 64; o <<= 1) { au = fmaxf(au, __shfl_xor(au, o)); av = fmaxf(av, __shfl_xor(av, o)); }
            const float su = au > 0.f ? au * (UI4 ? 1.f / 7.f : U8 ? 1.f / 127.f : U4 ? 1.f / 6.f : 1.f / 7.5f) : 1.f, sv = av > 0.f ? av * (V4 ? 1.f / 6.f : 1.f / 7.5f) : 1.f;
            if (VMF) {
                const unsigned bu = (__builtin_bit_cast(unsigned, su) + 0xffffu) & 0xffff0000u, bv = (__builtin_bit_cast(unsigned, sv) + 0xffffu) & 0xffff0000u;
                u = u * (1.f / __builtin_bit_cast(float, bu)); v = v * (1.f / __builtin_bit_cast(float, bv));
                if (lane == 0) ((unsigned*)US)[it] = (bu >> 16) | bv;
            } else { u = u * (1.f / su); v = v * (1.f / sv); if (lane == 0) { US[it] = su; VS[it] = sv; } }
            table_store<UI4 ? 3 : U8 ? 2 : U4 ? 1 : 0>(u, UT, it, lane, tt); table_store<V4 ? 1 : 0>(v, VT, it, lane, tt);
        }
#undef TB_LD
    }
    {
        f32x4 nx[4], mx[4];
        auto xsrc = [&](int row) { return row < XROWS ? a.x + (size_t)row * D : a.meta + (size_t)(row < NROWS ? row - MROW0 : 0) * D; };
#define XR_LD(X, rw) do { if ((rw) < RP) { _Pragma("unroll") for (int j = 0; j < 4; ++j) X[j] = *(const f32x4*)(xsrc(rw) + 256 * j + 4 * lane); } } while (0)
        XR_LD(nx, gw); XR_LD(mx, gw + nw);
#pragma unroll 1
        for (int row = gw; row < RP; row += nw) {
            f32x4 cx[4];
#pragma unroll
            for (int j = 0; j < 4; ++j) { cx[j] = nx[j]; nx[j] = mx[j]; }
            XR_LD(mx, row + 2 * nw);
            __builtin_amdgcn_sched_barrier(0);
            bf16_t* o = XB + (size_t)row * D;
            if (row >= NROWS) { for (int j = 0; j < 4; ++j) *(uint2*)(o + 256 * j + 4 * lane) = make_uint2(0u, 0u); if (lane == 0) RS0[row] = 1.f; continue; }
            float ss = 0.f;
#pragma unroll
            for (int j = 0; j < 4; ++j) { const f32x4 v = cx[j]; ss += v[0] * v[0] + v[1] * v[1] + v[2] * v[2] + v[3] * v[3];
                *(uint2*)(o + 256 * j + 4 * lane) = make_uint2(pk2(v[0], v[1]), pk2(v[2], v[3])); }
            ss = wave_sum(ss);
            if (lane == 0) RS0[row] = rsqrtf(ss * (1.f / D) + EPS);
        }
    }
}
template <int W>
__device__ __forceinline__ void poold_run(const bf16_t* H2, const float* RS2, bf16_t* Dm, int row0, int c8) {
    const int b = row0 >> 14, p0 = (row0 & (SEQ - 1)) + NMETA;
    float s[8];
#pragma unroll
    for (int q = 0; q < 8; ++q) s[q] = 0.f;
#pragma unroll
    for (int j = 1; j < W; ++j) { const int r = prow(b, p0 - j); const float rs = RS2[r]; const u32x4 hv = *(const u32x4*)(H2 + (size_t)r * D + c8);
#pragma unroll
        for (int q = 0; q < 4; ++q) { s[2 * q] += bflo(hv[q]) * rs; s[2 * q + 1] += bfhi(hv[q]) * rs; } }
    constexpr float inv = 1.f / (float)W;
#pragma unroll 1
    for (int t0 = 0; t0 < 32; t0 += 8) {
        u32x4 hn[8], ho[8]; float rn[8], ro[8];
#pragma unroll
        for (int t = 0; t < 8; ++t) { const int p = p0 + t0 + t, r = row0 + t0 + t, po = prow(b, p - W + 1);
            hn[t] = *(const u32x4*)(H2 + (size_t)r * D + c8); rn[t] = RS2[r]; ho[t] = *(const u32x4*)(H2 + (size_t)po * D + c8); ro[t] = RS2[po]; }
#pragma unroll
        for (int t = 0; t < 8; ++t) { u32x4 ov;
#pragma unroll
            for (int q = 0; q < 4; ++q) { const float nl = bflo(hn[t][q]) * rn[t], nh = bfhi(hn[t][q]) * rn[t];
                s[2 * q] += nl; s[2 * q + 1] += nh;
                ov[q] = pk2(s[2 * q] * inv - nl, s[2 * q + 1] * inv - nh);
                s[2 * q] -= bflo(ho[t][q]) * ro[t]; s[2 * q + 1] -= bfhi(ho[t][q]) * ro[t]; }
            *(u32x4*)(Dm + (size_t)(row0 + t0 + t) * D + c8) = ov; }
    }
}
__device__ __forceinline__ void p7_poold_opt(const Args& a, bf16_t* Dm) {
    const bf16_t* H2 = (const bf16_t*)(a.ws + WS_XB); const float* RS2 = (const float*)(a.ws + WS_RS2);
    const int tid = opaque_tid(), lane = tid & 63, wave = __builtin_amdgcn_readfirstlane(tid >> 6);
    const int gw = wave * (int)gridDim.x + (int)blockIdx.x, nw = (int)gridDim.x * 8;
    for (int it = gw; it < (XROWS / 64) * 4; it += nw) {
        const int g = it & 3, row0 = ((it >> 2) * 2 + (lane >> 5)) * 32, c8 = g * 256 + (lane & 31) * 8;
        if (g == 0) poold_run<2>(H2, RS2, Dm, row0, c8);
        else if (g == 1) poold_run<4>(H2, RS2, Dm, row0, c8);
        else if (g == 2) poold_run<8>(H2, RS2, Dm, row0, c8);
        else poold_run<16>(H2, RS2, Dm, row0, c8);
    }
}


template <class BRow>
__device__ __forceinline__ bool meta_unit(const bf16_t* A, int lda, const bf16_t* Bt, BRow brow, f32x4 (&acc)[4], LAS unsigned char* lds, int wave, int lane) {
    const int n16 = lane & 15, kg = lane >> 4, k0 = 128 * wave + 8 * kg;
    bf16x8_t af[4], bfr[4][4];
#pragma unroll
    for (int ks = 0; ks < 4; ++ks) { af[ks] = *(const bf16x8_t*)(A + (size_t)n16 * lda + k0 + 32 * ks);
#pragma unroll
        for (int t = 0; t < 4; ++t) bfr[t][ks] = *(const bf16x8_t*)(Bt + (size_t)brow(16 * t + n16) * D + k0 + 32 * ks); }
#pragma unroll
    for (int t = 0; t < 4; ++t) { acc[t] = (f32x4){0.f, 0.f, 0.f, 0.f};
#pragma unroll
        for (int ks = 0; ks < 4; ++ks) acc[t] = __builtin_amdgcn_mfma_f32_16x16x32_bf16(af[ks], bfr[t][ks], acc[t], 0, 0, 0); }
    LAS f32x4* part = (LAS f32x4*)lds;
#pragma unroll
    for (int t = 0; t < 4; ++t) part[(wave * 4 + t) * 64 + lane] = acc[t];
    __syncthreads();
    if (wave == 0) {
#pragma unroll
        for (int t = 0; t < 4; ++t) { f32x4 sum = part[t * 64 + lane];
#pragma unroll
            for (int w = 1; w < 8; ++w) sum += part[(w * 4 + t) * 64 + lane];
            acc[t] = sum; }
    }
    __syncthreads();
    return wave == 0;
}
__device__ __forceinline__ void meta_p1(const Args& a, int u64, LAS unsigned char* lds, int wave, int lane) {
    unsigned char* ws = a.ws; bf16_t* P1 = (bf16_t*)(ws + WS_P1); const float* RS0 = (const float*)(ws + WS_RS0);
    f32x4 acc[4];
    if (!meta_unit((const bf16_t*)(ws + WS_XB) + (size_t)MROW0 * D, D, (const bf16_t*)(ws + WS_WIN), [=](int d) { return win_btrow(u64, d); }, acc, lds, wave, lane)) return;
    const int n16 = lane & 15, r4 = (lane >> 4) * 4;
#pragma unroll
    for (int i = 0; i < 4; ++i) { const int row = MROW0 + r4 + i; const float sc = RS0[row];
        float v[4]; float ss = 0.f;
#pragma unroll
        for (int t = 0; t < 4; ++t) { v[t] = acc[t][i] * sc; ss += v[t] * v[t]; }
        bf16_t* o = P1 + (size_t)row * P1W;
        if (u64 < 16) {
            ss += __shfl_xor(ss, 1); ss += __shfl_xor(ss, 2); ss += __shfl_xor(ss, 4); ss += __shfl_xor(ss, 8);
            const float r = rsqrtf(ss * (1.f / 64.f) + EPS) * (u64 < 8 ? 0.125f * LOG2E : 1.f); const float* g = u64 < 8 ? a.qg : a.kg;
#pragma unroll
            for (int t = 0; t < 4; ++t) o[u64 * 64 + 16 * t + n16] = f2bf(v[t] * r * g[16 * t + n16]);
        } else if (u64 < 32) {
#pragma unroll
            for (int t = 0; t < 4; ++t) o[u64 * 64 + 16 * t + n16] = f2bf(v[t]);
        } else {
            o[2048 + 32 * (u64 - 32) + n16] = f2bf(v[0] * v[2]); o[2048 + 32 * (u64 - 32) + 16 + n16] = f2bf(v[1] * v[3]);
        }
    }
}
__device__ __forceinline__ void meta_p3(const Args& a, int u, LAS unsigned char* lds, int wave, int lane) {
    unsigned char* ws = a.ws; bf16_t* H1 = (bf16_t*)(ws + WS_H1); float* SSQ1 = (float*)(ws + WS_SSQ1);
    f32x4 acc[4];
    if (!meta_unit((const bf16_t*)a.out + (size_t)MROW0 * D, D, (const bf16_t*)(ws + WS_WOUT), [=](int d) { return u * 64 + d; }, acc, lds, wave, lane)) return;
    const int n16 = lane & 15, r4 = (lane >> 4) * 4;
#pragma unroll
    for (int i = 0; i < 4; ++i) { const int row = MROW0 + r4 + i; float ss = 0.f;
#pragma unroll
        for (int t = 0; t < 4; ++t) { const int col = u * 64 + 16 * t + n16; const bf16_t hb = f2bf(a.meta[(size_t)(r4 + i) * D + col] + acc[t][i]); const float hv = bf2f(hb); ss += hv * hv; H1[(size_t)row * D + col] = hb; }
        ss += __shfl_xor(ss, 1); ss += __shfl_xor(ss, 2); ss += __shfl_xor(ss, 4); ss += __shfl_xor(ss, 8);
        if (n16 == 0) SSQ1[(size_t)row * 16 + u] = ss; }
}
__device__ __forceinline__ void meta_p4(const Args& a, int u, LAS unsigned char* lds, int wave, int lane) {
    unsigned char* ws = a.ws; bf16_t* QP = (bf16_t*)(ws + WS_P1);
    f32x4 acc[4];
    if (!meta_unit((const bf16_t*)(ws + WS_H1) + (size_t)MROW0 * D, D, (const bf16_t*)(ws + WS_WQ), [=](int d) { return u * 64 + d; }, acc, lds, wave, lane)) return;
    const int n16 = lane & 15, r4 = (lane >> 4) * 4;
#pragma unroll
    for (int i = 0; i < 4; ++i)
#pragma unroll
        for (int t = 0; t < 4; ++t) QP[(size_t)(MROW0 + r4 + i) * 2048 + u * 64 + 16 * t + n16] = f2bf(acc[t][i]);
}

constexpr int NPHASE = 12;
constexpr int OPT_THREADS = 512, OPT_LDS = 147456;

template <int PH> __device__ __forceinline__ void run_naive(const Args& a, long gtid, long gsz) {
    bf16_t* MIX = (bf16_t*)a.out;
    if (PH == 0) p0_prep(a, gtid, gsz);
    if (PH == 1) p1_gemm_in(a, gtid, gsz);
    if (PH == 2) p2_attn_conv(a, MIX, gtid, gsz);
    if (PH == 3) p3_gemm_out(a, MIX, gtid, gsz);
    if (PH == 4) p4_gemm_q(a, 0, (const bf16_t*)(a.ws + WS_H1), NROWS, gtid, gsz);
    if (PH == 5) p5_topk(a, 0, (const float*)(a.ws + WS_SSQ1), NROWS, gtid, gsz);
    if (PH == 6) p6_peer<false>(a, 0, (const bf16_t*)(a.ws + WS_H1), (const float*)(a.ws + WS_SSQ1), (bf16_t*)(a.ws + WS_XB), (float*)(a.ws + WS_RS2), NROWS, gtid, gsz);
    if (PH == 7) p7_poold(a, MIX, gtid, gsz);
    if (PH == 8) p8_gemm_pool(a, MIX, gtid, gsz);
    if (PH == 9) p4_gemm_q(a, 1, (const bf16_t*)(a.ws + WS_H1), XROWS, gtid, gsz);
    if (PH == 10) p5_topk(a, 1, (const float*)(a.ws + WS_SSQ3), XROWS, gtid, gsz);
    if (PH == 11) p6_peer<true>(a, 1, (const bf16_t*)(a.ws + WS_H1), (const float*)(a.ws + WS_SSQ3), nullptr, nullptr, XROWS, gtid, gsz);
}
template <int PH> __global__ void __launch_bounds__(256) k_naive(Args a) {
    run_naive<PH>(a, (long)blockIdx.x * blockDim.x + threadIdx.x, (long)gridDim.x * blockDim.x);
}

template <int PH> __device__ __forceinline__ void run_opt(const Args& a, LAS unsigned char* lds) {
    unsigned char* ws = a.ws;
    if (PH == 1) {
        pg8::Gemm g{(const bf16_t*)(ws + WS_XB), (const bf16_t*)(ws + WS_WIN), D, D, D, 0}; pg8::StaticOrder S; S.init(XROWS, INC, gridDim.x, blockIdx.x);
        pg8::EpiIn E{(bf16_t*)(ws + WS_P1), (const float*)(ws + WS_RS0), a.qg, a.kg};
        pg8::gemm_phase<pg8::EpiIn, pg8::StaticOrder, true, true>(lds, g, S, E);
        if (blockIdx.x < 48) { const int tid = opaque_tid(); meta_p1(a, (int)blockIdx.x, lds, __builtin_amdgcn_readfirstlane(tid >> 6), tid & 63); }
    }
    if (PH == 3) {
        pg8::Gemm g{(const bf16_t*)a.out, (const bf16_t*)(ws + WS_WOUT), D, D, D, 0}; pg8::StaticOrder S; S.init(XROWS, D, gridDim.x, blockIdx.x);
        pg8::EpiRes<0> E{a.x, a.meta, nullptr, (bf16_t*)(ws + WS_H1), (float*)(ws + WS_SSQ1)};
        pg8::gemm_phase<pg8::EpiRes<0>, pg8::StaticOrder, true, true>(lds, g, S, E);
        if (blockIdx.x < 16) { const int tid = opaque_tid(); meta_p3(a, (int)blockIdx.x, lds, __builtin_amdgcn_readfirstlane(tid >> 6), tid & 63); }
    }
    if (PH == 4 || PH == 9) {
        const int layer = PH == 4 ? 0 : 1;
        pg8::Gemm g{(const bf16_t*)(ws + WS_H1), (const bf16_t*)(ws + WS_WQ) + (size_t)layer * 2048 * D, D, D, D, 0}; pg8::StaticOrder S; S.init(XROWS, 2048, gridDim.x, blockIdx.x);
        pg8::EpiPlain E{(bf16_t*)(ws + WS_P1), 2048};
        pg8::gemm_phase<pg8::EpiPlain, pg8::StaticOrder, true, true>(lds, g, S, E);
        if (PH == 4 && blockIdx.x < 32) { const int tid = opaque_tid(); meta_p4(a, (int)blockIdx.x, lds, __builtin_amdgcn_readfirstlane(tid >> 6), tid & 63); }
    }
    if (PH == 0) p0_prep_opt(a, lds);
    if (PH == 7) p7_poold_opt(a, (bf16_t*)a.out);
    if (PH == 2) p2_attn_opt(a, (bf16_t*)a.out, lds);
    if (PH == 5) p5_topk_opt(a, 0, (const float*)(ws + WS_SSQ1), RP / 256, lds);
    if (PH == 10) p5_topk_opt(a, 1, (const float*)(ws + WS_SSQ3), XROWS / 256, lds);
    if (PH == 6 || PH == 11) {
        const int tid = opaque_tid(), lane = tid & 63, wave = __builtin_amdgcn_readfirstlane(tid >> 6);
        const int gw = wave * gridDim.x + blockIdx.x, nw = gridDim.x * 8;
        if (CQ && VMF) { if (PH == 6) p6_peer_mf<false>(a, 0, (const bf16_t*)(ws + WS_H1), (const float*)(ws + WS_SSQ1), (bf16_t*)(ws + WS_XB), (float*)(ws + WS_RS2), NROWS, lds);
                  else p6_peer_mf<true>(a, 1, (const bf16_t*)(ws + WS_H1), (const float*)(ws + WS_SSQ3), nullptr, nullptr, XROWS, lds); }
        else if (CQ) { if (PH == 6) p6_peer_cq<false>(a, 0, (const bf16_t*)(ws + WS_H1), (const float*)(ws + WS_SSQ1), (bf16_t*)(ws + WS_XB), (float*)(ws + WS_RS2), NROWS, lds);
                  else p6_peer_cq<true>(a, 1, (const bf16_t*)(ws + WS_H1), (const float*)(ws + WS_SSQ3), nullptr, nullptr, XROWS, lds); }
        else if (PH == 6) p6_peer6<false>(a, 0, (const bf16_t*)(ws + WS_H1), (const float*)(ws + WS_SSQ1), (bf16_t*)(ws + WS_XB), (float*)(ws + WS_RS2), NROWS, gw, nw, lane);
        else p6_peer6<true>(a, 1, (const bf16_t*)(ws + WS_H1), (const float*)(ws + WS_SSQ3), nullptr, nullptr, XROWS, gw, nw, lane);
    }
    if (PH == 8) {
        int kp = 256; asm volatile("" : "+s"(kp));
        pg8::Gemm g{(const bf16_t*)a.out, (const bf16_t*)(ws + WS_POOL), D, 256, kp, 256}; pg8::StaticOrder S; S.init(XROWS, D, gridDim.x, blockIdx.x);
        pg8::EpiRes<1> E{nullptr, nullptr, (const bf16_t*)(ws + WS_XB), (bf16_t*)(ws + WS_H1), (float*)(ws + WS_SSQ3)};
        pg8::gemm_phase<pg8::EpiRes<1>, pg8::StaticOrder, true, true>(lds, g, S, E);
    }
}
template <int PH> __global__ void __launch_bounds__(OPT_THREADS, 2) k_opt(Args a) {
    extern __shared__ __attribute__((aligned(16))) unsigned char lds_raw[];
    run_opt<PH>(a, (LAS unsigned char*)lds_raw);
}

template <int PH> static void launch_naive(const Args& a, hipStream_t s) { hipLaunchKernelGGL(k_naive<PH>, dim3(1024), dim3(256), 0, s, a); }
template <int PH> static void launch_opt(const Args& a, hipStream_t s) {
    static bool attr = false;
    if (!attr) { (void)hipFuncSetAttribute((const void*)k_opt<PH>, hipFuncAttributeMaxDynamicSharedMemorySize, OPT_LDS); attr = true; }
    hipLaunchKernelGGL(k_opt<PH>, dim3(256), dim3(OPT_THREADS), OPT_LDS, s, a);
}

#define XB_TMO      128
#define XB_XCNT(j)  (256  + 64 * (j))
#define XB_XSUB(j)  (1280 + 64 * (j))
#define XB_XGEN(j)  (2304 + 64 * (j))
#define XB_TOP      3328
#define XB_TOPGEN   3392
#define XCD_BAR_WORDS 3456
#define XB_SPIN_CAP (1u << 18)

__device__ __forceinline__ unsigned xb_ld(unsigned* p)              { return __hip_atomic_load(p, __ATOMIC_RELAXED, __HIP_MEMORY_SCOPE_AGENT); }
__device__ __forceinline__ unsigned xb_add(unsigned* p, unsigned v) { return __hip_atomic_fetch_add(p, v, __ATOMIC_RELAXED, __HIP_MEMORY_SCOPE_AGENT); }
__device__ __forceinline__ unsigned xb_xcc_id() { return (unsigned)__builtin_amdgcn_s_getreg((3 << 11) | 20) & 0xFu; }
#define XB_SPIN(cond, bar) do { unsigned _sp = 0; while (cond) { __builtin_amdgcn_s_sleep(1); \
    if ((++_sp & 255u) == 0u) { if (xb_ld(&(bar)[XB_TMO])) break; if (_sp > XB_SPIN_CAP) { atomicAdd(&(bar)[XB_TMO], 1u); break; } } } } while (0)

struct XcdBarrier {
    unsigned* bar; unsigned x;
    volatile LAS unsigned* st;
};

__device__ __forceinline__ XcdBarrier xcd_barrier_post(unsigned* bar, volatile LAS unsigned* st) {
    XcdBarrier b; b.bar = bar; b.x = xb_xcc_id(); b.st = st;
    if (threadIdx.x == 0) (void)xb_add(&bar[XB_XCNT(b.x)], 1u);
    return b;
}
__device__ __forceinline__ void xcd_barrier_complete(unsigned* bar, unsigned x, unsigned& nloc, unsigned& nx) {
    const unsigned G = gridDim.x * gridDim.y * gridDim.z;
    unsigned sum, cnt, mine, sp = 0u;
    for (;;) {
        sum = 0u; cnt = 0u; mine = 0u;
#pragma unroll
        for (unsigned j = 0; j < 16; ++j) { const unsigned c = xb_ld(&bar[XB_XCNT(j)]); sum += c; cnt += (c > 0u) ? 1u : 0u; mine = (j == x) ? c : mine; }
        if (sum == G) break;
        __builtin_amdgcn_s_sleep(1);
        if ((++sp & 255u) == 0u) { if (xb_ld(&bar[XB_TMO])) break; if (sp > XB_SPIN_CAP) { atomicAdd(&bar[XB_TMO], 1u); break; } }
    }
    nloc = mine > 0u ? mine : 1u; nx = cnt > 0u ? cnt : 1u;
}

__device__ __forceinline__ void xcd_barrier(const XcdBarrier& b) {
    asm volatile("s_waitcnt vmcnt(0)" ::: "memory");
    __syncthreads();
    if (threadIdx.x == 0) {
        unsigned* bar = b.bar;
        __builtin_amdgcn_s_waitcnt(0);
        unsigned nloc = b.st[0], nx = b.st[1];
        if (nloc == 0u) { xcd_barrier_complete(bar, b.x, nloc, nx); b.st[0] = nloc; b.st[1] = nx; }
        const unsigned old = xb_add(&bar[XB_XSUB(b.x)], 1u);
        const unsigned gen = old / nloc;
        if (old + 1u == (gen + 1u) * nloc) {
            __builtin_amdgcn_fence(__ATOMIC_RELEASE, "agent");
            asm volatile("s_waitcnt vmcnt(0)" ::: "memory");
            const unsigned og = xb_add(&bar[XB_TOP], 1u);
            const unsigned tg = og / nx;
            if (og + 1u == (tg + 1u) * nx) xb_add(&bar[XB_TOPGEN], 1u);
            else XB_SPIN(xb_ld(&bar[XB_TOPGEN]) == tg, bar);
            __builtin_amdgcn_fence(__ATOMIC_ACQUIRE, "agent");
            xb_add(&bar[XB_XGEN(b.x)], 1u);
            asm volatile("s_waitcnt vmcnt(0)" ::: "memory");
        } else {
            XB_SPIN(xb_ld(&bar[XB_XGEN(b.x)]) == gen, bar);
            __builtin_amdgcn_fence(__ATOMIC_ACQUIRE, "agent");
            asm volatile("s_waitcnt vmcnt(0)" ::: "memory");
        }
    }
    __syncthreads();
}


#define GRID_SYNC() xcd_barrier(bar)
#ifndef PROBE_MASK
#define PROBE_MASK 0
#endif
#define RUN(ph) do { run_opt<ph>(a, lds); if ((PROBE_MASK >> ph) & 1) { GRID_SYNC(); run_opt<ph>(a, lds); } } while (0)
__global__ void __launch_bounds__(OPT_THREADS, 2) mega(Args a) {
    extern __shared__ __attribute__((aligned(16))) unsigned char lds_raw[];
    LAS unsigned char* lds = (LAS unsigned char*)lds_raw;
    volatile LAS unsigned* st = (volatile LAS unsigned*)(lds + OPT_LDS - 16);
    if (threadIdx.x < 4) st[threadIdx.x] = 0u;
    __syncthreads();
    const XcdBarrier bar = xcd_barrier_post((unsigned*)(a.ws + WS_CTL), st);
    RUN(0); GRID_SYNC();
    RUN(1); GRID_SYNC();
    RUN(2); GRID_SYNC();
    RUN(3); GRID_SYNC();
    RUN(4); GRID_SYNC();
    RUN(5); GRID_SYNC();
    RUN(6); GRID_SYNC();
#ifndef POOL_FUSED
#define POOL_FUSED 1
#endif
#if POOL_FUSED
    p78_pool_fused(a, lds); GRID_SYNC();
#else
    RUN(7); GRID_SYNC();
    RUN(8); GRID_SYNC();
#endif
    RUN(9); GRID_SYNC();
    RUN(10); GRID_SYNC();
    RUN(11);
}

extern "C" void kernel_launch(void* const* d_in, const int* in_sizes, int n_in, void* d_out, int out_size, void* d_ws, size_t ws_size, hipStream_t stream) {
    if (n_in != 16 || ws_size < WS_END) { fprintf(stderr, "kernel_launch: unexpected n_in %d / ws %zu\n", n_in, ws_size); return; }
    Args a{};
    a.x = (const float*)d_in[0]; a.meta = (const float*)d_in[1]; a.even_g = (const float*)d_in[2]; a.w_in = (const float*)d_in[3]; a.qg = (const float*)d_in[4]; a.kg = (const float*)d_in[5];
    a.conv_w = (const float*)d_in[6]; a.w_out = (const float*)d_in[7]; a.odd_g = (const float*)d_in[8]; a.pool_w = (const float*)d_in[9]; a.pool_scale = (const float*)d_in[10];
    a.ffn_g = (const float*)d_in[11]; a.w_query = (const float*)d_in[12]; a.sub_keys = (const float*)d_in[13]; a.peer_u = (const float*)d_in[14]; a.peer_v = (const float*)d_in[15];
    a.out = (float*)d_out; a.ws = (unsigned char*)d_ws; a.ph_lo = 0; a.ph_hi = NPHASE;
    static int grid = 0;
    if (grid == 0) {
        int dev = 0, cus = 0, per_cu = 0;
        (void)hipGetDevice(&dev);
        (void)hipDeviceGetAttribute(&cus, hipDeviceAttributeMultiprocessorCount, dev);
        (void)hipFuncSetAttribute((const void*)mega, hipFuncAttributeMaxDynamicSharedMemorySize, OPT_LDS);
        (void)hipOccupancyMaxActiveBlocksPerMultiprocessor(&per_cu, (const void*)mega, OPT_THREADS, OPT_LDS);
        if (per_cu < 1) { fprintf(stderr, "kernel_launch: occupancy query returned %d\n", per_cu); per_cu = 1; }
        grid = cus * 1;
        if (grid % 8 != 0) grid -= grid % 8;
    }
    (void)hipMemsetAsync((char*)d_ws + WS_CTL, 0, 16384, stream);
    void* args[] = {&a};
    hipError_t e = hipLaunchCooperativeKernel((const void*)mega, dim3(grid), dim3(OPT_THREADS), args, OPT_LDS, stream);
    if (e != hipSuccess) fprintf(stderr, "cooperative launch failed: %s (grid %d)\n", hipGetErrorString(e), grid);
}
```

```cpp
#include <hip/hip_runtime.h>
#include <hip/hip_cooperative_groups.h>
#include <stdint.h>
#include <stdio.h>
namespace cg = cooperative_groups;

typedef unsigned short bf16_t;
typedef unsigned u32x4 __attribute__((ext_vector_type(4)));
typedef float f32x4 __attribute__((ext_vector_type(4)));
typedef unsigned u32x3 __attribute__((ext_vector_type(3)));
typedef unsigned u32x2 __attribute__((ext_vector_type(2)));
typedef float f32x16 __attribute__((ext_vector_type(16)));
typedef unsigned u32x6 __attribute__((ext_vector_type(6)));
typedef float f32x32 __attribute__((ext_vector_type(32)));

constexpr int D = 1024, NB = 2, SEQ = 16384, NMETA = 16;
constexpr int XROWS = NB * SEQ;
constexpr int MROW0 = XROWS;
constexpr int NROWS = XROWS + NMETA;
constexpr int RP = 33024;
constexpr int NPOS = SEQ + NMETA;
constexpr int INC = 3072;
constexpr int P1W = 2560;
constexpr int NEXP = 16384;
constexpr float EPS = 1e-6f;
constexpr float LOG2E = 1.4426950408889634f;
constexpr float CARRY2_STOP = -150.5f;
#ifndef TAB_U4
#define TAB_U4 0
#endif
#ifndef TAB_V4
#define TAB_V4 1
#endif
#ifndef TAB_U8
#define TAB_U8 2
#endif
constexpr bool U4 = TAB_U4 != 0, V4 = TAB_V4 != 0;
constexpr bool U8 = TAB_U8 != 0;
#ifndef TAB_VMF
#define TAB_VMF 1
#endif
constexpr bool VMF = TAB_VMF != 0;
constexpr bool UI4 = TAB_U8 == 2;
constexpr int USTRIDE = UI4 ? 512 : U8 ? 1024 : U4 ? 512 : 768, VSTRIDE = V4 ? 512 : 768;
#ifndef TAB_CQ
#define TAB_CQ 1
#endif
constexpr bool CQ = TAB_CQ != 0;
static_assert(!CQ || !U4, "column-quarter u table is fp6 only");

constexpr size_t MiB = 1u << 20;
constexpr size_t WS_CTL = 0;
constexpr size_t WS_WIN = 1 * MiB;
constexpr size_t WS_WOUT = 7 * MiB;
constexpr size_t WS_WQ = 9 * MiB;
constexpr size_t WS_KEYS = 17 * MiB;
constexpr size_t WS_POOL = 18 * MiB;
constexpr size_t WS_RS0 = 19 * MiB;
constexpr size_t WS_SSQ1 = 20 * MiB;
constexpr size_t WS_RS2 = 23 * MiB;
constexpr size_t WS_SSQ3 = 24 * MiB;
constexpr size_t WS_UB = 32 * MiB;
constexpr size_t WS_VB = 96 * MiB;
constexpr size_t WS_XB = 160 * MiB;
constexpr size_t WS_H1 = 225 * MiB;
constexpr size_t WS_P1 = 290 * MiB;
constexpr size_t WS_IDX = 452 * MiB;
constexpr size_t WS_GATE = 469 * MiB;
constexpr size_t WS_END = 486 * MiB;

#define LAS __attribute__((address_space(3)))
#define MKRSRC(p, bytes) __builtin_amdgcn_make_buffer_rsrc((void*)(p), 0, (int)(bytes), 0x00020000)
__device__ __forceinline__ float bf2f(bf16_t v) { return __uint_as_float(((unsigned)v) << 16); }
__device__ __forceinline__ float bflo(unsigned w) { return __uint_as_float(w << 16); }
__device__ __forceinline__ float bfhi(unsigned w) { return __uint_as_float(w & 0xffff0000u); }
__device__ __forceinline__ bf16_t f2bf(float f) { unsigned u = __float_as_uint(f); return (bf16_t)((u + 0x7fffu + ((u >> 16) & 1u)) >> 16); }
__device__ __forceinline__ unsigned pk2(float lo, float hi) { unsigned r; asm("v_cvt_pk_bf16_f32 %0, %1, %2" : "=v"(r) : "v"(lo), "v"(hi)); return r; }
__device__ __forceinline__ float wave_sum(float v) {
#pragma unroll
    for (int o = 1; o < 64; o <<= 1) v += __shfl_xor(v, o);
    return v;
}
__device__ __forceinline__ int opaque_tid() { int t = (int)threadIdx.x; asm volatile("" : "+v"(t)); return t; }

__device__ __forceinline__ float dpp_xor1(float v) { return __builtin_bit_cast(float, __builtin_amdgcn_update_dpp(0, __builtin_bit_cast(int, v), 0xB1, 0xF, 0xF, true)); }
__device__ __forceinline__ float dpp_xor2(float v) { return __builtin_bit_cast(float, __builtin_amdgcn_update_dpp(0, __builtin_bit_cast(int, v), 0x4E, 0xF, 0xF, true)); }
__device__ __forceinline__ float dpp_xor8(float v) { return __builtin_bit_cast(float, __builtin_amdgcn_update_dpp(0, __builtin_bit_cast(int, v), 0x128, 0xF, 0xF, true)); }
__device__ __forceinline__ int prow(int b, int p) { return p < NMETA ? MROW0 + p : b * SEQ + (p - NMETA); }
__device__ __forceinline__ void rowpos(int row, int& b, int& p) { if (row >= MROW0) { b = 0; p = row - MROW0; } else { b = row >> 14; p = (row & (SEQ - 1)) + NMETA; } }
__host__ __device__ __forceinline__ int win_btrow(int u64, int d) { return 256 * (u64 >> 2) + 128 * (d >> 5) + 32 * (u64 & 3) + (d & 31); }
__host__ __device__ __forceinline__ int win_srccol(int u64, int d) {
    if (u64 < 24) return 64 * u64 + d;
    if (u64 < 32) return 1536 + 64 * (u64 - 24) + d;
    const int c32 = u64 - 32;
    return d < 32 ? 2048 + 32 * c32 + d : 2560 + 32 * c32 + (d - 32);
}
__device__ __forceinline__ float gelu_tanh(float x) {
    const float y = 0.7978845608028654f * (x + 0.044715f * x * x * x);
    const float e = __expf(2.f * y);
    const float t = 1.f - 2.f / (1.f + e);
    return 0.5f * x * (1.f + t);
}

struct Args {
    const float* x; const float* meta; const float* even_g; const float* w_in; const float* qg; const float* kg; const float* conv_w; const float* w_out;
    const float* odd_g; const float* pool_w; const float* pool_scale; const float* ffn_g; const float* w_query; const float* sub_keys; const float* peer_u; const float* peer_v;
    float* out; unsigned char* ws; int ph_lo, ph_hi;
};

__device__ __forceinline__ void p0_prep(const Args& a, long gtid, long gsz) {
    unsigned char* ws = a.ws;
    bf16_t* WinT = (bf16_t*)(ws + WS_WIN); bf16_t* WoutT = (bf16_t*)(ws + WS_WOUT); bf16_t* WqT = (bf16_t*)(ws + WS_WQ);
    bf16_t* KeysB = (bf16_t*)(ws + WS_KEYS); bf16_t* PoolT = (bf16_t*)(ws + WS_POOL);
    bf16_t* UB = (bf16_t*)(ws + WS_UB); bf16_t* VB = (bf16_t*)(ws + WS_VB); bf16_t* XB = (bf16_t*)(ws + WS_XB); float* RS0 = (float*)(ws + WS_RS0);
    for (long i = gtid; i < (long)INC * D; i += gsz) {
        const int k = (int)(i % D), l = (int)(i / D), u64 = l >> 6, d = l & 63;
        WinT[(size_t)win_btrow(u64, d) * D + k] = f2bf(a.w_in[(size_t)k * INC + win_srccol(u64, d)] * a.even_g[k]);
    }
    for (long i = gtid; i < (long)D * D; i += gsz) { const int k = (int)(i % D), n = (int)(i / D); WoutT[(size_t)n * D + k] = f2bf(a.w_out[(size_t)k * D + n]); }
    for (long i = gtid; i < 2L * 2048 * D; i += gsz) {
        const int k = (int)(i % D); const long r = i / D; const int n = (int)(r % 2048), l = (int)(r / 2048);
        WqT[((size_t)l * 2048 + n) * D + k] = f2bf(a.w_query[((size_t)l * D + k) * 2048 + n] * a.ffn_g[l * D + k]);
    }
    for (long i = gtid; i < 2L * 2 * 8 * 128 * 128; i += gsz) KeysB[i] = f2bf(a.sub_keys[i]);
    for (long i = gtid; i < 1024L * 256; i += gsz) {
        const int c = (int)(i % 256), n = (int)(i / 256), g = n >> 8, e = n & 255;
        PoolT[(size_t)n * 256 + c] = f2bf(a.pool_w[((size_t)g * 256 + c) * 256 + e] * a.odd_g[g * 256 + c] * a.pool_scale[n]);
    }
    for (long i = gtid; i < 2L * NEXP * D / 4; i += gsz) {
        const long e4 = i * 4; const int l = (int)(e4 / ((long)NEXP * D)), dcol = (int)(e4 % D);
        const f32x4 u = *(const f32x4*)(a.peer_u + e4), v = *(const f32x4*)(a.peer_v + e4), g = *(const f32x4*)(a.ffn_g + l * D + dcol);
        *(uint2*)(UB + e4) = make_uint2(pk2(u[0] * g[0], u[1] * g[1]), pk2(u[2] * g[2], u[3] * g[3]));
        *(uint2*)(VB + e4) = make_uint2(pk2(v[0], v[1]), pk2(v[2], v[3]));
    }
    const long gw = gtid >> 6, nw = gsz >> 6; const int lane = (int)(gtid & 63);
    for (long row = gw; row < RP; row += nw) {
        bf16_t* o = XB + (size_t)row * D;
        if (row >= NROWS) { for (int j = 0; j < 4; ++j) *(uint2*)(o + 256 * j + 4 * lane) = make_uint2(0u, 0u); if (lane == 0) RS0[row] = 1.f; continue; }
        const float* src = row < XROWS ? a.x + (size_t)row * D : a.meta + (size_t)(row - MROW0) * D;
        float ss = 0.f;
        for (int j = 0; j < 4; ++j) { const f32x4 v = *(const f32x4*)(src + 256 * j + 4 * lane); ss += v[0] * v[0] + v[1] * v[1] + v[2] * v[2] + v[3] * v[3];
            *(uint2*)(o + 256 * j + 4 * lane) = make_uint2(pk2(v[0], v[1]), pk2(v[2], v[3])); }
        ss = wave_sum(ss);
        if (lane == 0) RS0[row] = rsqrtf(ss * (1.f / D) + EPS);
    }
}

template <class BRow, class AOff, class Epi>
__device__ __forceinline__ void naive_gemm(const bf16_t* A, int lda, const bf16_t* Bt, int K, int nrows, int nunits, BRow brow, AOff aoff, Epi epi, long gtid, long gsz) {
    const int rblks = (nrows + 63) / 64;
    const long nwaves = (long)rblks * nunits;
    const int lane = (int)(gtid & 63);
    for (long w = gtid >> 6; w < nwaves; w += gsz >> 6) {
        const int unit = __builtin_amdgcn_readfirstlane((int)(w / rblks));
        const int row = (int)(w % rblks) * 64 + lane;
        const int rr = row < nrows ? row : nrows - 1;
        const bf16_t* arow = A + (size_t)rr * lda + aoff(unit);
        float acc[64];
#pragma unroll
        for (int c = 0; c < 64; ++c) acc[c] = 0.f;
        for (int k = 0; k < K; k += 8) {
            const u32x4 av = *(const u32x4*)(arow + k);
            const float a0 = bflo(av[0]), a1 = bfhi(av[0]), a2 = bflo(av[1]), a3 = bfhi(av[1]), a4 = bflo(av[2]), a5 = bfhi(av[2]), a6 = bflo(av[3]), a7 = bfhi(av[3]);
#pragma unroll
            for (int c = 0; c < 64; ++c) {
                const u32x4 bv = *(const u32x4*)(Bt + (size_t)brow(unit, c) * K + k);
                acc[c] += a0 * bflo(bv[0]) + a1 * bfhi(bv[0]) + a2 * bflo(bv[1]) + a3 * bfhi(bv[1]) + a4 * bflo(bv[2]) + a5 * bfhi(bv[2]) + a6 * bflo(bv[3]) + a7 * bfhi(bv[3]);
            }
        }
        if (row < nrows) epi(row, unit, acc);
    }
}

__device__ __forceinline__ void p1_gemm_in(const Args& a, long gtid, long gsz) {
    unsigned char* ws = a.ws;
    const bf16_t* XB = (const bf16_t*)(ws + WS_XB); const bf16_t* WinT = (const bf16_t*)(ws + WS_WIN); const float* RS0 = (const float*)(ws + WS_RS0);
    bf16_t* P1 = (bf16_t*)(ws + WS_P1);
    const float* qg = a.qg; const float* kg = a.kg;
    naive_gemm(XB, D, WinT, D, NROWS, 48,
        [](int u, int c) { return win_btrow(u, c); }, [](int) { return 0; },
        [=](int row, int u, float (&acc)[64]) {
            const float s = RS0[row];
            bf16_t* o = P1 + (size_t)row * P1W;
            if (u < 16) {
                float ss = 0.f;
#pragma unroll
                for (int c = 0; c < 64; ++c) { acc[c] *= s; ss += acc[c] * acc[c]; }
                const float r = rsqrtf(ss * (1.f / 64.f) + EPS) * (u < 8 ? 0.125f * LOG2E : 1.f);
                const float* g = u < 8 ? qg : kg;
#pragma unroll
                for (int c = 0; c < 64; ++c) o[u * 64 + c] = f2bf(acc[c] * r * g[c]);
            } else if (u < 32) {
#pragma unroll
                for (int c = 0; c < 64; ++c) o[u * 64 + c] = f2bf(acc[c] * s);
            } else {
                const int c32 = u - 32;
#pragma unroll
                for (int c = 0; c < 32; ++c) o[2048 + 32 * c32 + c] = f2bf((acc[c] * s) * (acc[32 + c] * s));
            }
        }, gtid, gsz);
}

__device__ __forceinline__ void p2_attn_conv(const Args& a, bf16_t* MIX, long gtid, long gsz) {
    const bf16_t* P1 = (const bf16_t*)(a.ws + WS_P1);
    for (long it = gtid; it < (long)NROWS * 8; it += gsz) {
        const int row = (int)(it % NROWS), h = (int)(it / NROWS);
        int b, p; rowpos(row, b, p);
        float q[64], o[64];
        const bf16_t* qp = P1 + (size_t)row * P1W + h * 64;
#pragma unroll
        for (int c = 0; c < 64; ++c) { q[c] = bf2f(qp[c]); o[c] = 0.f; }
        float carry = 0.f;
        for (int s = p - 1; s >= 0; --s) {
            const bf16_t* kp = P1 + (size_t)prow(b, s) * P1W + 512 + h * 64;
            float z = 0.f;
#pragma unroll
            for (int c = 0; c < 64; ++c) z += q[c] * bf2f(kp[c]);
            const float L = z > 0.f ? z + log2f(1.f + exp2f(-z)) : log2f(1.f + exp2f(z));
            const float w = exp2f(z - L + carry);
            const bf16_t* vp = kp + 512;
#pragma unroll
            for (int c = 0; c < 64; ++c) o[c] += w * bf2f(vp[c]);
            carry -= L;
            if (carry < CARRY2_STOP) break;
        }
        bf16_t* op = MIX + (size_t)row * D + h * 64;
#pragma unroll
        for (int c = 0; c < 64; ++c) op[c] = f2bf(o[c]);
    }
    for (long it = gtid; it < (long)NROWS * 512; it += gsz) {
        const int c = (int)(it & 511), row = (int)(it >> 9);
        int b, p; rowpos(row, b, p);
        float y = a.conv_w[2 * 512 + c] * bf2f(P1[(size_t)row * P1W + 2048 + c]);
        if (p >= 1) y += a.conv_w[1 * 512 + c] * bf2f(P1[(size_t)prow(b, p - 1) * P1W + 2048 + c]);
        if (p >= 2) y += a.conv_w[0 * 512 + c] * bf2f(P1[(size_t)prow(b, p - 2) * P1W + 2048 + c]);
        MIX[(size_t)row * D + 512 + c] = f2bf(y * bf2f(P1[(size_t)row * P1W + 1536 + c]));
    }
}

__device__ __forceinline__ void p3_gemm_out(const Args& a, const bf16_t* MIX, long gtid, long gsz) {
    const bf16_t* WoutT = (const bf16_t*)(a.ws + WS_WOUT); bf16_t* H1 = (bf16_t*)(a.ws + WS_H1); float* SSQ1 = (float*)(a.ws + WS_SSQ1);
    const float* x = a.x; const float* meta = a.meta;
    naive_gemm(MIX, D, WoutT, D, NROWS, 16,
        [](int u, int c) { return u * 64 + c; }, [](int) { return 0; },
        [=](int row, int u, float (&acc)[64]) {
            const float* h0 = (row < XROWS ? x + (size_t)row * D : meta + (size_t)(row - MROW0) * D) + u * 64;
            float ss = 0.f;
#pragma unroll
            for (int c = 0; c < 64; ++c) { const bf16_t hb = f2bf(h0[c] + acc[c]); const float hv = bf2f(hb); ss += hv * hv; H1[(size_t)row * D + u * 64 + c] = hb; }
            SSQ1[(size_t)row * 16 + u] = ss;
        }, gtid, gsz);
}

__device__ __forceinline__ void p4_gemm_q(const Args& a, int layer, const bf16_t* H, int nrows, long gtid, long gsz) {
    const bf16_t* WqT = (const bf16_t*)(a.ws + WS_WQ) + (size_t)layer * 2048 * D; bf16_t* QP = (bf16_t*)(a.ws + WS_P1);
    naive_gemm(H, D, WqT, D, nrows, 32,
        [](int u, int c) { return u * 64 + c; }, [](int) { return 0; },
        [=](int row, int u, float (&acc)[64]) {
#pragma unroll
            for (int c = 0; c < 64; ++c) QP[(size_t)row * 2048 + u * 64 + c] = f2bf(acc[c]);
        }, gtid, gsz);
}

__device__ __forceinline__ void ins16(float (&tv)[16], int (&ti)[16], float v, int i) {
#pragma unroll
    for (int j = 0; j < 16; ++j) { const bool sw = v > tv[j]; const float ov = tv[j]; const int oi = ti[j]; tv[j] = sw ? v : ov; ti[j] = sw ? i : oi; v = sw ? ov : v; i = sw ? oi : i; }
}
__device__ __forceinline__ void p5_topk(const Args& a, int layer, const float* SSQ, int nrows, long gtid, long gsz) {
    const bf16_t* QP = (const bf16_t*)(a.ws + WS_P1); const bf16_t* KeysB = (const bf16_t*)(a.ws + WS_KEYS) + (size_t)layer * 2 * 8 * 128 * 128;
    int* IDX = (int*)(a.ws + WS_IDX); float* GATE = (float*)(a.ws + WS_GATE);
    for (long it = gtid; it < (long)nrows * 8; it += gsz) {
        const int row = (int)(it % nrows), h = (int)(it / nrows);
        float sv[2][16]; int si[2][16];
#pragma unroll
        for (int p = 0; p < 2; ++p) {
#pragma unroll
            for (int j = 0; j < 16; ++j) { sv[p][j] = -INFINITY; si[p][j] = 0; }
            const bf16_t* qp = QP + (size_t)row * 2048 + h * 256 + p * 128;
            const bf16_t* kb = KeysB + ((size_t)(p * 8 + h) * 128) * 128;
            for (int k = 0; k < 128; ++k) {
                float s = 0.f;
                for (int c = 0; c < 128; c += 8) {
                    const u32x4 qv = *(const u32x4*)(qp + c), kv = *(const u32x4*)(kb + (size_t)k * 128 + c);
                    s += bflo(qv[0]) * bflo(kv[0]) + bfhi(qv[0]) * bfhi(kv[0]) + bflo(qv[1]) * bflo(kv[1]) + bfhi(qv[1]) * bfhi(kv[1])
                       + bflo(qv[2]) * bflo(kv[2]) + bfhi(qv[2]) * bfhi(kv[2]) + bflo(qv[3]) * bflo(kv[3]) + bfhi(qv[3]) * bfhi(kv[3]);
                }
                ins16(sv[p], si[p], s, k);
            }
        }
        float tv[16]; int ti[16];
#pragma unroll
        for (int j = 0; j < 16; ++j) { tv[j] = -INFINITY; ti[j] = 0; }
#pragma unroll
        for (int i = 0; i < 16; ++i)
#pragma unroll
            for (int j = 0; j < 16; ++j) ins16(tv, ti, sv[0][i] + sv[1][j], si[0][i] * 128 + si[1][j]);
        float ssq = 0.f;
        for (int j = 0; j < 16; ++j) ssq += SSQ[(size_t)row * 16 + j];
        const float rstd = rsqrtf(ssq * (1.f / D) + EPS);
        float e[16], sum = 0.f;
#pragma unroll
        for (int j = 0; j < 16; ++j) { e[j] = __expf((tv[j] - tv[0]) * rstd); sum += e[j]; }
        const float inv = 1.f / sum;
#pragma unroll
        for (int j = 0; j < 16; ++j) { IDX[(size_t)row * 128 + h * 16 + j] = ti[j]; GATE[(size_t)row * 128 + h * 16 + j] = e[j] * inv; }
    }
}

template <bool FINAL>
__device__ __forceinline__ void p6_peer(const Args& a, int layer, const bf16_t* H, const float* SSQ, bf16_t* Hout, float* RSout, int nrows, long gtid, long gsz) {
    const bf16_t* UB = (const bf16_t*)(a.ws + WS_UB) + (size_t)layer * NEXP * D; const bf16_t* VB = (const bf16_t*)(a.ws + WS_VB) + (size_t)layer * NEXP * D;
    const int* IDX = (const int*)(a.ws + WS_IDX); const float* GATE = (const float*)(a.ws + WS_GATE);
    const int lane = (int)(gtid & 63);
    for (long row = gtid >> 6; row < nrows; row += gsz >> 6) {
        const bf16_t* hp = H + (size_t)row * D;
        const u32x4 h0 = *(const u32x4*)(hp + lane * 8), h1 = *(const u32x4*)(hp + 512 + lane * 8);
        float hv[16];
#pragma unroll
        for (int j = 0; j < 4; ++j) { hv[2 * j] = bflo(h0[j]); hv[2 * j + 1] = bfhi(h0[j]); hv[8 + 2 * j] = bflo(h1[j]); hv[9 + 2 * j] = bfhi(h1[j]); }
        float ssq = 0.f;
        for (int j = 0; j < 16; ++j) ssq += SSQ[(size_t)row * 16 + j];
        const float rstd = rsqrtf(ssq * (1.f / D) + EPS);
        float y[16];
#pragma unroll
        for (int j = 0; j < 16; ++j) y[j] = 0.f;
        for (int n = 0; n < 128; ++n) {
            const int e = IDX[(size_t)row * 128 + n]; const float g = GATE[(size_t)row * 128 + n];
            const bf16_t* up = UB + (size_t)e * D; const bf16_t* vp = VB + (size_t)e * D;
            const u32x4 u0 = *(const u32x4*)(up + lane * 8), u1 = *(const u32x4*)(up + 512 + lane * 8);
            float dsum = 0.f;
#pragma unroll
            for (int j = 0; j < 4; ++j) dsum += hv[2 * j] * bflo(u0[j]) + hv[2 * j + 1] * bfhi(u0[j]) + hv[8 + 2 * j] * bflo(u1[j]) + hv[9 + 2 * j] * bfhi(u1[j]);
            dsum = wave_sum(dsum);
            const float c = g * gelu_tanh(dsum * rstd);
            const u32x4 v0 = *(const u32x4*)(vp + lane * 8), v1 = *(const u32x4*)(vp + 512 + lane * 8);
#pragma unroll
            for (int j = 0; j < 4; ++j) { y[2 * j] += c * bflo(v0[j]); y[2 * j + 1] += c * bfhi(v0[j]); y[8 + 2 * j] += c * bflo(v1[j]); y[9 + 2 * j] += c * bfhi(v1[j]); }
        }
#pragma unroll
        for (int j = 0; j < 16; ++j) y[j] += hv[j];
        if (FINAL) {
            float* o = a.out + (size_t)row * D;
            *(f32x4*)(o + lane * 8) = (f32x4){y[0], y[1], y[2], y[3]}; *(f32x4*)(o + lane * 8 + 4) = (f32x4){y[4], y[5], y[6], y[7]};
            *(f32x4*)(o + 512 + lane * 8) = (f32x4){y[8], y[9], y[10], y[11]}; *(f32x4*)(o + 512 + lane * 8 + 4) = (f32x4){y[12], y[13], y[14], y[15]};
        } else {
            u32x4 w0, w1; float ss = 0.f;
#pragma unroll
            for (int j = 0; j < 4; ++j) { w0[j] = pk2(y[2 * j], y[2 * j + 1]); w1[j] = pk2(y[8 + 2 * j], y[9 + 2 * j]); }
#pragma unroll
            for (int j = 0; j < 4; ++j) { const float a0 = bflo(w0[j]), a1 = bfhi(w0[j]), b0 = bflo(w1[j]), b1 = bfhi(w1[j]); ss += a0 * a0 + a1 * a1 + b0 * b0 + b1 * b1; }
            ss = wave_sum(ss);
            *(u32x4*)(Hout + (size_t)row * D + lane * 8) = w0; *(u32x4*)(Hout + (size_t)row * D + 512 + lane * 8) = w1;
            if (lane == 0) RSout[row] = rsqrtf(ss * (1.f / D) + EPS);
        }
    }
}

__device__ __forceinline__ void p7_poold(const Args& a, bf16_t* Dm, long gtid, long gsz) {
    const bf16_t* H2 = (const bf16_t*)(a.ws + WS_XB); const float* RS2 = (const float*)(a.ws + WS_RS2);
    for (long it = gtid; it < (long)XROWS * D; it += gsz) {
        const int c = (int)(it & (D - 1)), row = (int)(it >> 10);
        int b, p; rowpos(row, b, p);
        const int w = 2 << (c >> 8);
        const int lo = p - w + 1 > 0 ? p - w + 1 : 0;
        float s = 0.f, self = 0.f;
        for (int j = lo; j <= p; ++j) { const int r = prow(b, j); const float v = bf2f(H2[(size_t)r * D + c]) * RS2[r]; s += v; self = v; }
        Dm[(size_t)row * D + c] = f2bf(s / (float)(p - lo + 1) - self);
    }
}

__device__ __forceinline__ void p8_gemm_pool(const Args& a, const bf16_t* Dm, long gtid, long gsz) {
    const bf16_t* PoolT = (const bf16_t*)(a.ws + WS_POOL); const bf16_t* H2 = (const bf16_t*)(a.ws + WS_XB); bf16_t* H3 = (bf16_t*)(a.ws + WS_H1); float* SSQ3 = (float*)(a.ws + WS_SSQ3);
    naive_gemm(Dm, D, PoolT, 256, XROWS, 16,
        [](int u, int c) { return u * 64 + c; }, [](int u) { return (u >> 2) * 256; },
        [=](int row, int u, float (&acc)[64]) {
            float ss = 0.f;
#pragma unroll
            for (int c = 0; c < 64; ++c) { const bf16_t hb = f2bf(bf2f(H2[(size_t)row * D + u * 64 + c]) + acc[c]); const float hv = bf2f(hb); ss += hv * hv; H3[(size_t)row * D + u * 64 + c] = hb; }
            SSQ3[(size_t)row * 16 + u] = ss;
        }, gtid, gsz);
}


namespace pg8 {
#define PG8_LAS __attribute__((address_space(3)))
typedef unsigned short bf16_t;
typedef short bf16x8 __attribute__((ext_vector_type(8)));
typedef float f32x4 __attribute__((ext_vector_type(4)));
typedef unsigned u32x4 __attribute__((ext_vector_type(4)));
constexpr int BM = 256, BK = 64, HALF = 128, HTB = HALF * BK * 2  , STAGE_BYTES = 8 * HTB, NXCD = 8, WGM = 8;

__host__ __device__ __forceinline__ int lds_byte(int r, int c) { const int st = (r >> 4) * 2 + (c >> 5), rr = r & 15, cc = c & 31, ob = rr * 64 + cc * 2; return st * 1024 + (ob ^ (((ob >> 9) & 1) << 5)); }
__host__ __device__ __forceinline__ void stage_rc(int b, int& R, int& C) { const int st = b / 1024, sb = b % 1024, swz = sb ^ (((sb >> 9) & 1) << 5); R = (st >> 1) * 16 + swz / 64; C = (st & 1) * 32 + (swz % 64) / 2; }
__host__ __device__ __forceinline__ int perm32(int rho) { const int n = rho >> 4, i = rho & 15; return 8 * (i >> 2) + 4 * n + (i & 3); }

struct Unit { int pm, pn; };
struct Gemm { const bf16_t* A; const bf16_t* Bt; int lda, ldb, K, a_pn_off; };

struct StaticOrder {
    int nM, nN, nwg, G, c;
    __host__ __device__ void init(int M, int N, int G_, int c_) { nM = M / BM; nN = N / BM; nwg = nM * nN; G = G_; c = c_; }
    __host__ __device__ bool next(int i, Unit& u) const {
        const long L = (long)i * G + c; if (L >= nwg) return false;
        int wgid = (int)L; { const int q = nwg / NXCD, r = nwg % NXCD, xcd = wgid % NXCD, off = wgid / NXCD; wgid = (xcd < r ? xcd * (q + 1) : r * (q + 1) + (xcd - r) * q) + off; }
        const int nig = WGM * nN, gid = wgid / nig, fm = gid * WGM, gsz = (nM - fm) < WGM ? (nM - fm) : WGM;
        u.pm = fm + ((wgid % nig) % gsz); u.pn = (wgid % nig) / gsz; return true;
    }
    __device__ __forceinline__ void a_ready(const Unit&) const {}
    __device__ __forceinline__ void done(const Unit&) const {}
};


__device__ __forceinline__ unsigned cvt_pk_bf16(float lo, float hi) { unsigned r; asm volatile("v_cvt_pk_bf16_f32 %0, %1, %2" : "=v"(r) : "v"(lo), "v"(hi)); return r; }

struct EpiPlain {
    static constexpr bool PERM = true, AFTER_DRAIN = false;
    bf16_t* O; int ldc;
    __device__ __forceinline__ void operator()(const f32x4 (&acc)[2][2][4][2], const Unit& u, int wr, int wc, int fr, int fq) const {
        const int row0 = u.pm * BM + wr * 64 + fr, col0 = u.pn * BM + wc * 32 + 8 * fq;
#pragma unroll
        for (int ai = 0; ai < 2; ++ai)
#pragma unroll
            for (int m = 0; m < 4; ++m) { bf16_t* rowp = O + (size_t)(row0 + ai * HALF + m * 16) * ldc + col0;
#pragma unroll
                for (int bj = 0; bj < 2; ++bj) { const f32x4 v0 = acc[ai][bj][m][0], v1 = acc[ai][bj][m][1];
                    u32x4 w; w.x = cvt_pk_bf16(v0[0], v0[1]); w.y = cvt_pk_bf16(v0[2], v0[3]); w.z = cvt_pk_bf16(v1[0], v1[1]); w.w = cvt_pk_bf16(v1[2], v1[3]);
                    *(u32x4*)(rowp + bj * HALF) = w; } }
    }
};
struct EpiIn {
    static constexpr bool PERM = true, AFTER_DRAIN = false;
    bf16_t* P1; const float* RS0; const float* qg; const float* kg;
    __device__ __forceinline__ void operator()(const f32x4 (&acc)[2][2][4][2], const Unit& u, int wr, int wc, int fr, int fq) const {
        const int u64 = 4 * u.pn + wc;
        const int row0 = u.pm * BM + wr * 64 + fr;
        if (u64 < 16) {
            const float* g = u64 < 8 ? qg : kg; const float sc = u64 < 8 ? 0.125f * LOG2E : 1.f;
            f32x4 gv[2][2];
#pragma unroll
            for (int bj = 0; bj < 2; ++bj)
#pragma unroll
                for (int n = 0; n < 2; ++n) gv[bj][n] = *(const f32x4*)(g + 32 * bj + 8 * fq + 4 * n);
#pragma unroll
            for (int ai = 0; ai < 2; ++ai)
#pragma unroll
                for (int m = 0; m < 4; ++m) { const int row = row0 + ai * HALF + m * 16; const float s = RS0[row];
                    f32x4 v[2][2]; float ss = 0.f;
#pragma unroll
                    for (int bj = 0; bj < 2; ++bj)
#pragma unroll
                        for (int n = 0; n < 2; ++n) { v[bj][n] = acc[ai][bj][m][n] * s; ss += (v[bj][n][0] * v[bj][n][0] + v[bj][n][1] * v[bj][n][1]) + (v[bj][n][2] * v[bj][n][2] + v[bj][n][3] * v[bj][n][3]); }
                    ss += __shfl_xor(ss, 16); ss += __shfl_xor(ss, 32);
                    const float r = rsqrtf(ss * (1.f / 64.f) + EPS) * sc;
                    bf16_t* rowp = P1 + (size_t)row * P1W + u64 * 64 + 8 * fq;
#pragma unroll
                    for (int bj = 0; bj < 2; ++bj) { const f32x4 a0 = v[bj][0] * gv[bj][0] * r, a1 = v[bj][1] * gv[bj][1] * r;
                        u32x4 w; w.x = cvt_pk_bf16(a0[0], a0[1]); w.y = cvt_pk_bf16(a0[2], a0[3]); w.z = cvt_pk_bf16(a1[0], a1[1]); w.w = cvt_pk_bf16(a1[2], a1[3]);
                        *(u32x4*)(rowp + 32 * bj) = w; } }
        } else if (u64 < 32) {
#pragma unroll
            for (int ai = 0; ai < 2; ++ai)
#pragma unroll
                for (int m = 0; m < 4; ++m) { const int row = row0 + ai * HALF + m * 16; const float s = RS0[row];
                    bf16_t* rowp = P1 + (size_t)row * P1W + u64 * 64 + 8 * fq;
#pragma unroll
                    for (int bj = 0; bj < 2; ++bj) { const f32x4 a0 = acc[ai][bj][m][0] * s, a1 = acc[ai][bj][m][1] * s;
                        u32x4 w; w.x = cvt_pk_bf16(a0[0], a0[1]); w.y = cvt_pk_bf16(a0[2], a0[3]); w.z = cvt_pk_bf16(a1[0], a1[1]); w.w = cvt_pk_bf16(a1[2], a1[3]);
                        *(u32x4*)(rowp + 32 * bj) = w; } }
        } else {
            const int c32 = u64 - 32;
#pragma unroll
            for (int ai = 0; ai < 2; ++ai)
#pragma unroll
                for (int m = 0; m < 4; ++m) { const int row = row0 + ai * HALF + m * 16; const float s = RS0[row], s2 = s * s;
                    const f32x4 a0 = acc[ai][0][m][0] * acc[ai][1][m][0] * s2, a1 = acc[ai][0][m][1] * acc[ai][1][m][1] * s2;
                    u32x4 w; w.x = cvt_pk_bf16(a0[0], a0[1]); w.y = cvt_pk_bf16(a0[2], a0[3]); w.z = cvt_pk_bf16(a1[0], a1[1]); w.w = cvt_pk_bf16(a1[2], a1[3]);
                    *(u32x4*)(P1 + (size_t)row * P1W + 2048 + 32 * c32 + 8 * fq) = w; }
        }
    }
};
template <int MODE> struct EpiRes {
    static constexpr bool PERM = true, AFTER_DRAIN = false;
    const float* x; const float* meta; const bf16_t* Hb; bf16_t* Hout; float* SSQ;
    __device__ __forceinline__ void operator()(const f32x4 (&acc)[2][2][4][2], const Unit& u, int wr, int wc, int fr, int fq) const {
        const int row0 = u.pm * BM + wr * 64 + fr, col0 = u.pn * BM + wc * 32 + 8 * fq;
        constexpr int DEP = MODE == 0 ? 4 : 8;
        f32x4 bf[8][2][2]; u32x4 bh[8][2];
#define ER_ISSUE(g) do { const int row_ = row0 + ((g) >> 2) * HALF + ((g) & 3) * 16; _Pragma("unroll") for (int bj = 0; bj < 2; ++bj) { const int col_ = col0 + bj * HALF; \
            if (MODE == 0) { const float* bp = row_ < XROWS ? x + (size_t)row_ * D + col_ : meta + (size_t)(row_ < NROWS ? row_ - MROW0 : 0) * D + col_; bf[g][bj][0] = *(const f32x4*)bp; bf[g][bj][1] = *(const f32x4*)(bp + 4); } \
            else bh[g][bj] = *(const u32x4*)(Hb + (size_t)row_ * D + col_); } } while (0)
#pragma unroll
        for (int g = 0; g < DEP; ++g) ER_ISSUE(g);
#pragma unroll
        for (int g = 0; g < 8; ++g) { const int ai = g >> 2, m = g & 3, row = row0 + ai * HALF + m * 16; float ss = 0.f;
            asm volatile("" ::: "memory");
#pragma unroll
            for (int bj = 0; bj < 2; ++bj) { const int col = col0 + bj * HALF; f32x4 b0, b1;
                if (MODE == 0) { b0 = bf[g][bj][0]; b1 = bf[g][bj][1]; }
                else { const u32x4 hb = bh[g][bj]; b0 = (f32x4){bflo(hb[0]), bfhi(hb[0]), bflo(hb[1]), bfhi(hb[1])}; b1 = (f32x4){bflo(hb[2]), bfhi(hb[2]), bflo(hb[3]), bfhi(hb[3])}; }
                const f32x4 v0 = acc[ai][bj][m][0] + b0, v1 = acc[ai][bj][m][1] + b1;
                u32x4 w; w.x = cvt_pk_bf16(v0[0], v0[1]); w.y = cvt_pk_bf16(v0[2], v0[3]); w.z = cvt_pk_bf16(v1[0], v1[1]); w.w = cvt_pk_bf16(v1[2], v1[3]);
#pragma unroll
                for (int j = 0; j < 4; ++j) { const float lo = bflo(w[j]), hi = bfhi(w[j]); ss += lo * lo + hi * hi; }
                *(u32x4*)(Hout + (size_t)row * D + col) = w; }
            ss += __shfl_xor(ss, 16); ss += __shfl_xor(ss, 32);
            if (fq == 0) SSQ[(size_t)row * 16 + 4 * u.pn + wc] = ss;
            if (g + DEP < 8) ER_ISSUE((g + DEP) & 7);
        }
#undef ER_ISSUE
    }
};
template <class Epi, class Sched, bool ALIGN_EPI = false, bool SP2 = false>
__device__ __forceinline__ void gemm_phase(PG8_LAS unsigned char* lds, const Gemm g, const Sched& S, const Epi& E) {
    const int tid = opaque_tid(), wid = __builtin_amdgcn_readfirstlane(tid >> 6), lane = tid & 63, wr = wid >> 2, wc = wid & 3, fr = lane & 15, fq = lane >> 4;
    const int K = g.K, nt = K / BK;
    unsigned voffA[2], voffB[2];
#pragma unroll
    for (int i = 0; i < 2; ++i) { int R, C; stage_rc(tid * 16 + i * 8192, R, C); const int Rb = Epi::PERM ? ((R & ~31) + perm32(R & 31)) : R;
        voffA[i] = (unsigned)(R * g.lda + C) * 2u; voffB[i] = (unsigned)(Rb * g.ldb + C) * 2u; }
    const size_t kstep = (size_t)(BK * 2);
    const size_t hstepA = (size_t)HALF * g.lda * 2, hstepB = (size_t)HALF * g.ldb * 2;
    const size_t tstepA = 2 * hstepA, tstepB = 2 * hstepB;
    const size_t apn = (size_t)g.a_pn_off * 2;
    const unsigned ldsw = (unsigned)wid * 1024u;
    const int aoff = lds_byte(wr * 64 + fr, fq * 8), boff = lds_byte(wc * 32 + fr, fq * 8);
#define PG8_SA(b, h) (((b) * 2 + (h)) * HTB)
#define PG8_SB(b, h) ((4 + (b) * 2 + (h)) * HTB)
#define PG8_STAGE(bufoff, gbase, voff) do { _Pragma("unroll") for (int _i = 0; _i < 2; ++_i) \
        __builtin_amdgcn_global_load_lds((const unsigned*)((const char*)(gbase) + (voff)[_i]), (PG8_LAS unsigned*)(lds + (bufoff) + ldsw + _i * 8192), 16, 0, 0); } while (0)
#define PG8_LDA(dst, b, h) do { _Pragma("unroll") for (int m = 0; m < 4; ++m) _Pragma("unroll") for (int k = 0; k < 2; ++k) dst[m][k] = *(const PG8_LAS bf16x8*)(lds + PG8_SA(b, h) + aoff + m * 2048 + k * 1024); } while (0)
#define PG8_LDB(dst, b, h) do { _Pragma("unroll") for (int n = 0; n < 2; ++n) _Pragma("unroll") for (int k = 0; k < 2; ++k) dst[n][k] = *(const PG8_LAS bf16x8*)(lds + PG8_SB(b, h) + boff + n * 2048 + k * 1024); } while (0)
#define PG8_MMA(ai, bj, At, Bt) do { __builtin_amdgcn_s_setprio(1); _Pragma("unroll") for (int m = 0; m < 4; ++m) _Pragma("unroll") for (int n = 0; n < 2; ++n) _Pragma("unroll") for (int k = 0; k < 2; ++k) \
        acc[ai][bj][m][n] = __builtin_amdgcn_mfma_f32_16x16x32_bf16(Bt[n][k], At[m][k], acc[ai][bj][m][n], 0, 0, 0); __builtin_amdgcn_s_setprio(0); } while (0)
#define PG8_WAIT_V(n) asm volatile("s_waitcnt vmcnt(" #n ")" ::: "memory")
#define PG8_WAIT_L(n) asm volatile("s_waitcnt lgkmcnt(" #n ")" ::: "memory")
#define PG8_BAR __builtin_amdgcn_s_barrier()
#define PG8_SCHED __builtin_amdgcn_sched_barrier(0)
    Unit cur, nxt; int ui = 0;
    if (!S.next(0, cur)) return;
    f32x4 acc[2][2][4][2];
#pragma unroll
    for (int a = 0; a < 2; ++a)
#pragma unroll
        for (int b = 0; b < 2; ++b)
#pragma unroll
            for (int m = 0; m < 4; ++m)
#pragma unroll
                for (int n = 0; n < 2; ++n) acc[a][b][m][n] = (f32x4){0.f, 0.f, 0.f, 0.f};
    bf16x8 At[4][2], B0[2][2], B1[2][2];
    const char* cA = (const char*)g.A + (size_t)cur.pm * tstepA + (size_t)cur.pn * apn; const char* cB = (const char*)g.Bt + (size_t)cur.pn * tstepB;
    S.a_ready(cur);
    if constexpr (SP2) {
        PG8_STAGE(PG8_SB(0, 0), cB, voffB); PG8_STAGE(PG8_SB(0, 1), cB + hstepB, voffB); PG8_STAGE(PG8_SA(0, 0), cA, voffA); PG8_STAGE(PG8_SA(0, 1), cA + hstepA, voffA);
        if (wr == 1) PG8_BAR;
        PG8_WAIT_V(2); PG8_BAR;
        PG8_STAGE(PG8_SB(1, 0), cB + kstep, voffB); PG8_STAGE(PG8_SA(1, 0), cA + kstep, voffA); PG8_STAGE(PG8_SB(1, 1), cB + hstepB + kstep, voffB);
        PG8_WAIT_V(6); PG8_BAR;
    } else {
        PG8_STAGE(PG8_SB(0, 0), cB, voffB); PG8_STAGE(PG8_SA(0, 0), cA, voffA); PG8_STAGE(PG8_SB(0, 1), cB + hstepB, voffB); PG8_STAGE(PG8_SA(0, 1), cA + hstepA, voffA);
        if (wr == 1) PG8_BAR;
        PG8_WAIT_V(4); PG8_BAR;
        PG8_STAGE(PG8_SB(1, 0), cB + kstep, voffB); PG8_STAGE(PG8_SA(1, 0), cA + kstep, voffA); PG8_STAGE(PG8_SB(1, 1), cB + hstepB + kstep, voffB);
        PG8_WAIT_V(6); PG8_BAR;
    }
    for (;;) {
        const bool has_next = S.next(ui + 1, nxt);
        const char* nA = has_next ? (const char*)g.A + (size_t)nxt.pm * tstepA + (size_t)nxt.pn * apn : cA; const char* nB = has_next ? (const char*)g.Bt + (size_t)nxt.pn * tstepB : cB;
        for (int t = 0; t < nt; t += 2) {
            const bool last = (t == nt - 2);
            const char* a1 = cA + (size_t)(t + 1) * kstep;
            const char* a2 = last ? nA : cA + (size_t)(t + 2) * kstep; const char* b2 = last ? nB : cB + (size_t)(t + 2) * kstep;
            const char* a3 = a2 + kstep; const char* b3 = b2 + kstep;
            if (last && has_next) S.a_ready(nxt);
            if constexpr (SP2) {
            PG8_LDB(B0, 0, 0); PG8_LDB(B1, 0, 1); PG8_SCHED; PG8_LDA(At, 0, 0); PG8_STAGE(PG8_SA(1, 1), a1 + hstepA, voffA);
            PG8_WAIT_V(8); PG8_WAIT_L(0); PG8_BAR; PG8_MMA(0, 0, At, B0); PG8_MMA(0, 1, At, B1); PG8_BAR; PG8_SCHED;
            PG8_LDA(At, 0, 1); PG8_STAGE(PG8_SB(0, 0), b2, voffB); PG8_STAGE(PG8_SB(0, 1), b2 + hstepB, voffB); PG8_STAGE(PG8_SA(0, 0), a2, voffA);
            PG8_WAIT_V(8); PG8_WAIT_L(0); PG8_BAR; PG8_MMA(1, 0, At, B0); PG8_MMA(1, 1, At, B1); PG8_BAR; PG8_SCHED;
            PG8_LDB(B0, 1, 0); PG8_LDB(B1, 1, 1); PG8_SCHED; PG8_LDA(At, 1, 0); PG8_STAGE(PG8_SA(0, 1), a2 + hstepA, voffA);
            PG8_WAIT_V(8); PG8_WAIT_L(0); PG8_BAR; PG8_MMA(0, 0, At, B0); PG8_MMA(0, 1, At, B1); PG8_BAR; PG8_SCHED;
            PG8_LDA(At, 1, 1); PG8_STAGE(PG8_SB(1, 0), b3, voffB); PG8_STAGE(PG8_SB(1, 1), b3 + hstepB, voffB); PG8_STAGE(PG8_SA(1, 0), a3, voffA);
            PG8_WAIT_V(8); PG8_WAIT_L(0); PG8_BAR; PG8_MMA(1, 0, At, B0); PG8_MMA(1, 1, At, B1); PG8_BAR; PG8_SCHED;
            } else {
            PG8_LDB(B0, 0, 0); PG8_SCHED; PG8_LDA(At, 0, 0); PG8_STAGE(PG8_SA(1, 1), a1 + hstepA, voffA);
            PG8_WAIT_L(8); PG8_BAR; PG8_WAIT_L(0); PG8_MMA(0, 0, At, B0); PG8_BAR; PG8_SCHED;
            PG8_LDB(B1, 0, 1); PG8_STAGE(PG8_SB(0, 0), b2, voffB);
            PG8_BAR; PG8_WAIT_L(0); PG8_MMA(0, 1, At, B1); PG8_BAR;
            PG8_LDA(At, 0, 1); PG8_STAGE(PG8_SA(0, 0), a2, voffA);
            PG8_BAR; PG8_WAIT_L(0); PG8_MMA(1, 0, At, B0); PG8_BAR; PG8_SCHED;
            PG8_STAGE(PG8_SB(0, 1), b2 + hstepB, voffB);
            PG8_WAIT_V(6); PG8_BAR; PG8_MMA(1, 1, At, B1); PG8_BAR;
            PG8_LDB(B0, 1, 0); PG8_SCHED; PG8_LDA(At, 1, 0); PG8_STAGE(PG8_SA(0, 1), a2 + hstepA, voffA);
            PG8_WAIT_L(8); PG8_BAR; PG8_WAIT_L(0); PG8_MMA(0, 0, At, B0); PG8_BAR; PG8_SCHED;
            PG8_LDB(B1, 1, 1); PG8_STAGE(PG8_SB(1, 0), b3, voffB);
            PG8_BAR; PG8_WAIT_L(0); PG8_MMA(0, 1, At, B1); PG8_BAR;
            PG8_LDA(At, 1, 1); PG8_STAGE(PG8_SA(1, 0), a3, voffA);
            PG8_BAR; PG8_WAIT_L(0); PG8_MMA(1, 0, At, B0); PG8_BAR; PG8_SCHED;
            PG8_STAGE(PG8_SB(1, 1), b3 + hstepB, voffB);
            PG8_WAIT_V(6); PG8_BAR; PG8_MMA(1, 1, At, B1); PG8_BAR;
            }
        }
        if constexpr (ALIGN_EPI) { if (wr == 0) PG8_BAR; }
        if constexpr (!Epi::AFTER_DRAIN) { E(acc, cur, wr, wc, fr, fq); S.done(cur); }
        if (!has_next) break;
#pragma unroll
        for (int a = 0; a < 2; ++a)
#pragma unroll
            for (int b = 0; b < 2; ++b)
#pragma unroll
                for (int m = 0; m < 4; ++m)
#pragma unroll
                    for (int n = 0; n < 2; ++n) acc[a][b][m][n] = (f32x4){0.f, 0.f, 0.f, 0.f};
        cur = nxt; cA = nA; cB = nB; ++ui;
        if constexpr (ALIGN_EPI) { if (wr == 1) PG8_BAR; }
    }
    PG8_WAIT_V(0);
    if constexpr (!ALIGN_EPI) { if (wr == 0) PG8_BAR; }
    PG8_BAR;
    if constexpr (Epi::AFTER_DRAIN) { E.fused(acc, cur, wr, wc, fr, fq, lds, wid, lane); S.done(cur); }
#undef PG8_SA
#undef PG8_SB
#undef PG8_STAGE
#undef PG8_LDA
#undef PG8_LDB
#undef PG8_MMA
#undef PG8_WAIT_V
#undef PG8_WAIT_L
#undef PG8_BAR
#undef PG8_SCHED
}
}


struct RowBatch { u32x4 r[8][2]; };
__device__ __forceinline__ void batch_load(RowBatch& B, __amdgpu_buffer_rsrc_t T, int iv0, int iv1, int c, int voff) {
#pragma unroll
    for (int j = 0; j < 8; ++j) {
        const int n = 8 * c + j;
        const int e = __builtin_amdgcn_readlane(n < 64 ? iv0 : iv1, n & 63);
        B.r[j][0] = __builtin_amdgcn_raw_buffer_load_b128(T, voff, e * 2048, 0); B.r[j][1] = __builtin_amdgcn_raw_buffer_load_b128(T, voff + 1024, e * 2048, 0);
    }
}
template <bool FINAL>
__device__ __forceinline__ void p6_peer_opt(const Args& a, int layer, const bf16_t* H, const float* SSQ, bf16_t* Hout, float* RSout, int nrows, int gw, int nw, int lane) {
    const __amdgpu_buffer_rsrc_t UB = MKRSRC(a.ws + WS_UB + (size_t)layer * NEXP * D * 2, NEXP * D * 2);
    const __amdgpu_buffer_rsrc_t VB = MKRSRC(a.ws + WS_VB + (size_t)layer * NEXP * D * 2, NEXP * D * 2);
    const __amdgpu_buffer_rsrc_t IDXr = MKRSRC(a.ws + WS_IDX, RP * 128 * 4), GATEr = MKRSRC(a.ws + WS_GATE, RP * 128 * 4);
    const __amdgpu_buffer_rsrc_t Hr = MKRSRC(H, RP * D * 2), SSQr = MKRSRC(SSQ, RP * 16 * 4);
    const __amdgpu_buffer_rsrc_t Or = FINAL ? MKRSRC(a.out, XROWS * D * 4) : MKRSRC(Hout, RP * D * 2);
    const int voff = lane * 16, v4 = lane * 4;
    for (int row = gw; row < nrows; row += nw) {
        const int iv0 = __builtin_amdgcn_raw_buffer_load_b32(IDXr, v4, row * 512, 0), iv1 = __builtin_amdgcn_raw_buffer_load_b32(IDXr, v4 + 256, row * 512, 0);
        const float gv0 = __builtin_bit_cast(float, __builtin_amdgcn_raw_buffer_load_b32(GATEr, v4, row * 512, 0)), gv1 = __builtin_bit_cast(float, __builtin_amdgcn_raw_buffer_load_b32(GATEr, v4 + 256, row * 512, 0));
        RowBatch A, B;
        batch_load(A, UB, iv0, iv1, 0, voff);
        const u32x4 h0 = __builtin_amdgcn_raw_buffer_load_b128(Hr, voff, row * 2048, 0), h1 = __builtin_amdgcn_raw_buffer_load_b128(Hr, voff + 1024, row * 2048, 0);
        float hv[16];
#pragma unroll
        for (int j = 0; j < 4; ++j) { hv[2 * j] = bflo(h0[j]); hv[2 * j + 1] = bfhi(h0[j]); hv[8 + 2 * j] = bflo(h1[j]); hv[9 + 2 * j] = bfhi(h1[j]); }
        const float sq = __builtin_bit_cast(float, __builtin_amdgcn_raw_buffer_load_b32(SSQr, (lane & 15) * 4, row * 64, 0));
        const float rstd = rsqrtf(wave_sum(sq) * (0.25f / D) + EPS);
        float cc0 = 0.f, cc1 = 0.f;
#define PEER_DOTS(BUF, c) do { _Pragma("unroll") for (int j = 0; j < 8; ++j) { const int n = 8 * (c) + j; float ds = 0.f; \
            u32x4 r0 = BUF.r[j][0], r1 = BUF.r[j][1]; asm volatile("" : "+v"(r0), "+v"(r1), "+v"(cc0), "+v"(cc1));     \
            _Pragma("unroll") for (int q = 0; q < 4; ++q) ds += hv[2 * q] * bflo(r0[q]) + hv[2 * q + 1] * bfhi(r0[q]) + hv[8 + 2 * q] * bflo(r1[q]) + hv[9 + 2 * q] * bfhi(r1[q]); \
            ds = wave_sum(ds); const float act = gelu_tanh(ds * rstd); \
            cc0 = (lane == n) ? gv0 * act : cc0; cc1 = (lane == n - 64) ? gv1 * act : cc1; } } while (0)
#pragma unroll 1
        for (int c = 0; c < 16; c += 2) {
            batch_load(B, UB, iv0, iv1, c + 1, voff);
            PEER_DOTS(A, c);
            if (c + 2 < 16) batch_load(A, UB, iv0, iv1, c + 2, voff); else batch_load(A, VB, iv0, iv1, 0, voff);
            PEER_DOTS(B, c + 1);
        }
#undef PEER_DOTS
        float y[16];
#pragma unroll
        for (int j = 0; j < 16; ++j) y[j] = 0.f;
#define PEER_ACC(BUF, c) do { _Pragma("unroll") for (int j = 0; j < 8; ++j) { const int n = 8 * (c) + j; \
            const float cf = __builtin_bit_cast(float, __builtin_amdgcn_readlane(__builtin_bit_cast(int, n < 64 ? cc0 : cc1), n & 63)); \
            u32x4 r0 = BUF.r[j][0], r1 = BUF.r[j][1]; \
            asm volatile("" : "+v"(r0), "+v"(r1), "+v"(y[0]), "+v"(y[1]), "+v"(y[2]), "+v"(y[3]), "+v"(y[4]), "+v"(y[5]), "+v"(y[6]), "+v"(y[7]), "+v"(y[8]), "+v"(y[9]), "+v"(y[10]), "+v"(y[11]), "+v"(y[12]), "+v"(y[13]), "+v"(y[14]), "+v"(y[15])); \
            _Pragma("unroll") for (int q = 0; q < 4; ++q) { y[2 * q] += cf * bflo(r0[q]); y[2 * q + 1] += cf * bfhi(r0[q]); y[8 + 2 * q] += cf * bflo(r1[q]); y[9 + 2 * q] += cf * bfhi(r1[q]); } } } while (0)
#pragma unroll 1
        for (int c = 0; c < 16; c += 2) {
            batch_load(B, VB, iv0, iv1, c + 1, voff);
            PEER_ACC(A, c);
            if (c + 2 < 16) batch_load(A, VB, iv0, iv1, c + 2, voff);
            PEER_ACC(B, c + 1);
        }
#undef PEER_ACC
        {
            const u32x4 r0 = __builtin_amdgcn_raw_buffer_load_b128(Hr, voff, row * 2048, 0), r1 = __builtin_amdgcn_raw_buffer_load_b128(Hr, voff + 1024, row * 2048, 0);
#pragma unroll
            for (int j = 0; j < 4; ++j) { y[2 * j] += bflo(r0[j]); y[2 * j + 1] += bfhi(r0[j]); y[8 + 2 * j] += bflo(r1[j]); y[9 + 2 * j] += bfhi(r1[j]); }
        }
        if (FINAL) {
            const int v8 = lane * 32;
            __builtin_amdgcn_raw_buffer_store_b128(__builtin_bit_cast(u32x4, (f32x4){y[0], y[1], y[2], y[3]}), Or, v8, row * 4096, 0);
            __builtin_amdgcn_raw_buffer_store_b128(__builtin_bit_cast(u32x4, (f32x4){y[4], y[5], y[6], y[7]}), Or, v8 + 16, row * 4096, 0);
            __builtin_amdgcn_raw_buffer_store_b128(__builtin_bit_cast(u32x4, (f32x4){y[8], y[9], y[10], y[11]}), Or, v8 + 2048, row * 4096, 0);
            __builtin_amdgcn_raw_buffer_store_b128(__builtin_bit_cast(u32x4, (f32x4){y[12], y[13], y[14], y[15]}), Or, v8 + 2064, row * 4096, 0);
        } else {
            u32x4 w0, w1; float ss = 0.f;
#pragma unroll
            for (int j = 0; j < 4; ++j) { w0[j] = pk2(y[2 * j], y[2 * j + 1]); w1[j] = pk2(y[8 + 2 * j], y[9 + 2 * j]); }
#pragma unroll
            for (int j = 0; j < 4; ++j) { const float a0 = bflo(w0[j]), a1 = bfhi(w0[j]), b0 = bflo(w1[j]), b1 = bfhi(w1[j]); ss += a0 * a0 + a1 * a1 + b0 * b0 + b1 * b1; }
            ss = wave_sum(ss);
            __builtin_amdgcn_raw_buffer_store_b128(w0, Or, voff, row * 2048, 0); __builtin_amdgcn_raw_buffer_store_b128(w1, Or, voff + 1024, row * 2048, 0);
            if (lane == 0) RSout[row] = rsqrtf(ss * (1.f / D) + EPS);
        }
    }
}


typedef float f32x2 __attribute__((ext_vector_type(2)));
struct RowBatch8 { u32x4 r[16]; };
__device__ __forceinline__ void batch_load8(RowBatch8& B, __amdgpu_buffer_rsrc_t T, int iv0, int iv1, int c, int voff) {
#pragma unroll
    for (int j = 0; j < 16; ++j) {
        const int n = 16 * c + j;
        const int e = __builtin_amdgcn_readlane(n < 64 ? iv0 : iv1, n & 63);
        B.r[j] = __builtin_amdgcn_raw_buffer_load_b128(T, voff, e * 1024, 0);
    }
}
template <bool FINAL>
__device__ __forceinline__ void p6_peer8(const Args& a, int layer, const bf16_t* H, const float* SSQ, bf16_t* Hout, float* RSout, int nrows, int gw, int nw, int lane) {
    const __amdgpu_buffer_rsrc_t UB = MKRSRC(a.ws + WS_UB + (size_t)layer * NEXP * D, NEXP * D), VB = MKRSRC(a.ws + WS_VB + (size_t)layer * NEXP * D, NEXP * D);
    const __amdgpu_buffer_rsrc_t USr = MKRSRC(a.ws + WS_UB + 32 * MiB + (size_t)layer * NEXP * 4, NEXP * 4), VSr = MKRSRC(a.ws + WS_VB + 32 * MiB + (size_t)layer * NEXP * 4, NEXP * 4);
    const __amdgpu_buffer_rsrc_t IDXr = MKRSRC(a.ws + WS_IDX, RP * 128 * 4), GATEr = MKRSRC(a.ws + WS_GATE, RP * 128 * 4);
    const __amdgpu_buffer_rsrc_t Hr = MKRSRC(H, RP * D * 2), SSQr = MKRSRC(SSQ, RP * 16 * 4);
    const __amdgpu_buffer_rsrc_t Or = FINAL ? MKRSRC(a.out, XROWS * D * 4) : MKRSRC(Hout, RP * D * 2);
    const int voff = lane * 16, v4 = lane * 4, v32 = lane * 32;
    for (int row = gw; row < nrows; row += nw) {
        const int iv0 = __builtin_amdgcn_raw_buffer_load_b32(IDXr, v4, row * 512, 0), iv1 = __builtin_amdgcn_raw_buffer_load_b32(IDXr, v4 + 256, row * 512, 0);
        RowBatch8 A, B;
        batch_load8(A, UB, iv0, iv1, 0, voff);
        float gs0 = __builtin_bit_cast(float, __builtin_amdgcn_raw_buffer_load_b32(GATEr, v4, row * 512, 0)), gs1 = __builtin_bit_cast(float, __builtin_amdgcn_raw_buffer_load_b32(GATEr, v4 + 256, row * 512, 0));
        const float su0 = __builtin_bit_cast(float, __builtin_amdgcn_raw_buffer_load_b32(USr, iv0 * 4, 0, 0)), su1 = __builtin_bit_cast(float, __builtin_amdgcn_raw_buffer_load_b32(USr, iv1 * 4, 0, 0));
        gs0 *= __builtin_bit_cast(float, __builtin_amdgcn_raw_buffer_load_b32(VSr, iv0 * 4, 0, 0)); gs1 *= __builtin_bit_cast(float, __builtin_amdgcn_raw_buffer_load_b32(VSr, iv1 * 4, 0, 0));
        const u32x4 h0 = __builtin_amdgcn_raw_buffer_load_b128(Hr, v32, row * 2048, 0), h1 = __builtin_amdgcn_raw_buffer_load_b128(Hr, v32 + 16, row * 2048, 0);
        float hv[16];
#pragma unroll
        for (int j = 0; j < 4; ++j) { hv[2 * j] = bflo(h0[j]); hv[2 * j + 1] = bfhi(h0[j]); hv[8 + 2 * j] = bflo(h1[j]); hv[9 + 2 * j] = bfhi(h1[j]); }
        const float sq = __builtin_bit_cast(float, __builtin_amdgcn_raw_buffer_load_b32(SSQr, (lane & 15) * 4, row * 64, 0));
        const float rstd = rsqrtf(wave_sum(sq) * (0.25f / D) + EPS);
        const float rs0 = rstd * su0, rs1 = rstd * su1;
        float cc0 = 0.f, cc1 = 0.f;
        const bool b5 = (lane & 32) != 0, b4 = (lane & 16) != 0, b3 = (lane & 8) != 0, b2 = (lane & 4) != 0;
        const int el = (b5 ? 8 : 0) + (b4 ? 4 : 0) + (b3 ? 2 : 0) + (b2 ? 1 : 0);
        const int lsrc = ((lane >> 3) & 1) * 32 + ((lane >> 2) & 1) * 16 + ((lane >> 1) & 1) * 8 + (lane & 1) * 4;
#define PEER_DOTS8(BUF, c) do { float pd[16]; \
            _Pragma("unroll") for (int j = 0; j < 16; ++j) { float ds = 0.f; \
                u32x4 r0 = BUF.r[j]; if (j > 0) asm volatile("" : "+v"(r0), "+v"(pd[j - 1])); else asm volatile("" : "+v"(r0), "+v"(cc0), "+v"(cc1));     \
                _Pragma("unroll") for (int q = 0; q < 4; ++q) { const f32x2 lo = __builtin_amdgcn_cvt_pk_f32_fp8((int)r0[q], false), hh = __builtin_amdgcn_cvt_pk_f32_fp8((int)r0[q], true); \
                    ds += (hv[4 * q] * lo[0] + hv[4 * q + 1] * lo[1]) + (hv[4 * q + 2] * hh[0] + hv[4 * q + 3] * hh[1]); } \
                pd[j] = ds; } \
              \
            float q8[8], q4[4], q2[2]; \
            _Pragma("unroll") for (int j = 0; j < 8; ++j) { const float snd = b5 ? pd[j] : pd[j + 8], kp = b5 ? pd[j + 8] : pd[j]; q8[j] = kp + __shfl_xor(snd, 32); } \
            _Pragma("unroll") for (int j = 0; j < 4; ++j) { const float snd = b4 ? q8[j] : q8[j + 4], kp = b4 ? q8[j + 4] : q8[j]; q4[j] = kp + __shfl_xor(snd, 16); } \
            _Pragma("unroll") for (int j = 0; j < 2; ++j) { const float snd = b3 ? q4[j] : q4[j + 2], kp = b3 ? q4[j + 2] : q4[j]; q2[j] = kp + __shfl_xor(snd, 8); } \
            float q1 = (b2 ? q2[1] : q2[0]) + __shfl_xor(b2 ? q2[0] : q2[1], 4); \
            q1 += __shfl_xor(q1, 2); q1 += __shfl_xor(q1, 1); \
            const float rsv = __shfl((c) < 4 ? rs0 : rs1, 16 * ((c) & 3) + el);        \
            const float actv = __shfl(gelu_tanh(q1 * rsv), lsrc);                       \
            const bool mine = (lane >> 4) == ((c) & 3); \
            cc0 = (mine && (c) < 4) ? gs0 * actv : cc0; cc1 = (mine && (c) >= 4) ? gs1 * actv : cc1; } while (0)
#pragma unroll 1
        for (int c = 0; c < 8; c += 2) {
            batch_load8(B, UB, iv0, iv1, c + 1, voff);
            PEER_DOTS8(A, c);
            if (c + 2 < 8) batch_load8(A, UB, iv0, iv1, c + 2, voff); else batch_load8(A, VB, iv0, iv1, 0, voff);
            PEER_DOTS8(B, c + 1);
        }
#undef PEER_DOTS8
        float y[16];
#pragma unroll
        for (int j = 0; j < 16; ++j) y[j] = 0.f;
#define PEER_ACC8(BUF, c) do { _Pragma("unroll") for (int j = 0; j < 16; ++j) { const int n = 16 * (c) + j; \
            const float cf = __builtin_bit_cast(float, __builtin_amdgcn_readlane(__builtin_bit_cast(int, n < 64 ? cc0 : cc1), n & 63)); \
            u32x4 r0 = BUF.r[j]; \
            asm volatile("" : "+v"(r0), "+v"(y[0]), "+v"(y[1]), "+v"(y[2]), "+v"(y[3]), "+v"(y[4]), "+v"(y[5]), "+v"(y[6]), "+v"(y[7]), "+v"(y[8]), "+v"(y[9]), "+v"(y[10]), "+v"(y[11]), "+v"(y[12]), "+v"(y[13]), "+v"(y[14]), "+v"(y[15])); \
            _Pragma("unroll") for (int q = 0; q < 4; ++q) { const f32x2 lo = __builtin_amdgcn_cvt_pk_f32_fp8((int)r0[q], false), hh = __builtin_amdgcn_cvt_pk_f32_fp8((int)r0[q], true); \
                y[4 * q] += cf * lo[0]; y[4 * q + 1] += cf * lo[1]; y[4 * q + 2] += cf * hh[0]; y[4 * q + 3] += cf * hh[1]; } } } while (0)
#pragma unroll 1
        for (int c = 0; c < 8; c += 2) {
            batch_load8(B, VB, iv0, iv1, c + 1, voff);
            PEER_ACC8(A, c);
            if (c + 2 < 8) batch_load8(A, VB, iv0, iv1, c + 2, voff);
            PEER_ACC8(B, c + 1);
        }
#undef PEER_ACC8
        {
            const u32x4 r0 = __builtin_amdgcn_raw_buffer_load_b128(Hr, v32, row * 2048, 0), r1 = __builtin_amdgcn_raw_buffer_load_b128(Hr, v32 + 16, row * 2048, 0);
#pragma unroll
            for (int j = 0; j < 4; ++j) { y[2 * j] += bflo(r0[j]); y[2 * j + 1] += bfhi(r0[j]); y[8 + 2 * j] += bflo(r1[j]); y[9 + 2 * j] += bfhi(r1[j]); }
        }
        if (FINAL) {
            const int v64 = lane * 64;
#pragma unroll
            for (int q = 0; q < 4; ++q) __builtin_amdgcn_raw_buffer_store_b128(__builtin_bit_cast(u32x4, (f32x4){y[4 * q], y[4 * q + 1], y[4 * q + 2], y[4 * q + 3]}), Or, v64 + 16 * q, row * 4096, 0);
        } else {
            u32x4 w0, w1; float ss = 0.f;
#pragma unroll
            for (int j = 0; j < 4; ++j) { w0[j] = pk2(y[2 * j], y[2 * j + 1]); w1[j] = pk2(y[8 + 2 * j], y[9 + 2 * j]); }
#pragma unroll
            for (int j = 0; j < 4; ++j) { const float a0 = bflo(w0[j]), a1 = bfhi(w0[j]), b0 = bflo(w1[j]), b1 = bfhi(w1[j]); ss += a0 * a0 + a1 * a1 + b0 * b0 + b1 * b1; }
            ss = wave_sum(ss);
            __builtin_amdgcn_raw_buffer_store_b128(w0, Or, v32, row * 2048, 0); __builtin_amdgcn_raw_buffer_store_b128(w1, Or, v32 + 16, row * 2048, 0);
            if (lane == 0) RSout[row] = rsqrtf(ss * (1.f / D) + EPS);
        }
    }
}


struct RowBatch6 { u32x3 r[16]; };
template <bool F4> __device__ __forceinline__ void batch_load6(RowBatch6& B, __amdgpu_buffer_rsrc_t T, int iv0, int iv1, int c, int lane) {
#pragma unroll
    for (int j = 0; j < 16; ++j) {
        const int n = 16 * c + j;
        const int e = __builtin_amdgcn_readlane(n < 64 ? iv0 : iv1, n & 63);
        if (F4) { const u32x2 t = __builtin_amdgcn_raw_buffer_load_b64(T, lane * 8, e * 512, 0); B.r[j] = (u32x3){t[0], t[1], 0u}; }
        else B.r[j] = __builtin_amdgcn_raw_buffer_load_b96(T, lane * 12, e * 768, 0);
    }
}
template <bool FINAL>
__device__ __forceinline__ void p6_peer6(const Args& a, int layer, const bf16_t* H, const float* SSQ, bf16_t* Hout, float* RSout, int nrows, int gw, int nw, int lane) {
    const __amdgpu_buffer_rsrc_t UB = MKRSRC(a.ws + WS_UB + (size_t)layer * NEXP * USTRIDE, NEXP * USTRIDE), VB = MKRSRC(a.ws + WS_VB + (size_t)layer * NEXP * VSTRIDE, NEXP * VSTRIDE);
    const __amdgpu_buffer_rsrc_t USr = MKRSRC(a.ws + WS_UB + 32 * MiB + (size_t)layer * NEXP * 4, NEXP * 4), VSr = MKRSRC(a.ws + WS_VB + 32 * MiB + (size_t)layer * NEXP * 4, NEXP * 4);
    const __amdgpu_buffer_rsrc_t IDXr = MKRSRC(a.ws + WS_IDX, RP * 128 * 4), GATEr = MKRSRC(a.ws + WS_GATE, RP * 128 * 4);
    const __amdgpu_buffer_rsrc_t Hr = MKRSRC(H, RP * D * 2), SSQr = MKRSRC(SSQ, RP * 16 * 4);
    const __amdgpu_buffer_rsrc_t Or = FINAL ? MKRSRC(a.out, XROWS * D * 4) : MKRSRC(Hout, RP * D * 2);
    const int voff = lane, v4 = lane * 4, v32 = lane * 32;
    const bool b5 = (lane & 32) != 0, b4 = (lane & 16) != 0, b3 = (lane & 8) != 0, b2 = (lane & 4) != 0;
    const int el = (b5 ? 8 : 0) + (b4 ? 4 : 0) + (b3 ? 2 : 0) + (b2 ? 1 : 0);
    const int lsrc = ((lane >> 3) & 1) * 32 + ((lane >> 2) & 1) * 16 + ((lane >> 1) & 1) * 8 + (lane & 1) * 4;
    for (int row = gw; row < nrows; row += nw) {
        const int iv0 = __builtin_amdgcn_raw_buffer_load_b32(IDXr, v4, row * 512, 0), iv1 = __builtin_amdgcn_raw_buffer_load_b32(IDXr, v4 + 256, row * 512, 0);
        RowBatch6 A, B;
        batch_load6<U4>(A, UB, iv0, iv1, 0, voff);
        float gs0 = __builtin_bit_cast(float, __builtin_amdgcn_raw_buffer_load_b32(GATEr, v4, row * 512, 0)), gs1 = __builtin_bit_cast(float, __builtin_amdgcn_raw_buffer_load_b32(GATEr, v4 + 256, row * 512, 0));
        const float su0 = __builtin_bit_cast(float, __builtin_amdgcn_raw_buffer_load_b32(USr, iv0 * 4, 0, 0)), su1 = __builtin_bit_cast(float, __builtin_amdgcn_raw_buffer_load_b32(USr, iv1 * 4, 0, 0));
        gs0 *= __builtin_bit_cast(float, __builtin_amdgcn_raw_buffer_load_b32(VSr, iv0 * 4, 0, 0)); gs1 *= __builtin_bit_cast(float, __builtin_amdgcn_raw_buffer_load_b32(VSr, iv1 * 4, 0, 0));
        const u32x4 h0 = __builtin_amdgcn_raw_buffer_load_b128(Hr, v32, row * 2048, 0), h1 = __builtin_amdgcn_raw_buffer_load_b128(Hr, v32 + 16, row * 2048, 0);
        float hv[16];
#pragma unroll
        for (int j = 0; j < 4; ++j) { hv[2 * j] = bflo(h0[j]); hv[2 * j + 1] = bfhi(h0[j]); hv[8 + 2 * j] = bflo(h1[j]); hv[9 + 2 * j] = bfhi(h1[j]); }
        const float sq = __builtin_bit_cast(float, __builtin_amdgcn_raw_buffer_load_b32(SSQr, (lane & 15) * 4, row * 64, 0));
        const float rstd = rsqrtf(wave_sum(sq) * (0.25f / D) + EPS);
        const float rs0 = rstd * su0, rs1 = rstd * su1;
        float cc0 = 0.f, cc1 = 0.f;
#define PEER_DOTS6(BUF, c) do { float pd[16]; \
            _Pragma("unroll") for (int j = 0; j < 16; j += 2) { \
                u32x6 s6 = (u32x6){BUF.r[j][0], BUF.r[j][1], BUF.r[j][2], BUF.r[j + 1][0], BUF.r[j + 1][1], BUF.r[j + 1][2]}; \
                if (j > 0) asm volatile("" : "+v"(s6), "+v"(pd[j - 1])); else asm volatile("" : "+v"(s6), "+v"(cc0), "+v"(cc1));     \
                float d0 = 0.f, d1 = 0.f; \
                if (U4) { _Pragma("unroll") for (int w = 0; w < 2; ++w) { \
                        { const f32x2 e0 = __builtin_amdgcn_cvt_scalef32_pk_f32_fp4(s6[w], 1.0f, 0), e1 = __builtin_amdgcn_cvt_scalef32_pk_f32_fp4(s6[w], 1.0f, 1), e2 = __builtin_amdgcn_cvt_scalef32_pk_f32_fp4(s6[w], 1.0f, 2), e3 = __builtin_amdgcn_cvt_scalef32_pk_f32_fp4(s6[w], 1.0f, 3); \
                          d0 += (hv[8 * w] * e0[0] + hv[8 * w + 1] * e0[1]) + (hv[8 * w + 2] * e1[0] + hv[8 * w + 3] * e1[1]) + (hv[8 * w + 4] * e2[0] + hv[8 * w + 5] * e2[1]) + (hv[8 * w + 6] * e3[0] + hv[8 * w + 7] * e3[1]); } \
                        { const f32x2 e0 = __builtin_amdgcn_cvt_scalef32_pk_f32_fp4(s6[3 + w], 1.0f, 0), e1 = __builtin_amdgcn_cvt_scalef32_pk_f32_fp4(s6[3 + w], 1.0f, 1), e2 = __builtin_amdgcn_cvt_scalef32_pk_f32_fp4(s6[3 + w], 1.0f, 2), e3 = __builtin_amdgcn_cvt_scalef32_pk_f32_fp4(s6[3 + w], 1.0f, 3); \
                          d1 += (hv[8 * w] * e0[0] + hv[8 * w + 1] * e0[1]) + (hv[8 * w + 2] * e1[0] + hv[8 * w + 3] * e1[1]) + (hv[8 * w + 4] * e2[0] + hv[8 * w + 5] * e2[1]) + (hv[8 * w + 6] * e3[0] + hv[8 * w + 7] * e3[1]); } } \
                } else { const f32x32 dv = __builtin_amdgcn_cvt_scalef32_pk32_f32_fp6(s6, 1.0f); \
                    _Pragma("unroll") for (int i = 0; i < 16; ++i) { d0 += hv[i] * dv[i]; d1 += hv[i] * dv[16 + i]; } } \
                pd[j] = d0; pd[j + 1] = d1; } \
              \
            float q8[8], q4[4], q2[2]; \
            _Pragma("unroll") for (int j = 0; j < 8; ++j) { const float snd = b5 ? pd[j] : pd[j + 8], kp = b5 ? pd[j + 8] : pd[j]; q8[j] = kp + __shfl_xor(snd, 32); } \
            _Pragma("unroll") for (int j = 0; j < 4; ++j) { const float snd = b4 ? q8[j] : q8[j + 4], kp = b4 ? q8[j + 4] : q8[j]; q4[j] = kp + __shfl_xor(snd, 16); } \
            _Pragma("unroll") for (int j = 0; j < 2; ++j) { const float snd = b3 ? q4[j] : q4[j + 2], kp = b3 ? q4[j + 2] : q4[j]; q2[j] = kp + __shfl_xor(snd, 8); } \
            float q1 = (b2 ? q2[1] : q2[0]) + __shfl_xor(b2 ? q2[0] : q2[1], 4); \
            q1 += __shfl_xor(q1, 2); q1 += __shfl_xor(q1, 1); \
            const float rsv = __shfl((c) < 4 ? rs0 : rs1, 16 * ((c) & 3) + el);        \
            const float actv = __shfl(gelu_tanh(q1 * rsv), lsrc);                       \
            const bool mine = (lane >> 4) == ((c) & 3); \
            cc0 = (mine && (c) < 4) ? gs0 * actv : cc0; cc1 = (mine && (c) >= 4) ? gs1 * actv : cc1; } while (0)
#pragma unroll 1
        for (int c = 0; c < 8; c += 2) {
            batch_load6<U4>(B, UB, iv0, iv1, c + 1, voff);
            PEER_DOTS6(A, c);
            if (c + 2 < 8) batch_load6<U4>(A, UB, iv0, iv1, c + 2, voff); else batch_load6<V4>(A, VB, iv0, iv1, 0, voff);
            PEER_DOTS6(B, c + 1);
        }
#undef PEER_DOTS6
        float y[16];
#pragma unroll
        for (int j = 0; j < 16; ++j) y[j] = 0.f;
#define ACC4_BYTE(w, bb) do { const f32x2 e0 = __builtin_amdgcn_cvt_scalef32_pk_f32_fp4(s6[w], 1.0f, bb), e1 = __builtin_amdgcn_cvt_scalef32_pk_f32_fp4(s6[3 + w], 1.0f, bb); \
            y[8 * (w) + 2 * (bb)] += cf0 * e0[0] + cf1 * e1[0]; y[8 * (w) + 2 * (bb) + 1] += cf0 * e0[1] + cf1 * e1[1]; } while (0)
#define PEER_ACC6(BUF, c) do { _Pragma("unroll") for (int j = 0; j < 16; j += 2) { const int n = 16 * (c) + j; \
            const float cf0 = __builtin_bit_cast(float, __builtin_amdgcn_readlane(__builtin_bit_cast(int, n < 64 ? cc0 : cc1), n & 63)); \
            const float cf1 = __builtin_bit_cast(float, __builtin_amdgcn_readlane(__builtin_bit_cast(int, n < 64 ? cc0 : cc1), (n + 1) & 63)); \
            u32x6 s6 = (u32x6){BUF.r[j][0], BUF.r[j][1], BUF.r[j][2], BUF.r[j + 1][0], BUF.r[j + 1][1], BUF.r[j + 1][2]}; \
            asm volatile("" : "+v"(s6), "+v"(y[0]), "+v"(y[1]), "+v"(y[2]), "+v"(y[3]), "+v"(y[4]), "+v"(y[5]), "+v"(y[6]), "+v"(y[7]), "+v"(y[8]), "+v"(y[9]), "+v"(y[10]), "+v"(y[11]), "+v"(y[12]), "+v"(y[13]), "+v"(y[14]), "+v"(y[15])); \
            if (V4) { _Pragma("unroll") for (int w = 0; w < 2; ++w) { \
                    ACC4_BYTE(w, 0); ACC4_BYTE(w, 1); ACC4_BYTE(w, 2); ACC4_BYTE(w, 3); } \
            } else { const f32x32 dv = __builtin_amdgcn_cvt_scalef32_pk32_f32_fp6(s6, 1.0f); \
                _Pragma("unroll") for (int i = 0; i < 16; ++i) y[i] += cf0 * dv[i] + cf1 * dv[16 + i]; } } } while (0)
#pragma unroll 1
        for (int c = 0; c < 8; c += 2) {
            batch_load6<V4>(B, VB, iv0, iv1, c + 1, voff);
            PEER_ACC6(A, c);
            if (c + 2 < 8) batch_load6<V4>(A, VB, iv0, iv1, c + 2, voff);
            PEER_ACC6(B, c + 1);
        }
#undef PEER_ACC6
        {
            const u32x4 r0 = __builtin_amdgcn_raw_buffer_load_b128(Hr, v32, row * 2048, 0), r1 = __builtin_amdgcn_raw_buffer_load_b128(Hr, v32 + 16, row * 2048, 0);
#pragma unroll
            for (int j = 0; j < 4; ++j) { y[2 * j] += bflo(r0[j]); y[2 * j + 1] += bfhi(r0[j]); y[8 + 2 * j] += bflo(r1[j]); y[9 + 2 * j] += bfhi(r1[j]); }
        }
        if (FINAL) {
            const int v64 = lane * 64;
#pragma unroll
            for (int q = 0; q < 4; ++q) __builtin_amdgcn_raw_buffer_store_b128(__builtin_bit_cast(u32x4, (f32x4){y[4 * q], y[4 * q + 1], y[4 * q + 2], y[4 * q + 3]}), Or, v64 + 16 * q, row * 4096, 0);
        } else {
            u32x4 w0, w1; float ss = 0.f;
#pragma unroll
            for (int j = 0; j < 4; ++j) { w0[j] = pk2(y[2 * j], y[2 * j + 1]); w1[j] = pk2(y[8 + 2 * j], y[9 + 2 * j]); }
#pragma unroll
            for (int j = 0; j < 4; ++j) { const float a0 = bflo(w0[j]), a1 = bfhi(w0[j]), b0 = bflo(w1[j]), b1 = bfhi(w1[j]); ss += a0 * a0 + a1 * a1 + b0 * b0 + b1 * b1; }
            ss = wave_sum(ss);
            __builtin_amdgcn_raw_buffer_store_b128(w0, Or, v32, row * 2048, 0); __builtin_amdgcn_raw_buffer_store_b128(w1, Or, v32 + 16, row * 2048, 0);
            if (lane == 0) RSout[row] = rsqrtf(ss * (1.f / D) + EPS);
        }
    }
}


constexpr int CQ_MAXR = 17, CQ_WLDS = CQ_MAXR * 1024 + 128;
struct QBatch { u32x3 r[8]; };
template <bool FINAL>
__device__ __forceinline__ void p6_peer_cq(const Args& a, int layer, const bf16_t* H, const float* SSQ, bf16_t* Hout, float* RSout, int nrows, LAS unsigned char* lds) {
    const int tid = opaque_tid(), lane = tid & 63, wave = __builtin_amdgcn_readfirstlane(tid >> 6), slot = lane >> 4, chunk = lane & 15;
    const int gw = wave * (int)gridDim.x + (int)blockIdx.x, nw = (int)gridDim.x * 8;
    const int nk = gw < nrows ? (nrows - gw + nw - 1) / nw : 0;
    LAS int* IDXL = (LAS int*)(lds + wave * CQ_WLDS); LAS float* CL = (LAS float*)(lds + wave * CQ_WLDS + CQ_MAXR * 512); LAS float* RSL = (LAS float*)(lds + wave * CQ_WLDS + CQ_MAXR * 1024);
    const __amdgpu_buffer_rsrc_t USr = MKRSRC(a.ws + WS_UB + 32 * MiB + (size_t)layer * NEXP * 4, NEXP * 4), VSr = MKRSRC(a.ws + WS_VB + 32 * MiB + (size_t)layer * NEXP * 4, NEXP * 4);
    const __amdgpu_buffer_rsrc_t IDXr = MKRSRC(a.ws + WS_IDX, RP * 128 * 4), GATEr = MKRSRC(a.ws + WS_GATE, RP * 128 * 4);
    const __amdgpu_buffer_rsrc_t Hr = MKRSRC(H, RP * D * 2), SSQr = MKRSRC(SSQ, RP * 16 * 4);
    const __amdgpu_buffer_rsrc_t Or = FINAL ? MKRSRC(a.out, XROWS * D * 4) : MKRSRC(Hout, RP * D * 2);
    const bool b3 = (chunk & 8) != 0, b2 = (chunk & 4) != 0, b1 = (chunk & 2) != 0, b0 = (chunk & 1) != 0, s1 = (slot & 2) != 0, s0 = (slot & 1) != 0;
    const int c12 = chunk * 12;
    for (int k0 = 0; k0 < nk; k0 += 6) {
        int t0[6], t1[6];
#pragma unroll
        for (int j = 0; j < 6; ++j) { const int kk = k0 + j < nk ? k0 + j : nk - 1, row = gw + kk * nw;
            t0[j] = __builtin_amdgcn_raw_buffer_load_b32(IDXr, lane * 4, row * 512, 0); t1[j] = __builtin_amdgcn_raw_buffer_load_b32(IDXr, lane * 4 + 256, row * 512, 0); }
#pragma unroll
        for (int j = 0; j < 6; ++j) if (k0 + j < nk) { IDXL[(k0 + j) * 128 + lane] = t0[j]; IDXL[(k0 + j) * 128 + 64 + lane] = t1[j]; }
    }
#define CQ_LOAD(BUF, T, kk, bt) do { int ev[8]; _Pragma("unroll") for (int j = 0; j < 8; ++j) ev[j] = IDXL[(kk) * 128 + 32 * (bt) + 4 * j + slot]; \
        asm volatile("" : "+v"(ev[0]), "+v"(ev[1]), "+v"(ev[2]), "+v"(ev[3]), "+v"(ev[4]), "+v"(ev[5]), "+v"(ev[6]), "+v"(ev[7]));     \
        _Pragma("unroll") for (int j = 0; j < 8; ++j) BUF.r[j] = __builtin_amdgcn_raw_buffer_load_b96(T, ev[j] * 192 + c12, 0, 0); } while (0)
#define CQ_TAB(base, qq) MKRSRC(a.ws + (base) + ((size_t)layer * 4 + (qq)) * NEXP * 192, NEXP * 192)
    const int total = 4 * nk;
    if (U8 && nk > 0) {
        const int slot8 = lane >> 3, chunk8 = lane & 7;
        const bool c2 = (chunk8 & 4) != 0, c1 = (chunk8 & 2) != 0, c0 = (chunk8 & 1) != 0;
        const __amdgpu_buffer_rsrc_t H8r = MKRSRC(a.ws + WS_P1, RP * 1024);
        LAS int* CLI = (LAS int*)CL; LAS float* HSL = RSL;
        for (int k0 = 0; k0 < nk; k0 += 4) {
            u32x4 ha[4], hb[4];
#pragma unroll
            for (int j = 0; j < 4; ++j) { const int kk = k0 + j < nk ? k0 + j : nk - 1, row = gw + kk * nw;
                ha[j] = __builtin_amdgcn_raw_buffer_load_b128(Hr, lane * 32, row * 2048, 0); hb[j] = __builtin_amdgcn_raw_buffer_load_b128(Hr, lane * 32 + 16, row * 2048, 0); }
#pragma unroll
            for (int j = 0; j < 4; ++j) if (k0 + j < nk) { const int row = gw + (k0 + j) * nw;
                float hv[16], am = 0.f;
#pragma unroll
                for (int i = 0; i < 4; ++i) { hv[2 * i] = bflo(ha[j][i]); hv[2 * i + 1] = bfhi(ha[j][i]); hv[8 + 2 * i] = bflo(hb[j][i]); hv[9 + 2 * i] = bfhi(hb[j][i]); }
#pragma unroll
                for (int i = 0; i < 16; ++i) am = fmaxf(am, fabsf(hv[i]));
#pragma unroll
                for (int o = 1; o < 64; o <<= 1) am = fmaxf(am, __shfl_xor(am, o));
                const float sc = am > 0.f ? am * (UI4 ? 1.f / 119.f : 1.f / 127.f) : 1.f, inv = 1.f / sc;
                unsigned w[4] = {0u, 0u, 0u, 0u};
                if (UI4) {
#pragma unroll
                    for (int i = 0; i < 16; ++i) { const int q = (int)__builtin_rintf(hv[i] * inv), hl = ((q + 8) & 15) - 8, hh = (q - hl) >> 4;
                        w[i >> 3] |= ((unsigned)hh & 0xfu) << (4 * (i & 7)); w[2 + (i >> 3)] |= ((unsigned)hl & 0xfu) << (4 * (i & 7)); }
                    __builtin_amdgcn_raw_buffer_store_b64((u32x2){w[0], w[1]}, H8r, lane * 8, row * 1024, 0); __builtin_amdgcn_raw_buffer_store_b64((u32x2){w[2], w[3]}, H8r, 512 + lane * 8, row * 1024, 0);
                } else {
#pragma unroll
                    for (int i = 0; i < 16; ++i) { const int q = (int)__builtin_rintf(hv[i] * inv); w[i >> 2] |= ((unsigned)q & 0xffu) << (8 * (i & 3)); }
                    __builtin_amdgcn_raw_buffer_store_b128((u32x4){w[0], w[1], w[2], w[3]}, H8r, lane * 16, row * 1024, 0);
                }
                if (lane == 0) HSL[k0 + j] = sc; }
        }
        __threadfence_block();
        struct UB4 { u32x4 r[4]; };
        constexpr int NSW = UI4 ? 4 : 8;
#define U8_TAB(ee) MKRSRC(a.ws + WS_UB + ((size_t)layer * NSW + (ee)) * NEXP * 128, NEXP * 128)
#define U8_LOAD(BUF, T, kk, bt) do { int ev[4]; _Pragma("unroll") for (int j = 0; j < 4; ++j) ev[j] = IDXL[(kk) * 128 + 32 * (bt) + 8 * j + slot8]; \
            asm volatile("" : "+v"(ev[0]), "+v"(ev[1]), "+v"(ev[2]), "+v"(ev[3])); \
            _Pragma("unroll") for (int j = 0; j < 4; ++j) BUF.r[j] = __builtin_amdgcn_raw_buffer_load_b128(T, ev[j] * 128 + chunk8 * 16, 0, 0); } while (0)
#define U8_DOTS(BUF, bt) do { _Pragma("unroll") for (int j = 0; j < 4; ++j) { const u32x4 w4 = BUF.r[j]; \
            if (UI4) { const int ah = __builtin_amdgcn_sdot8((int)w4[3], (int)h8[3], __builtin_amdgcn_sdot8((int)w4[2], (int)h8[2], __builtin_amdgcn_sdot8((int)w4[1], (int)h8[1], __builtin_amdgcn_sdot8((int)w4[0], (int)h8[0], 0, false), false), false), false); \
                const int al = __builtin_amdgcn_sdot8((int)w4[3], (int)h8l[3], __builtin_amdgcn_sdot8((int)w4[2], (int)h8l[2], __builtin_amdgcn_sdot8((int)w4[1], (int)h8l[1], __builtin_amdgcn_sdot8((int)w4[0], (int)h8l[0], 0, false), false), false), false); \
                pd[4 * (bt) + j] = ah * 16 + al; } \
            else pd[4 * (bt) + j] = __builtin_amdgcn_sdot4((int)w4[3], (int)h8[3], __builtin_amdgcn_sdot4((int)w4[2], (int)h8[2], __builtin_amdgcn_sdot4((int)w4[1], (int)h8[1], __builtin_amdgcn_sdot4((int)w4[0], (int)h8[0], 0, false), false), false), false); } } while (0)
        UB4 A0, A1, A2, A3; u32x4 h8n, h8ln = (u32x4){0u, 0u, 0u, 0u};
        { const __amdgpu_buffer_rsrc_t T0 = U8_TAB(0);
          h8n = __builtin_amdgcn_raw_buffer_load_b128(H8r, chunk8 * 16, gw * 1024, 0);
          if (UI4) h8ln = __builtin_amdgcn_raw_buffer_load_b128(H8r, 512 + chunk8 * 16, gw * 1024, 0);
          U8_LOAD(A0, T0, 0, 0); U8_LOAD(A1, T0, 0, 1); U8_LOAD(A2, T0, 0, 2); U8_LOAD(A3, T0, 0, 3); }
        const int total8 = NSW * nk;
        int e = 0, k = 0;
#pragma unroll 1
        for (int f = 0; f < total8; ++f) {
            const int row = gw + k * nw;
            const u32x4 h8 = h8n, h8l = h8ln;
            const int ib = 8 * (c2 ? 1 : 0) + 4 * (c1 ? 1 : 0) + 2 * (c0 ? 1 : 0);
            float fus[2] = {0.f, 0.f}, fvs[2] = {0.f, 0.f}, fg[2] = {0.f, 0.f}, fsq = 0.f;
            if (e == NSW - 1) {
                fsq = __builtin_bit_cast(float, __builtin_amdgcn_raw_buffer_load_b32(SSQr, (lane & 15) * 4, row * 64, 0));
#pragma unroll
                for (int m = 0; m < 2; ++m) { const int n = 8 * (ib + m) + slot8, ex = IDXL[k * 128 + n];
                    fus[m] = __builtin_bit_cast(float, __builtin_amdgcn_raw_buffer_load_b32(USr, ex * 4, 0, 0)); fvs[m] = __builtin_bit_cast(float, __builtin_amdgcn_raw_buffer_load_b32(VSr, ex * 4, 0, 0));
                    fg[m] = __builtin_bit_cast(float, __builtin_amdgcn_raw_buffer_load_b32(GATEr, n * 4, row * 512, 0)); }
            }
            int kn = k + 1, en = e; if (kn == nk) { kn = 0; ++en; }
            if (f + 1 == total8) { kn = k; en = e; }
            const __amdgpu_buffer_rsrc_t TN = U8_TAB(en);
            int pd[16];
            U8_DOTS(A0, 0);
            h8n = __builtin_amdgcn_raw_buffer_load_b128(H8r, en * 128 + chunk8 * 16, (gw + kn * nw) * 1024, 0);
            if (UI4) h8ln = __builtin_amdgcn_raw_buffer_load_b128(H8r, 512 + en * 128 + chunk8 * 16, (gw + kn * nw) * 1024, 0);
            U8_LOAD(A0, TN, kn, 0);
            U8_DOTS(A1, 1); U8_LOAD(A1, TN, kn, 1);
            U8_DOTS(A2, 2); U8_LOAD(A2, TN, kn, 2);
            U8_DOTS(A3, 3); U8_LOAD(A3, TN, kn, 3);
            int q8[8], q4[4], q2[2];
#pragma unroll
            for (int j = 0; j < 8; ++j) { const int snd = c2 ? pd[j] : pd[j + 8], kp = c2 ? pd[j + 8] : pd[j]; q8[j] = kp + __shfl_xor(snd, 4); }
#pragma unroll
            for (int j = 0; j < 4; ++j) { const int snd = c1 ? q8[j] : q8[j + 4], kp = c1 ? q8[j + 4] : q8[j]; q4[j] = kp + __builtin_amdgcn_update_dpp(0, snd, 0x4E, 0xF, 0xF, true); }
#pragma unroll
            for (int j = 0; j < 2; ++j) { const int snd = c0 ? q4[j] : q4[j + 2], kp = c0 ? q4[j + 2] : q4[j]; q2[j] = kp + __builtin_amdgcn_update_dpp(0, snd, 0xB1, 0xF, 0xF, true); }
            if (e < NSW - 1) {
#pragma unroll
                for (int m = 0; m < 2; ++m) { const int ad = k * 128 + 8 * (ib + m) + slot8; CLI[ad] = e == 0 ? q2[m] : CLI[ad] + q2[m]; }
            } else {
                const float rstd = rsqrtf(wave_sum(fsq) * (0.25f / D) + EPS), hs = HSL[k];
#pragma unroll
                for (int m = 0; m < 2; ++m) { const int ad = k * 128 + 8 * (ib + m) + slot8;
                    const float dot = (float)(CLI[ad] + q2[m]) * hs;
                    CL[ad] = fg[m] * fvs[m] * gelu_tanh(dot * rstd * fus[m]); }
            }
            k = kn; e = en;
        }
#undef U8_TAB
#undef U8_LOAD
#undef U8_DOTS
    }
    if (!U8 && nk > 0) {
        QBatch A0, A1, A2, A3; u32x4 hn0, hn1;
        { const __amdgpu_buffer_rsrc_t T0 = CQ_TAB(WS_UB, 0);
          hn0 = __builtin_amdgcn_raw_buffer_load_b128(Hr, chunk * 32, gw * 2048, 0); hn1 = __builtin_amdgcn_raw_buffer_load_b128(Hr, chunk * 32 + 16, gw * 2048, 0);
          CQ_LOAD(A0, T0, 0, 0); CQ_LOAD(A1, T0, 0, 1); CQ_LOAD(A2, T0, 0, 2); CQ_LOAD(A3, T0, 0, 3); }
        int q = 0, k = 0;
#pragma unroll 1
        for (int f = 0; f < total; ++f) {
            const int row = gw + k * nw;
            float hv[16];
#pragma unroll
            for (int j = 0; j < 4; ++j) { hv[2 * j] = bflo(hn0[j]); hv[2 * j + 1] = bfhi(hn0[j]); hv[8 + 2 * j] = bflo(hn1[j]); hv[9 + 2 * j] = bfhi(hn1[j]); }
            float pd[16], chain = 0.f;
            float fus[2] = {0.f, 0.f}, fvs[2] = {0.f, 0.f}, fg[2] = {0.f, 0.f}, fsq = 0.f;
            if (q == 3) {
                fsq = __builtin_bit_cast(float, __builtin_amdgcn_raw_buffer_load_b32(SSQr, chunk * 4, row * 64, 0));
#pragma unroll
                for (int m = 0; m < 2; ++m) { const int n = 64 * m + 4 * chunk + slot, e = IDXL[k * 128 + n];
                    fus[m] = __builtin_bit_cast(float, __builtin_amdgcn_raw_buffer_load_b32(USr, e * 4, 0, 0)); fvs[m] = __builtin_bit_cast(float, __builtin_amdgcn_raw_buffer_load_b32(VSr, e * 4, 0, 0));
                    fg[m] = __builtin_bit_cast(float, __builtin_amdgcn_raw_buffer_load_b32(GATEr, n * 4, row * 512, 0)); }
            }
#define CQ_DOTS(BUF, base) do { _Pragma("unroll") for (int j = 0; j < 8; j += 2) { \
                u32x6 s6 = (u32x6){BUF.r[j][0], BUF.r[j][1], BUF.r[j][2], BUF.r[j + 1][0], BUF.r[j + 1][1], BUF.r[j + 1][2]}; \
                asm volatile("" : "+v"(s6), "+v"(chain));     \
                const f32x32 dv = __builtin_amdgcn_cvt_scalef32_pk32_f32_fp6(s6, 1.0f); f32x2 d0 = (f32x2){0.f, 0.f}, d1 = (f32x2){0.f, 0.f}; \
                _Pragma("unroll") for (int i = 0; i < 8; ++i) { const f32x2 h2 = (f32x2){hv[2 * i], hv[2 * i + 1]}; \
                    d0 = __builtin_elementwise_fma(h2, (f32x2){dv[2 * i], dv[2 * i + 1]}, d0); d1 = __builtin_elementwise_fma(h2, (f32x2){dv[16 + 2 * i], dv[17 + 2 * i]}, d1); } \
                pd[(base) + j] = d0[0] + d0[1]; pd[(base) + j + 1] = d1[0] + d1[1]; chain = pd[(base) + j + 1]; } } while (0)
#define CQ_REDUCE(m) do { float q8[8], q4[4], q2[2]; \
                _Pragma("unroll") for (int j = 0; j < 8; ++j) { const float snd = b3 ? pd[j] : pd[j + 8], kp = b3 ? pd[j + 8] : pd[j]; q8[j] = kp + dpp_xor8(snd); } \
                _Pragma("unroll") for (int j = 0; j < 4; ++j) { const float snd = b2 ? q8[j] : q8[j + 4], kp = b2 ? q8[j + 4] : q8[j]; q4[j] = kp + __shfl_xor(snd, 4); } \
                _Pragma("unroll") for (int j = 0; j < 2; ++j) { const float snd = b1 ? q4[j] : q4[j + 2], kp = b1 ? q4[j + 2] : q4[j]; q2[j] = kp + dpp_xor2(snd); } \
                const float q1 = (b0 ? q2[1] : q2[0]) + dpp_xor1(b0 ? q2[0] : q2[1]); \
                const int ad = k * 128 + 64 * (m) + 4 * chunk + slot; CL[ad] = q == 0 ? q1 : CL[ad] + q1; } while (0)
            int kn = k + 1, qn = q; if (kn == nk) { kn = 0; ++qn; }
            if (f + 1 == total) { kn = k; qn = q; }
            const __amdgpu_buffer_rsrc_t TN = CQ_TAB(WS_UB, qn);
            CQ_DOTS(A0, 0);
            { const int rn = gw + kn * nw; hn0 = __builtin_amdgcn_raw_buffer_load_b128(Hr, qn * 512 + chunk * 32, rn * 2048, 0); hn1 = __builtin_amdgcn_raw_buffer_load_b128(Hr, qn * 512 + chunk * 32 + 16, rn * 2048, 0); }
            CQ_LOAD(A0, TN, kn, 0);
            CQ_DOTS(A1, 8); CQ_LOAD(A1, TN, kn, 1); CQ_REDUCE(0);
            CQ_DOTS(A2, 0); CQ_LOAD(A2, TN, kn, 2);
            CQ_DOTS(A3, 8); CQ_LOAD(A3, TN, kn, 3); CQ_REDUCE(1);
            if (q == 3) {
                const float rstd = rsqrtf(wave_sum(fsq) * (0.25f / D) + EPS);
#pragma unroll
                for (int m = 0; m < 2; ++m) { const int ad = k * 128 + 64 * m + 4 * chunk + slot;
                    CL[ad] = fg[m] * fvs[m] * gelu_tanh(CL[ad] * rstd * fus[m]); }
            }
            k = kn; q = qn;
        }
#undef CQ_DOTS
#undef CQ_REDUCE
    }
    if (V4 && nk > 0) {
        const int slot8 = lane >> 3, chunk8 = lane & 7;
        const bool t2 = (slot8 & 4) != 0, t1 = (slot8 & 2) != 0, t0 = (slot8 & 1) != 0;
        struct VB4 { u32x4 r[4]; };
#define V4_TAB(qq) MKRSRC(a.ws + WS_VB + ((size_t)layer * 4 + (qq)) * NEXP * 128, NEXP * 128)
#define V4_LOAD(BUF, T, kk, bt) do { int ev[4]; _Pragma("unroll") for (int j = 0; j < 4; ++j) ev[j] = IDXL[(kk) * 128 + 32 * (bt) + 8 * j + slot8]; \
            asm volatile("" : "+v"(ev[0]), "+v"(ev[1]), "+v"(ev[2]), "+v"(ev[3])); \
            _Pragma("unroll") for (int j = 0; j < 4; ++j) BUF.r[j] = __builtin_amdgcn_raw_buffer_load_b128(T, ev[j] * 128 + chunk8 * 16, 0, 0); } while (0)
#define V4_DEC(W, E, o) do { E[(o) + 0] = __builtin_amdgcn_cvt_scalef32_pk_f32_fp4(W, 1.0f, 0); E[(o) + 1] = __builtin_amdgcn_cvt_scalef32_pk_f32_fp4(W, 1.0f, 1); E[(o) + 2] = __builtin_amdgcn_cvt_scalef32_pk_f32_fp4(W, 1.0f, 2); E[(o) + 3] = __builtin_amdgcn_cvt_scalef32_pk_f32_fp4(W, 1.0f, 3); } while (0)
#define V4_ACC(BUF, bt) do { float cf[4]; _Pragma("unroll") for (int j = 0; j < 4; ++j) cf[j] = CL[k * 128 + 32 * (bt) + 8 * j + slot8]; \
            asm volatile("" : "+v"(cf[0]), "+v"(cf[1]), "+v"(cf[2]), "+v"(cf[3])); \
            _Pragma("unroll") for (int j = 0; j < 4; ++j) { u32x4 w4 = BUF.r[j]; asm volatile("" : "+v"(w4), "+v"(y2[0]), "+v"(y2[15])); \
                f32x2 e[16]; V4_DEC(w4[0], e, 0); V4_DEC(w4[1], e, 4); V4_DEC(w4[2], e, 8); V4_DEC(w4[3], e, 12); const f32x2 c0 = (f32x2){cf[j], cf[j]}; \
                _Pragma("unroll") for (int i = 0; i < 16; ++i) y2[i] = __builtin_elementwise_fma(c0, e[i], y2[i]); } } while (0)
        VB4 A0, A1, A2, A3;
        { const __amdgpu_buffer_rsrc_t T0 = V4_TAB(0); V4_LOAD(A0, T0, 0, 0); V4_LOAD(A1, T0, 0, 1); V4_LOAD(A2, T0, 0, 2); V4_LOAD(A3, T0, 0, 3); }
        int q = 0, k = 0;
#pragma unroll 1
        for (int f = 0; f < total; ++f) {
            const int row = gw + k * nw;
            f32x2 y2[16];
#pragma unroll
            for (int j = 0; j < 16; ++j) y2[j] = (f32x2){0.f, 0.f};
            int kn = k + 1, qn = q; if (kn == nk) { kn = 0; ++qn; }
            if (f + 1 == total) { kn = k; qn = q; }
            const __amdgpu_buffer_rsrc_t TN = V4_TAB(qn);
            const int hoff = q * 512 + chunk8 * 64 + slot8 * 8;
            const u32x2 hr = __builtin_amdgcn_raw_buffer_load_b64(Hr, hoff, row * 2048, 0);
            V4_ACC(A0, 0); V4_LOAD(A0, TN, kn, 0);
            V4_ACC(A1, 1); V4_LOAD(A1, TN, kn, 1);
            V4_ACC(A2, 2); V4_LOAD(A2, TN, kn, 2);
            V4_ACC(A3, 3); V4_LOAD(A3, TN, kn, 3);
            float y16[16], y8[8], y4[4];
#pragma unroll
            for (int j = 0; j < 16; ++j) { const float ylo = y2[j >> 1][j & 1], yhi = y2[8 + (j >> 1)][j & 1]; const float snd = t2 ? ylo : yhi, kp = t2 ? yhi : ylo; y16[j] = kp + __shfl_xor(snd, 32); }
#pragma unroll
            for (int j = 0; j < 8; ++j) { const float snd = t1 ? y16[j] : y16[j + 8], kp = t1 ? y16[j + 8] : y16[j]; y8[j] = kp + __shfl_xor(snd, 16); }
#pragma unroll
            for (int j = 0; j < 4; ++j) { const float snd = t0 ? y8[j] : y8[j + 4], kp = t0 ? y8[j + 4] : y8[j]; y4[j] = kp + dpp_xor8(snd); }
            y4[0] += bflo(hr[0]); y4[1] += bfhi(hr[0]); y4[2] += bflo(hr[1]); y4[3] += bfhi(hr[1]);
            if (FINAL) {
                __builtin_amdgcn_raw_buffer_store_b128(__builtin_bit_cast(u32x4, (f32x4){y4[0], y4[1], y4[2], y4[3]}), Or, 2 * hoff, row * 4096, 0);
            } else {
                const unsigned w0 = pk2(y4[0], y4[1]), w1 = pk2(y4[2], y4[3]);
                const float a0 = bflo(w0), a1 = bfhi(w0), a2 = bflo(w1), a3 = bfhi(w1);
                const float ss = wave_sum((a0 * a0 + a1 * a1) + (a2 * a2 + a3 * a3));
                __builtin_amdgcn_raw_buffer_store_b64((u32x2){w0, w1}, Or, hoff, row * 2048, 0);
                if (lane == 0) { const float t = q == 0 ? ss : RSL[k] + ss; RSL[k] = t; if (q == 3) RSout[row] = rsqrtf(t * (1.f / D) + EPS); }
            }
            k = kn; q = qn;
        }
#undef V4_TAB
#undef V4_LOAD
#undef V4_DEC
#undef V4_ACC
    }
    if (!V4 && nk > 0) {
        QBatch A0, A1, A2, A3;
        { const __amdgpu_buffer_rsrc_t T0 = CQ_TAB(WS_VB, 0); CQ_LOAD(A0, T0, 0, 0); CQ_LOAD(A1, T0, 0, 1); CQ_LOAD(A2, T0, 0, 2); CQ_LOAD(A3, T0, 0, 3); }
        int q = 0, k = 0;
#pragma unroll 1
        for (int f = 0; f < total; ++f) {
            const int row = gw + k * nw;
            f32x2 y2[8];
#pragma unroll
            for (int j = 0; j < 8; ++j) y2[j] = (f32x2){0.f, 0.f};
#define CQ_ACC(BUF, bt) do { float cf[8]; _Pragma("unroll") for (int j = 0; j < 8; ++j) cf[j] = CL[k * 128 + 32 * (bt) + 4 * j + slot]; \
            asm volatile("" : "+v"(cf[0]), "+v"(cf[1]), "+v"(cf[2]), "+v"(cf[3]), "+v"(cf[4]), "+v"(cf[5]), "+v"(cf[6]), "+v"(cf[7]));     \
            _Pragma("unroll") for (int j = 0; j < 8; j += 2) { \
                u32x6 s6 = (u32x6){BUF.r[j][0], BUF.r[j][1], BUF.r[j][2], BUF.r[j + 1][0], BUF.r[j + 1][1], BUF.r[j + 1][2]}; \
                asm volatile("" : "+v"(s6), "+v"(y2[0]), "+v"(y2[1]), "+v"(y2[2]), "+v"(y2[3]), "+v"(y2[4]), "+v"(y2[5]), "+v"(y2[6]), "+v"(y2[7])); \
                const f32x32 dv = __builtin_amdgcn_cvt_scalef32_pk32_f32_fp6(s6, 1.0f); const f32x2 c0 = (f32x2){cf[j], cf[j]}, c1 = (f32x2){cf[j + 1], cf[j + 1]}; \
                _Pragma("unroll") for (int i = 0; i < 8; ++i) { y2[i] = __builtin_elementwise_fma(c0, (f32x2){dv[2 * i], dv[2 * i + 1]}, y2[i]); y2[i] = __builtin_elementwise_fma(c1, (f32x2){dv[16 + 2 * i], dv[17 + 2 * i]}, y2[i]); } } } while (0)
            int kn = k + 1, qn = q; if (kn == nk) { kn = 0; ++qn; }
            if (f + 1 == total) { kn = k; qn = q; }
            const __amdgpu_buffer_rsrc_t TN = CQ_TAB(WS_VB, qn);
            const int hoff = q * 512 + chunk * 32 + slot * 8;
            const u32x2 hr = __builtin_amdgcn_raw_buffer_load_b64(Hr, hoff, row * 2048, 0);
            CQ_ACC(A0, 0); CQ_LOAD(A0, TN, kn, 0);
            CQ_ACC(A1, 1); CQ_LOAD(A1, TN, kn, 1);
            CQ_ACC(A2, 2); CQ_LOAD(A2, TN, kn, 2);
            CQ_ACC(A3, 3); CQ_LOAD(A3, TN, kn, 3);
#undef CQ_ACC
            float y8[8], y4[4];
#pragma unroll
            for (int j = 0; j < 8; ++j) { const float ylo = y2[j >> 1][j & 1], yhi = y2[4 + (j >> 1)][j & 1]; const float snd = s1 ? ylo : yhi, kp = s1 ? yhi : ylo; y8[j] = kp + __shfl_xor(snd, 32); }
#pragma unroll
            for (int j = 0; j < 4; ++j) { const float snd = s0 ? y8[j] : y8[j + 4], kp = s0 ? y8[j + 4] : y8[j]; y4[j] = kp + __shfl_xor(snd, 16); }
            y4[0] += bflo(hr[0]); y4[1] += bfhi(hr[0]); y4[2] += bflo(hr[1]); y4[3] += bfhi(hr[1]);
            if (FINAL) {
                __builtin_amdgcn_raw_buffer_store_b128(__builtin_bit_cast(u32x4, (f32x4){y4[0], y4[1], y4[2], y4[3]}), Or, 2 * hoff, row * 4096, 0);
            } else {
                const unsigned w0 = pk2(y4[0], y4[1]), w1 = pk2(y4[2], y4[3]);
                const float a0 = bflo(w0), a1 = bfhi(w0), a2 = bflo(w1), a3 = bfhi(w1);
                const float ss = wave_sum((a0 * a0 + a1 * a1) + (a2 * a2 + a3 * a3));
                __builtin_amdgcn_raw_buffer_store_b64((u32x2){w0, w1}, Or, hoff, row * 2048, 0);
                if (lane == 0) { const float t = q == 0 ? ss : RSL[k] + ss; RSL[k] = t; if (q == 3) RSout[row] = rsqrtf(t * (1.f / D) + EPS); }
            }
            k = kn; q = qn;
        }
    }
#undef CQ_TAB
#undef CQ_LOAD
}

typedef short bf16x8_t __attribute__((ext_vector_type(8)));
__device__ __forceinline__ float fmax_asm(float a, float b) { float r; asm("v_max_f32 %0, %1, %2" : "=v"(r) : "v"(a), "v"(b)); return r; }
__device__ __forceinline__ float fmin_asm(float a, float b) { float r; asm("v_min_f32 %0, %1, %2" : "=v"(r) : "v"(a), "v"(b)); return r; }
#define CEF(a, b) do { const float _mx = fmax_asm(a, b), _mn = fmin_asm(a, b); a = _mx; b = _mn; } while (0)
template <int BASE, int N> __device__ __forceinline__ void sort16_desc(float (&x)[N]) {
#pragma unroll
    for (int p = 1; p < 16; p <<= 1)
#pragma unroll
        for (int k = p; k >= 1; k >>= 1)
#pragma unroll
            for (int j = k % p; j + k < 16; j += 2 * k)
#pragma unroll
                for (int i = 0; i < (k < 16 - j - k ? k : 16 - j - k); ++i)
                    if ((i + j) / (2 * p) == (i + j + k) / (2 * p)) CEF(x[BASE + i + j], x[BASE + i + j + k]);
}
template <int BASE, int N> __device__ __forceinline__ void bitonic_merge16_desc(float (&x)[N]) {
#pragma unroll
    for (int j = 8; j > 0; j >>= 1)
#pragma unroll
        for (int i = 0; i < 16; ++i) { const int l = i ^ j; if (l > i) CEF(x[BASE + i], x[BASE + l]); }
}
template <int A, int B, int N> __device__ __forceinline__ void merge_top16(float (&x)[N]) {
#pragma unroll
    for (int i = 0; i < 16; ++i) x[A + i] = fmax_asm(x[A + i], x[B + 15 - i]);
    bitonic_merge16_desc<A>(x);
}
__device__ __forceinline__ void xlane_merge16(float (&x)[16]) {
    float p[16];
#pragma unroll
    for (int i = 0; i < 16; ++i) p[i] = __shfl_xor(x[i], 32);
#pragma unroll
    for (int i = 0; i < 16; ++i) x[i] = fmax_asm(x[i], p[15 - i]);
    bitonic_merge16_desc<0>(x);
}
constexpr int cand_ai(int s) { return s < 16 ? 0 : s < 24 ? 1 : s < 25 ? 2 : -1; }
constexpr int cand_aj(int s) { return s < 16 ? s : s < 24 ? s - 16 : s < 25 ? 0 : -1; }
constexpr int cand_bi(int s) { return s < 4 ? 2 : s < 8 ? 3 : s < 11 ? 4 : s < 13 ? 5 : s < 15 ? 6 : s < 17 ? 7 : s < 25 ? s - 9 : -1; }
constexpr int cand_bj(int s) { return s < 4 ? s + 1 : s < 8 ? s - 4 : s < 11 ? s - 8 : s < 13 ? s - 11 : s < 15 ? s - 13 : s < 17 ? s - 15 : s < 25 ? 0 : -1; }
constexpr int KLDS_ROW = 272, KLDS_P = 128 * KLDS_ROW;

__device__ __forceinline__ void p5_topk_opt(const Args& a, int layer, const float* SSQ, int ntiles, LAS unsigned char* lds) {
    const int tid = opaque_tid(), lane = tid & 63, wave = __builtin_amdgcn_readfirstlane(tid >> 6), r32 = lane & 31, hi = lane >> 5;
    const int h = blockIdx.x & 7;
    const bf16_t* QP = (const bf16_t*)(a.ws + WS_P1);
    const bf16_t* KeysB = (const bf16_t*)(a.ws + WS_KEYS) + (size_t)layer * 2 * 8 * 128 * 128;
    int* IDX = (int*)(a.ws + WS_IDX); float* GATE = (float*)(a.ws + WS_GATE);
#pragma unroll
    for (int p = 0; p < 2; ++p)
#pragma unroll
        for (int i = 0; i < 4; ++i) { const int chunk = tid + 512 * i, key = chunk >> 4, c16 = chunk & 15;
            const u32x4 v = *(const u32x4*)(KeysB + ((size_t)(p * 8 + h) * 128 + key) * 128 + c16 * 8);
            *(LAS u32x4*)(lds + p * KLDS_P + key * KLDS_ROW + c16 * 16) = v; }
    __syncthreads();
    const int hi4 = hi * 4;
    for (int t = (int)(blockIdx.x >> 3); t < ntiles; t += (int)(gridDim.x >> 3)) {
        const int row = t * 256 + wave * 32 + r32;
        if (t * 256 + wave * 32 >= NROWS) continue;
        asm volatile("" ::: "memory");
        float T[2][16];
#pragma unroll
        for (int p = 0; p < 2; ++p) {
            bf16x8_t qf[8];
            const bf16_t* qp = QP + (size_t)row * 2048 + h * 256 + p * 128 + hi * 8;
#pragma unroll
            for (int ks = 0; ks < 8; ++ks) qf[ks] = *(const bf16x8_t*)(qp + ks * 16);
            f32x16 acc[4];
#pragma unroll
            for (int mt = 0; mt < 4; ++mt) {
                acc[mt] = (f32x16){0.f, 0.f, 0.f, 0.f, 0.f, 0.f, 0.f, 0.f, 0.f, 0.f, 0.f, 0.f, 0.f, 0.f, 0.f, 0.f};
#pragma unroll
                for (int ks = 0; ks < 8; ++ks) {
                    const bf16x8_t kf = *(const LAS bf16x8_t*)(lds + p * KLDS_P + (32 * mt + r32) * KLDS_ROW + ks * 32 + hi * 16);
                    acc[mt] = __builtin_amdgcn_mfma_f32_32x32x16_bf16(kf, qf[ks], acc[mt], 0, 0, 0);
                }
            }
            float x[64];
#pragma unroll
            for (int mt = 0; mt < 4; ++mt)
#pragma unroll
                for (int rg = 0; rg < 16; ++rg) {
                    const unsigned code = 127u - (unsigned)(32 * mt + (rg & 3) + 8 * (rg >> 2));
                    x[16 * mt + rg] = __uint_as_float((__float_as_uint(acc[mt][rg]) & ~127u) | code);
                }
            sort16_desc<0>(x); sort16_desc<16>(x); sort16_desc<32>(x); sort16_desc<48>(x);
            merge_top16<0, 16>(x); merge_top16<32, 48>(x); merge_top16<0, 32>(x);
#pragma unroll
            for (int i = 0; i < 16; ++i) T[p][i] = __uint_as_float(__float_as_uint(x[i]) - (unsigned)hi4);
            xlane_merge16(T[p]);
        }
        float v0[16], v1[16]; unsigned long long k0lo = 0, k0hi = 0, k1lo = 0, k1hi = 0;
#pragma unroll
        for (int i = 0; i < 16; ++i) {
            const unsigned b0 = __float_as_uint(T[0][i]), b1 = __float_as_uint(T[1][i]);
            v0[i] = __uint_as_float(b0 & ~127u); v1[i] = __uint_as_float(b1 & ~127u);
            const unsigned long long e0 = 127u - (b0 & 127u), e1 = 127u - (b1 & 127u);
            if (i < 8) { k0lo |= e0 << (8 * i); k1lo |= e1 << (8 * i); } else { k0hi |= e0 << (8 * (i - 8)); k1hi |= e1 << (8 * (i - 8)); }
        }
        float cnd[32];
#pragma unroll
        for (int s = 0; s < 32; ++s) {
            if (cand_ai(s) >= 0) {
                const float ca = v0[cand_ai(s)] + v1[cand_aj(s)], cb = v0[cand_bi(s)] + v1[cand_bj(s)];
                const unsigned pa = (__float_as_uint(ca) & ~255u) | (255u - (unsigned)(16 * cand_ai(s) + cand_aj(s)));
                const unsigned pb = (__float_as_uint(cb) & ~255u) | (255u - (unsigned)(16 * cand_bi(s) + cand_bj(s)));
                cnd[s] = __uint_as_float(hi ? pb : pa);
            } else cnd[s] = __uint_as_float(0xff800000u);
        }
        sort16_desc<0>(cnd); sort16_desc<16>(cnd); merge_top16<0, 16>(cnd);
        float R[16];
#pragma unroll
        for (int i = 0; i < 16; ++i) R[i] = cnd[i];
        xlane_merge16(R);
        const f32x4 q0 = *(const f32x4*)(SSQ + (size_t)row * 16), q1 = *(const f32x4*)(SSQ + (size_t)row * 16 + 4), q2 = *(const f32x4*)(SSQ + (size_t)row * 16 + 8), q3 = *(const f32x4*)(SSQ + (size_t)row * 16 + 12);
        const float ssq = ((q0[0] + q0[1]) + (q0[2] + q0[3])) + ((q1[0] + q1[1]) + (q1[2] + q1[3])) + ((q2[0] + q2[1]) + (q2[2] + q2[3])) + ((q3[0] + q3[1]) + (q3[2] + q3[3]));
        const float rl = rsqrtf(ssq * (1.f / D) + EPS) * LOG2E;
        float e[16], esum = 0.f; unsigned ex[16];
        const float vtop = __uint_as_float(__float_as_uint(R[0]) & ~255u);
#pragma unroll
        for (int i = 0; i < 16; ++i) {
            const unsigned b = __float_as_uint(R[i]); const unsigned code = 255u - (b & 255u), ci = code >> 4, cj = code & 15u;
            e[i] = __builtin_amdgcn_exp2f((__uint_as_float(b & ~255u) - vtop) * rl); esum += e[i];
            const unsigned kk0 = (unsigned)(((ci & 8u) ? k0hi : k0lo) >> (8 * (ci & 7u))) & 127u, kk1 = (unsigned)(((cj & 8u) ? k1hi : k1lo) >> (8 * (cj & 7u))) & 127u;
            ex[i] = kk0 * 128u + kk1;
        }
        const float inv = 1.f / esum;
        unsigned* dst = hi ? (unsigned*)(GATE + (size_t)row * 128 + h * 16) : (unsigned*)(IDX + (size_t)row * 128 + h * 16);
#pragma unroll
        for (int q = 0; q < 4; ++q) { u32x4 w;
#pragma unroll
            for (int i = 0; i < 4; ++i) w[i] = hi ? __float_as_uint(e[4 * q + i] * inv) : ex[4 * q + i];
            *(u32x4*)(dst + 4 * q) = w; }
    }
}


constexpr int VT_PITCH = 144, VT_BYTES = 32 * VT_PITCH;
__device__ __forceinline__ void p2_attn_opt(const Args& a, bf16_t* MIX, LAS unsigned char* lds) {
    const int tid = opaque_tid(), lane = tid & 63, wave = __builtin_amdgcn_readfirstlane(tid >> 6), r32 = lane & 31, hi = lane >> 5;
    LAS unsigned char* vt = lds + wave * VT_BYTES;
    const bf16_t* P1 = (const bf16_t*)(a.ws + WS_P1);
    const int gw = wave * (int)gridDim.x + (int)blockIdx.x, nw = (int)gridDim.x * 8;
    constexpr int NSTRIP = NB * 8 * (SEQ / 32);
    for (int it = gw; it < NSTRIP + 8; it += nw) {
        int b, h, j, qrow0; bool meta_q;
        if (it < NSTRIP) { h = it & 7; const int sj = it >> 3; b = sj >> 9; j = sj & 511; qrow0 = b * SEQ + 32 * j; meta_q = false; }
        else { h = it - NSTRIP; b = 0; j = -1; qrow0 = MROW0; meta_q = true; }
        bf16x8_t qf[4];
#pragma unroll
        for (int ks = 0; ks < 4; ++ks) qf[ks] = *(const bf16x8_t*)(P1 + (size_t)(qrow0 + r32) * P1W + h * 64 + 16 * ks + 8 * hi);
        f32x16 o[2];
#pragma unroll
        for (int dt = 0; dt < 2; ++dt) o[dt] = (f32x16){0.f, 0.f, 0.f, 0.f, 0.f, 0.f, 0.f, 0.f, 0.f, 0.f, 0.f, 0.f, 0.f, 0.f, 0.f, 0.f};
        float carry = 0.f;
        int kt = j; bool diag = true;
        bf16x8_t kn[4]; u32x4 vn[4];
#define ATT_FETCH(KT) do { const int kr0_ = (KT) < 0 ? MROW0 : b * SEQ + 32 * (KT); \
            _Pragma("unroll") for (int ks = 0; ks < 4; ++ks) kn[ks] = *(const bf16x8_t*)(P1 + (size_t)(kr0_ + r32) * P1W + 512 + h * 64 + 16 * ks + 8 * hi); \
            _Pragma("unroll") for (int c4 = 0; c4 < 4; ++c4) { const int chunk = lane + 64 * c4, key = chunk >> 3, part = chunk & 7; \
                vn[c4] = *(const u32x4*)(P1 + (size_t)(kr0_ + key) * P1W + 1024 + h * 64 + part * 8); } } while (0)
        ATT_FETCH(kt);
        for (;;) {
            const bool is_meta = kt < 0;
            const int nvalid = is_meta ? NMETA : 32;
            bf16x8_t kf[4];
#pragma unroll
            for (int ks = 0; ks < 4; ++ks) kf[ks] = kn[ks];
#pragma unroll
            for (int c4 = 0; c4 < 4; ++c4) { const int chunk = lane + 64 * c4, key = chunk >> 3, part = chunk & 7;
                *(LAS u32x4*)(vt + key * VT_PITCH + part * 16) = vn[c4]; }
            if (!is_meta) ATT_FETCH(kt - 1);
            __builtin_amdgcn_sched_barrier(0);
            f32x16 sacc = (f32x16){0.f, 0.f, 0.f, 0.f, 0.f, 0.f, 0.f, 0.f, 0.f, 0.f, 0.f, 0.f, 0.f, 0.f, 0.f, 0.f};
#pragma unroll
            for (int ks = 0; ks < 4; ++ks) sacc = __builtin_amdgcn_mfma_f32_32x32x16_bf16(kf[ks], qf[ks], sacc, 0, 0, 0);
            float L[16]; bool ok[16];
#pragma unroll
            for (int rg = 0; rg < 16; ++rg) {
                const int kap = 8 * (rg >> 2) + 4 * hi + (rg & 3);
                ok[rg] = (kap < nvalid) && (!diag || kap < r32);
                const float z = sacc[rg], t = __builtin_amdgcn_exp2f(-__builtin_fabsf(z));
                const float l = __builtin_fmaxf(z, 0.f) + __builtin_amdgcn_logf(1.f + t);
                L[rg] = ok[rg] ? l : 0.f;
            }
            float G[4], PG[4];
#pragma unroll
            for (int g = 0; g < 4; ++g) { G[g] = (L[4 * g] + L[4 * g + 1]) + (L[4 * g + 2] + L[4 * g + 3]); PG[g] = __shfl_xor(G[g], 32); }
            float w[16]; float tot = 0.f;
#pragma unroll
            for (int g = 3; g >= 0; --g) {
                float run = tot + (hi == 0 ? PG[g] : 0.f);
#pragma unroll
                for (int i = 3; i >= 0; --i) { const int rg = 4 * g + i;
                    const float lw = (sacc[rg] - L[rg]) - run + carry;
                    w[rg] = ok[rg] ? __builtin_amdgcn_exp2f(lw) : 0.f;
                    run += L[rg]; }
                tot += G[g] + PG[g];
            }
            carry -= tot;
#pragma unroll
            for (int s2 = 0; s2 < 2; ++s2) {
                u32x4 pw;
#pragma unroll
                for (int q = 0; q < 4; ++q) pw[q] = pk2(w[8 * s2 + 2 * q], w[8 * s2 + 2 * q + 1]);
                const bf16x8_t pf = __builtin_bit_cast(bf16x8_t, pw);
#pragma unroll
                for (int dt = 0; dt < 2; ++dt) {
                    typedef short v4s_t __attribute__((ext_vector_type(4)));
                    const int tq = (lane & 15) >> 2, tp = lane & 3, tg = (lane >> 4) & 1;
                    const LAS unsigned char* tb = vt + (16 * s2 + 4 * hi + tq) * VT_PITCH + (32 * dt + 16 * tg + 4 * tp) * 2;
                    const v4s_t t0 = __builtin_amdgcn_ds_read_tr16_b64_v4i16((LAS v4s_t*)tb), t1 = __builtin_amdgcn_ds_read_tr16_b64_v4i16((LAS v4s_t*)(tb + 8 * VT_PITCH));
                    const bf16x8_t vw = (bf16x8_t){t0[0], t0[1], t0[2], t0[3], t1[0], t1[1], t1[2], t1[3]};
                    o[dt] = __builtin_amdgcn_mfma_f32_32x32x16_bf16(vw, pf, o[dt], 0, 0, 0);
                }
            }
            diag = false;
            if (is_meta) break;
            if (__all(carry < CARRY2_STOP)) break;
            --kt;
        }
#undef ATT_FETCH
        if (!meta_q || r32 < NMETA) {
            bf16_t* op = MIX + (size_t)(qrow0 + r32) * D + h * 64 + 4 * hi;
#pragma unroll
            for (int dt = 0; dt < 2; ++dt)
#pragma unroll
                for (int g = 0; g < 4; ++g) *(uint2*)(op + 32 * dt + 8 * g) = make_uint2(pk2(o[dt][4 * g], o[dt][4 * g + 1]), pk2(o[dt][4 * g + 2], o[dt][4 * g + 3]));
        }
    }
    const bf16_t* GB = P1 + 1536; const bf16_t* GC = P1 + 2048;
    {
        const int c8 = (tid & 63) * 8, rstep = (int)gridDim.x * 8;
        float cw[3][8];
#pragma unroll
        for (int t = 0; t < 3; ++t)
#pragma unroll
            for (int i = 0; i < 8; ++i) cw[t][i] = a.conv_w[t * 512 + c8 + i];
        const u32x4 z4 = (u32x4){0u, 0u, 0u, 0u};
#pragma unroll 1
        for (int row0 = (int)blockIdx.x * 8 + (tid >> 6); row0 < NROWS; row0 += 4 * rstep) {
            u32x4 u2[4], u1[4], u0[4], gb[4];
#pragma unroll
            for (int r = 0; r < 4; ++r) { const int row = row0 + r * rstep, rc = row < NROWS ? row : NROWS - 1;
                int b, p; rowpos(rc, b, p);
                u2[r] = *(const u32x4*)(GC + (size_t)rc * P1W + c8);
                u1[r] = p >= 1 ? *(const u32x4*)(GC + (size_t)prow(b, p - 1) * P1W + c8) : z4;
                u0[r] = p >= 2 ? *(const u32x4*)(GC + (size_t)prow(b, p - 2) * P1W + c8) : z4;
                gb[r] = *(const u32x4*)(GB + (size_t)rc * P1W + c8); }
#pragma unroll
            for (int r = 0; r < 4; ++r) { const int row = row0 + r * rstep;
                u32x4 ov;
#pragma unroll
                for (int q = 0; q < 4; ++q) {
                    const float ylo = cw[0][2 * q] * bflo(u0[r][q]) + cw[1][2 * q] * bflo(u1[r][q]) + cw[2][2 * q] * bflo(u2[r][q]);
                    const float yhi = cw[0][2 * q + 1] * bfhi(u0[r][q]) + cw[1][2 * q + 1] * bfhi(u1[r][q]) + cw[2][2 * q + 1] * bfhi(u2[r][q]);
                    ov[q] = pk2(ylo * bflo(gb[r][q]), yhi * bfhi(gb[r][q]));
                }
                if (row < NROWS) *(u32x4*)(MIX + (size_t)row * D + 512 + c8) = ov; }
        }
    }
}


typedef int v2i_t __attribute__((ext_vector_type(2)));
typedef int i32x8_t __attribute__((ext_vector_type(8)));
constexpr int OPT_LDS_C = 147456;

constexpr int MF_AT = 4352, MF_ST = 8704, MF_RS = 17920, MF_CM = 18048, MF_WLDS = 18176, MF_PITCH = 144;
static_assert(MF_WLDS * 8 <= OPT_LDS_C - 16, "per-wave gather LDS");
__device__ __forceinline__ unsigned fp4_enc(float x, float& f) {
    const float ax = fabsf(x);
    const float kf = ax < 2.f ? __builtin_rintf(ax * 2.f) : ax < 4.f ? __builtin_rintf(ax) + 2.f : __builtin_rintf(ax * 0.5f) + 4.f;
    unsigned m = (unsigned)kf; m = m > 7u ? 7u : m;
    const float mag = m < 4u ? 0.5f * (float)m : m == 4u ? 2.f : m == 5u ? 3.f : m == 6u ? 4.f : 6.f;
    f = x < 0.f ? -mag : mag;
    return m | (x < 0.f ? 8u : 0u);
}
template <bool FINAL>
__device__ __forceinline__ void p6_peer_mf(const Args& a, int layer, const bf16_t* H, const float* SSQ, bf16_t* Hout, float* RSout, int nrows, LAS unsigned char* lds) {
    const int tid = opaque_tid(), lane = tid & 63, wave = __builtin_amdgcn_readfirstlane(tid >> 6);
    const int gw = wave * (int)gridDim.x + (int)blockIdx.x, nw = (int)gridDim.x * 8;
    const int nk = gw < nrows ? (nrows - gw + nw - 1) / nw : 0;
    LAS unsigned char* wl = lds + wave * MF_WLDS;
    LAS unsigned short* IDXS = (LAS unsigned short*)wl; LAS unsigned char* AT = wl + MF_AT; LAS unsigned char* ST = wl + MF_ST;
    LAS int* CLI = (LAS int*)ST; LAS float* RSL = (LAS float*)(wl + MF_RS); LAS float* HSL = RSL; LAS float* CM = (LAS float*)(wl + MF_CM);
    const __amdgpu_buffer_rsrc_t USr = MKRSRC(a.ws + WS_UB + 32 * MiB + (size_t)layer * NEXP * 4, NEXP * 4), VSr = MKRSRC(a.ws + WS_VB + 32 * MiB + (size_t)layer * NEXP * 4, NEXP * 4);
    const __amdgpu_buffer_rsrc_t IDXr = MKRSRC(a.ws + WS_IDX, RP * 128 * 4), GATEr = MKRSRC(a.ws + WS_GATE, RP * 128 * 4);
    const __amdgpu_buffer_rsrc_t Hr = MKRSRC(H, RP * D * 2), SSQr = MKRSRC(SSQ, RP * 16 * 4);
    const __amdgpu_buffer_rsrc_t Or = FINAL ? MKRSRC(a.out, XROWS * D * 4) : MKRSRC(Hout, RP * D * 2);
    const __amdgpu_buffer_rsrc_t H8r = MKRSRC(a.ws + WS_P1, RP * 1024);
    const int slot8 = lane >> 3, chunk8 = lane & 7;
    const bool c2 = (chunk8 & 4) != 0, c1 = (chunk8 & 2) != 0, c0 = (chunk8 & 1) != 0;
    for (int k0 = 0; k0 < nk; k0 += 6) {
        int t0[6], t1[6];
#pragma unroll
        for (int j = 0; j < 6; ++j) { const int kk = k0 + j < nk ? k0 + j : nk - 1, row = gw + kk * nw;
            t0[j] = __builtin_amdgcn_raw_buffer_load_b32(IDXr, lane * 4, row * 512, 0); t1[j] = __builtin_amdgcn_raw_buffer_load_b32(IDXr, lane * 4 + 256, row * 512, 0); }
#pragma unroll
        for (int j = 0; j < 6; ++j) if (k0 + j < nk) { IDXS[(k0 + j) * 128 + lane] = (unsigned short)t0[j]; IDXS[(k0 + j) * 128 + 64 + lane] = (unsigned short)t1[j]; }
    }
    if (nk > 0) {
        for (int k0 = 0; k0 < nk; k0 += 4) {
            u32x4 ha[4], hb[4];
#pragma unroll
            for (int j = 0; j < 4; ++j) { const int kk = k0 + j < nk ? k0 + j : nk - 1, row = gw + kk * nw;
                ha[j] = __builtin_amdgcn_raw_buffer_load_b128(Hr, lane * 32, row * 2048, 0); hb[j] = __builtin_amdgcn_raw_buffer_load_b128(Hr, lane * 32 + 16, row * 2048, 0); }
#pragma unroll
            for (int j = 0; j < 4; ++j) if (k0 + j < nk) { const int row = gw + (k0 + j) * nw;
                float hv[16], am = 0.f;
#pragma unroll
                for (int i = 0; i < 4; ++i) { hv[2 * i] = bflo(ha[j][i]); hv[2 * i + 1] = bfhi(ha[j][i]); hv[8 + 2 * i] = bflo(hb[j][i]); hv[9 + 2 * i] = bfhi(hb[j][i]); }
#pragma unroll
                for (int i = 0; i < 16; ++i) am = fmaxf(am, fabsf(hv[i]));
#pragma unroll
                for (int o = 1; o < 64; o <<= 1) am = fmaxf(am, __shfl_xor(am, o));
                const float sc = am > 0.f ? am * (UI4 ? 1.f / 119.f : 1.f / 127.f) : 1.f, inv = 1.f / sc;
                unsigned w[4] = {0u, 0u, 0u, 0u};
                if (UI4) {
#pragma unroll
                    for (int i = 0; i < 16; ++i) { const int q = (int)__builtin_rintf(hv[i] * inv), hl = ((q + 8) & 15) - 8, hh = (q - hl) >> 4;
                        w[i >> 3] |= ((unsigned)hh & 0xfu) << (4 * (i & 7)); w[2 + (i >> 3)] |= ((unsigned)hl & 0xfu) << (4 * (i & 7)); }
                    __builtin_amdgcn_raw_buffer_store_b64((u32x2){w[0], w[1]}, H8r, lane * 8, row * 1024, 0); __builtin_amdgcn_raw_buffer_store_b64((u32x2){w[2], w[3]}, H8r, 512 + lane * 8, row * 1024, 0);
                } else {
#pragma unroll
                    for (int i = 0; i < 16; ++i) { const int q = (int)__builtin_rintf(hv[i] * inv); w[i >> 2] |= ((unsigned)q & 0xffu) << (8 * (i & 3)); }
                    __builtin_amdgcn_raw_buffer_store_b128((u32x4){w[0], w[1], w[2], w[3]}, H8r, lane * 16, row * 1024, 0);
                }
                if (lane == 0) HSL[k0 + j] = sc; }
        }
        __threadfence_block();
        struct UB4 { u32x4 r[4]; };
        constexpr int NSW = UI4 ? 4 : 8;
#define U8_TAB(ee) MKRSRC(a.ws + WS_UB + ((size_t)layer * NSW + (ee)) * NEXP * 128, NEXP * 128)
#define U8_LOAD(BUF, T, kk, bt) do { int ev[4]; _Pragma("unroll") for (int j = 0; j < 4; ++j) ev[j] = IDXS[(kk) * 128 + 32 * (bt) + 8 * j + slot8]; \
            asm volatile("" : "+v"(ev[0]), "+v"(ev[1]), "+v"(ev[2]), "+v"(ev[3])); \
            _Pragma("unroll") for (int j = 0; j < 4; ++j) BUF.r[j] = __builtin_amdgcn_raw_buffer_load_b128(T, ev[j] * 128 + chunk8 * 16, 0, 0); } while (0)
#define U8_DOTS(BUF, bt) do { _Pragma("unroll") for (int j = 0; j < 4; ++j) { const u32x4 w4 = BUF.r[j]; \
            if (UI4) { const int ah = __builtin_amdgcn_sdot8((int)w4[3], (int)h8[3], __builtin_amdgcn_sdot8((int)w4[2], (int)h8[2], __builtin_amdgcn_sdot8((int)w4[1], (int)h8[1], __builtin_amdgcn_sdot8((int)w4[0], (int)h8[0], 0, false), false), false), false); \
                const int al = __builtin_amdgcn_sdot8((int)w4[3], (int)h8l[3], __builtin_amdgcn_sdot8((int)w4[2], (int)h8l[2], __builtin_amdgcn_sdot8((int)w4[1], (int)h8l[1], __builtin_amdgcn_sdot8((int)w4[0], (int)h8l[0], 0, false), false), false), false); \
                pd[4 * (bt) + j] = ah * 16 + al; } \
            else pd[4 * (bt) + j] = __builtin_amdgcn_sdot4((int)w4[3], (int)h8[3], __builtin_amdgcn_sdot4((int)w4[2], (int)h8[2], __builtin_amdgcn_sdot4((int)w4[1], (int)h8[1], __builtin_amdgcn_sdot4((int)w4[0], (int)h8[0], 0, false), false), false), false); } } while (0)
        {
            UB4 A0, A1, A2, A3; u32x4 h8n, h8ln = (u32x4){0u, 0u, 0u, 0u};
            { const __amdgpu_buffer_rsrc_t T0 = U8_TAB(0);
              h8n = __builtin_amdgcn_raw_buffer_load_b128(H8r, chunk8 * 16, gw * 1024, 0);
              if (UI4) h8ln = __builtin_amdgcn_raw_buffer_load_b128(H8r, 512 + chunk8 * 16, gw * 1024, 0);
              U8_LOAD(A0, T0, 0, 0); U8_LOAD(A1, T0, 0, 1); U8_LOAD(A2, T0, 0, 2); U8_LOAD(A3, T0, 0, 3); }
            const int total8 = NSW * nk;
            int e = 0, k = 0;
#pragma unroll 1
            for (int f = 0; f < total8; ++f) {
                const int row = gw + k * nw;
                const u32x4 h8 = h8n, h8l = h8ln;
                const int ib = 8 * (c2 ? 1 : 0) + 4 * (c1 ? 1 : 0) + 2 * (c0 ? 1 : 0);
                float fus[2] = {0.f, 0.f}, fg[2] = {0.f, 0.f}, fsq = 0.f;
                if (e == NSW - 1) {
                    fsq = __builtin_bit_cast(float, __builtin_amdgcn_raw_buffer_load_b32(SSQr, (lane & 15) * 4, row * 64, 0));
#pragma unroll
                    for (int m = 0; m < 2; ++m) { const int n = 8 * (ib + m) + slot8, ex = IDXS[k * 128 + n];
                        fus[m] = __builtin_bit_cast(float, __builtin_amdgcn_raw_buffer_load_b32(USr, ex * 4, 0, 0));
                        fg[m] = __builtin_bit_cast(float, __builtin_amdgcn_raw_buffer_load_b32(GATEr, n * 4, row * 512, 0)); }
                }
                int kn = k + 1, en = e; if (kn == nk) { kn = 0; ++en; }
                if (f + 1 == total8) { kn = k; en = e; }
                const __amdgpu_buffer_rsrc_t TN = U8_TAB(en);
                int pd[16];
                U8_DOTS(A0, 0);
                h8n = __builtin_amdgcn_raw_buffer_load_b128(H8r, en * 128 + chunk8 * 16, (gw + kn * nw) * 1024, 0);
                if (UI4) h8ln = __builtin_amdgcn_raw_buffer_load_b128(H8r, 512 + en * 128 + chunk8 * 16, (gw + kn * nw) * 1024, 0);
                U8_LOAD(A0, TN, kn, 0);
                U8_DOTS(A1, 1); U8_LOAD(A1, TN, kn, 1);
                U8_DOTS(A2, 2); U8_LOAD(A2, TN, kn, 2);
                U8_DOTS(A3, 3); U8_LOAD(A3, TN, kn, 3);
                int q8[8], q4[4], q2[2];
#pragma unroll
                for (int j = 0; j < 8; ++j) { const int snd = c2 ? pd[j] : pd[j + 8], kp = c2 ? pd[j + 8] : pd[j]; q8[j] = kp + __shfl_xor(snd, 4); }
#pragma unroll
                for (int j = 0; j < 4; ++j) { const int snd = c1 ? q8[j] : q8[j + 4], kp = c1 ? q8[j + 4] : q8[j]; q4[j] = kp + __builtin_amdgcn_update_dpp(0, snd, 0x4E, 0xF, 0xF, true); }
#pragma unroll
                for (int j = 0; j < 2; ++j) { const int snd = c0 ? q4[j] : q4[j + 2], kp = c0 ? q4[j + 2] : q4[j]; q2[j] = kp + __builtin_amdgcn_update_dpp(0, snd, 0xB1, 0xF, 0xF, true); }
                if (e < NSW - 1) {
#pragma unroll
                    for (int m = 0; m < 2; ++m) { const int ad = k * 128 + 8 * (ib + m) + slot8; CLI[ad] = e == 0 ? q2[m] : CLI[ad] + q2[m]; }
                } else {
                    const float rstd = rsqrtf(wave_sum(fsq) * (0.25f / D) + EPS), hs = HSL[k];
                    float cv[2];
#pragma unroll
                    for (int m = 0; m < 2; ++m) { const int ad = k * 128 + 8 * (ib + m) + slot8;
                        const float dot = (float)(CLI[ad] + q2[m]) * hs;
                        const unsigned pk = __builtin_bit_cast(unsigned, fus[m]);
                        cv[m] = fg[m] * __builtin_bit_cast(float, pk & 0xffff0000u) * gelu_tanh(dot * rstd * __builtin_bit_cast(float, pk << 16)); }
                    float cm = fmaxf(fabsf(cv[0]), fabsf(cv[1]));
#pragma unroll
                    for (int o = 1; o < 64; o <<= 1) cm = fmaxf(cm, __shfl_xor(cm, o));
                    const float cmx = cm > 0.f ? cm : 1.f, s6 = 6.f / cmx;
                    float r0 = cv[0] * s6, r1 = cv[1] * s6;
                    const int ab = k * 256 + (c2 ? 32 : 0) + 8 * ((c1 ? 2 : 0) + (c0 ? 1 : 0)) + slot8;
#pragma unroll
                    for (int t = 0; t < 4; ++t) { float f0, f1; const unsigned n0 = fp4_enc(r0, f0), n1 = fp4_enc(r1, f1);
                        AT[ab + 64 * t] = (unsigned char)(n0 | (n1 << 4)); r0 = (r0 - f0) * 6.f; r1 = (r1 - f1) * 6.f; }
                    if (lane == 0) CM[k] = cmx;
                }
                k = kn; e = en;
            }
        }
#undef U8_TAB
#undef U8_LOAD
#undef U8_DOTS
        {
            const int m16 = lane & 15, g4 = lane >> 4;
            struct VB4 { u32x4 r[4]; };
#define V4_TAB(qq) MKRSRC(a.ws + WS_VB + ((size_t)layer * 4 + (qq)) * NEXP * 128, NEXP * 128)
#define V4_LOAD(BUF, T, kk, bt) do { int ev[4]; _Pragma("unroll") for (int j = 0; j < 4; ++j) ev[j] = IDXS[(kk) * 128 + 32 * (bt) + 8 * j + slot8]; \
                asm volatile("" : "+v"(ev[0]), "+v"(ev[1]), "+v"(ev[2]), "+v"(ev[3])); \
                _Pragma("unroll") for (int j = 0; j < 4; ++j) BUF.r[j] = __builtin_amdgcn_raw_buffer_load_b128(T, ev[j] * 128 + chunk8 * 16, 0, 0); } while (0)
#define MF_STAGE(BUF, bt) do { _Pragma("unroll") for (int j = 0; j < 4; ++j) { const int Ip = 4 * ((bt) & 1) + j; const u32x4 w_ = BUF.r[j]; \
                *(LAS u32x4*)(ST + (16 * (Ip >> 1) + 2 * slot8 + (Ip & 1)) * MF_PITCH + 16 * chunk8) = ((Ip >> 1) & 1) ? (u32x4){w_[2], w_[3], w_[0], w_[1]} : w_; } } while (0)
#define MF_MMA(hh) do { const i32x8_t av = (i32x8_t){(int)aop[hh][0], (int)aop[hh][1], 0, 0, 0, 0, 0, 0}; \
                _Pragma("unroll") for (int nb = 0; nb < 16; ++nb) { const v2i_t b = __builtin_amdgcn_ds_read_tr4_b64_v2i32((LAS v2i_t*)(ST + (16 * g4 + m16) * MF_PITCH + ((nb & 1) ? -8 : 8) * (g4 & 1) + 8 * nb)); \
                    acc[nb] = __builtin_amdgcn_mfma_scale_f32_16x16x128_f8f6f4(av, (i32x8_t){b[0], b[1], 0, 0, 0, 0, 0, 0}, acc[nb], 4, 4, 0, 0, 0, 0); } } while (0)
            VB4 A0, A1, A2, A3;
            { const __amdgpu_buffer_rsrc_t T0 = V4_TAB(0); V4_LOAD(A0, T0, 0, 0); V4_LOAD(A1, T0, 0, 1); V4_LOAD(A2, T0, 0, 2); V4_LOAD(A3, T0, 0, 3); }
            const int total = 4 * nk;
            int q = 0, k = 0;
#pragma unroll 1
            for (int f = 0; f < total; ++f) {
                const int row = gw + k * nw;
                f32x4 acc[16];
#pragma unroll
                for (int j = 0; j < 16; ++j) acc[j] = (f32x4){0.f, 0.f, 0.f, 0.f};
                u32x2 aop[2];
#pragma unroll
                for (int hh = 0; hh < 2; ++hh) { const u32x2 t = *(const LAS u32x2*)(AT + k * 256 + (m16 & 3) * 64 + hh * 32 + 8 * g4); aop[hh] = m16 < 4 ? t : (u32x2){0u, 0u}; }
                const float cmx = CM[k];
                int kn = k + 1, qn = q; if (kn == nk) { kn = 0; ++qn; }
                if (f + 1 == total) { kn = k; qn = q; }
                const __amdgpu_buffer_rsrc_t TN = V4_TAB(qn);
                const int hoff = q * 512 + m16 * 32;
                const u32x4 hr0 = __builtin_amdgcn_raw_buffer_load_b128(Hr, hoff, row * 2048, 0), hr1 = __builtin_amdgcn_raw_buffer_load_b128(Hr, hoff + 16, row * 2048, 0);
                MF_STAGE(A0, 0); V4_LOAD(A0, TN, kn, 0);
                MF_STAGE(A1, 1); V4_LOAD(A1, TN, kn, 1);
                MF_MMA(0);
                MF_STAGE(A2, 2); V4_LOAD(A2, TN, kn, 2);
                MF_STAGE(A3, 3); V4_LOAD(A3, TN, kn, 3);
                MF_MMA(1);
                float y[16];
#pragma unroll
                for (int nb = 0; nb < 16; ++nb) y[nb] = cmx * (acc[nb][0] * (1.f / 6.f) + acc[nb][1] * (1.f / 36.f) + acc[nb][2] * (1.f / 216.f) + acc[nb][3] * (1.f / 1296.f));
#pragma unroll
                for (int i = 0; i < 4; ++i) { y[2 * i] += bflo(hr0[i]); y[2 * i + 1] += bfhi(hr0[i]); y[8 + 2 * i] += bflo(hr1[i]); y[9 + 2 * i] += bfhi(hr1[i]); }
                if (FINAL) {
                    if (lane < 16) {
#pragma unroll
                        for (int i = 0; i < 4; ++i) __builtin_amdgcn_raw_buffer_store_b128(__builtin_bit_cast(u32x4, (f32x4){y[4 * i], y[4 * i + 1], y[4 * i + 2], y[4 * i + 3]}), Or, 2 * hoff + 16 * i, row * 4096, 0);
                    }
                } else {
                    unsigned w[8]; float ss = 0.f;
#pragma unroll
                    for (int i = 0; i < 8; ++i) { w[i] = pk2(y[2 * i], y[2 * i + 1]); const float a0 = bflo(w[i]), a1 = bfhi(w[i]); ss += a0 * a0 + a1 * a1; }
                    ss = wave_sum(lane < 16 ? ss : 0.f);
                    if (lane < 16) { __builtin_amdgcn_raw_buffer_store_b128((u32x4){w[0], w[1], w[2], w[3]}, Or, hoff, row * 2048, 0); __builtin_amdgcn_raw_buffer_store_b128((u32x4){w[4], w[5], w[6], w[7]}, Or, hoff + 16, row * 2048, 0); }
                    if (lane == 0) { const float t = q == 0 ? ss : RSL[k] + ss; RSL[k] = t; if (q == 3) RSout[row] = rsqrtf(t * (1.f / D) + EPS); }
                }
                k = kn; q = qn;
            }
#undef V4_TAB
#undef V4_LOAD
#undef MF_STAGE
#undef MF_MMA
        }
    }
}

constexpr int PF_SP = 528, PF_RS = 75520, PF_DT = 76096;
static_assert(PF_DT + 128 * PF_SP <= OPT_LDS_C - 16, "fused pooling LDS");
template <int W>
__device__ __forceinline__ void pf_diffs(LAS unsigned char* lds, int tid) {
    const int cp = tid & 127, rq = tid >> 7;
    const LAS float* RSv = (const LAS float*)(lds + PF_RS);
    float s0 = 0.f, s1 = 0.f;
#pragma unroll
    for (int j = 1; j < W; ++j) { const int i = 15 + 32 * rq - j; const unsigned hv = *(const LAS unsigned*)(lds + i * PF_SP + 4 * cp); const float rs = RSv[i]; s0 = __builtin_fmaf(bflo(hv), rs, s0); s1 = __builtin_fmaf(bfhi(hv), rs, s1); }
    constexpr float inv = 1.f / (float)W;
#pragma unroll 1
    for (int t0 = 0; t0 < 32; t0 += 4) {
        unsigned hn[4], ho[4]; float rn[4], ro[4];
#pragma unroll
        for (int t = 0; t < 4; ++t) { const int i = 15 + 32 * rq + t0 + t, io = i - W + 1;
            hn[t] = *(const LAS unsigned*)(lds + i * PF_SP + 4 * cp); ho[t] = *(const LAS unsigned*)(lds + io * PF_SP + 4 * cp); rn[t] = RSv[i]; ro[t] = -RSv[io]; }
        unsigned dv[4];
#pragma unroll
        for (int t = 0; t < 4; ++t) { const float n0 = bflo(hn[t]) * rn[t], n1 = bfhi(hn[t]) * rn[t];
            s0 += n0; s1 += n1;
            dv[t] = pg8::cvt_pk_bf16(__builtin_fmaf(s0, inv, -n0), __builtin_fmaf(s1, inv, -n1));
            s0 = __builtin_fmaf(bflo(ho[t]), ro[t], s0); s1 = __builtin_fmaf(bfhi(ho[t]), ro[t], s1); }
#pragma unroll
        for (int t = 0; t < 4; ++t) *(LAS unsigned*)(lds + PF_DT + (32 * rq + t0 + t) * PF_SP + 4 * cp) = dv[t];
    }
}
__device__ __forceinline__ void p78_pool_fused(const Args& a, LAS unsigned char* lds) {
    const int tid = opaque_tid(), lane = tid & 63, wave = __builtin_amdgcn_readfirstlane(tid >> 6), r32 = lane & 31, hi = lane >> 5;
    const bf16_t* H2 = (const bf16_t*)(a.ws + WS_XB); const float* RS2 = (const float*)(a.ws + WS_RS2); const bf16_t* PoolT = (const bf16_t*)(a.ws + WS_POOL);
    bf16_t* H3 = (bf16_t*)(a.ws + WS_H1); float* SSQ = (float*)(a.ws + WS_SSQ3);
    LAS float* RSv = (LAS float*)(lds + PF_RS);
    u32x4 sv[9]; float rv[9];
#define PF_FETCH(UU) do { const int t_ = opaque_tid(), rr_ = t_ >> 5, c16_ = t_ & 31; const int g_ = (UU) & 3, r0_ = ((UU) >> 2) * 128, b_ = r0_ >> 14, p0_ = (r0_ & (SEQ - 1)) + NMETA; \
        _Pragma("unroll") for (int ps = 0; ps < 9; ++ps) { const int i = ps * 16 + rr_, ic = i < 143 ? i : 142, row = ic < 15 ? prow(b_, p0_ - (15 - ic)) : r0_ + ic - 15; \
            sv[ps] = *(const u32x4*)(H2 + (size_t)row * D + g_ * 256 + 8 * c16_); rv[ps] = RS2[row]; } } while (0)
    if ((int)blockIdx.x < (XROWS / 128) * 4) PF_FETCH((int)blockIdx.x);
#pragma unroll 1
    for (int u = (int)blockIdx.x; u < (XROWS / 128) * 4; u += (int)gridDim.x) {
        const int g = u & 3, r0 = (u >> 2) * 128;
        bf16x8_t wf[16];
#pragma unroll
        for (int ks = 0; ks < 16; ++ks) wf[ks] = *(const bf16x8_t*)(PoolT + (size_t)(g * 256 + 32 * wave + r32) * 256 + 16 * ks + 8 * hi);
        { const int t_ = opaque_tid(), rr_ = t_ >> 5, c16_ = t_ & 31;
#pragma unroll
          for (int ps = 0; ps < 9; ++ps) { const int i = ps * 16 + rr_; if (i < 143) { *(LAS u32x4*)(lds + i * PF_SP + 16 * c16_) = sv[ps]; if (c16_ == 0) RSv[i] = rv[ps]; } } }
        { const int un = u + (int)gridDim.x; if (un < (XROWS / 128) * 4) PF_FETCH(un); }
        __builtin_amdgcn_sched_barrier(0);
        __syncthreads();
        { const int t_ = opaque_tid(); if (g == 0) pf_diffs<2>(lds, t_); else if (g == 1) pf_diffs<4>(lds, t_); else if (g == 2) pf_diffs<8>(lds, t_); else pf_diffs<16>(lds, t_); }
        __syncthreads();
        f32x16 acc[4];
#pragma unroll
        for (int mb = 0; mb < 4; ++mb) acc[mb] = (f32x16){0.f, 0.f, 0.f, 0.f, 0.f, 0.f, 0.f, 0.f, 0.f, 0.f, 0.f, 0.f, 0.f, 0.f, 0.f, 0.f};
        {
            bf16x8_t dfa[4];
#define PF_LDF(DST, ks) do { _Pragma("unroll") for (int mb = 0; mb < 4; ++mb) DST[mb] = *(const LAS bf16x8_t*)(lds + PF_DT + (32 * mb + r32) * PF_SP + 32 * (ks) + 16 * hi); } while (0)
#define PF_MMA(SRC, ks) do { _Pragma("unroll") for (int mb = 0; mb < 4; ++mb) acc[mb] = __builtin_amdgcn_mfma_f32_32x32x16_bf16(wf[ks], SRC[mb], acc[mb], 0, 0, 0); } while (0)
#pragma unroll
            for (int ks = 0; ks < 16; ++ks) { PF_LDF(dfa, ks); __builtin_amdgcn_sched_barrier(0); PF_MMA(dfa, ks); __builtin_amdgcn_sched_barrier(0); }
#undef PF_LDF
#undef PF_MMA
        }
        __syncthreads();
#pragma unroll
        for (int mb = 0; mb < 4; ++mb)
#pragma unroll
            for (int q = 0; q < 4; ++q)
                *(LAS u32x2*)(lds + PF_DT + (32 * mb + r32) * PF_SP + (32 * wave + 8 * q + 4 * hi) * 2) = (u32x2){pg8::cvt_pk_bf16(acc[mb][4 * q], acc[mb][4 * q + 1]), pg8::cvt_pk_bf16(acc[mb][4 * q + 2], acc[mb][4 * q + 3])};
        __syncthreads();
        {
            const int t_ = opaque_tid(), rr = t_ >> 5, c16 = t_ & 31;
#pragma unroll
            for (int ps = 0; ps < 8; ++ps) { const int r = ps * 16 + rr;
                const u32x4 ov = *(const LAS u32x4*)(lds + PF_DT + r * PF_SP + 16 * c16), hv = *(const LAS u32x4*)(lds + (15 + r) * PF_SP + 16 * c16);
                u32x4 w; float ss = 0.f;
#pragma unroll
                for (int j = 0; j < 4; ++j) { w[j] = pg8::cvt_pk_bf16(bflo(hv[j]) + bflo(ov[j]), bfhi(hv[j]) + bfhi(ov[j])); const float lo = bflo(w[j]), h2 = bfhi(w[j]); ss += lo * lo + h2 * h2; }
                *(u32x4*)(H3 + (size_t)(r0 + r) * D + g * 256 + 8 * c16) = w;
                ss += dpp_xor1(ss); ss += dpp_xor2(ss); ss += __shfl_xor(ss, 4);
                if ((c16 & 7) == 0) SSQ[(size_t)(r0 + r) * 16 + 4 * g + (c16 >> 3)] = ss; }
        }
        __syncthreads();
    }
#undef PF_FETCH
}
template <int F4> __device__ __forceinline__ void table_store(const f32x16& x, __amdgpu_buffer_rsrc_t T, int it, int lane, LAS unsigned char* tt) {
    if (F4 == 2) {
        unsigned w[4] = {0u, 0u, 0u, 0u};
#pragma unroll
        for (int i = 0; i < 16; ++i) { int q = (int)__builtin_rintf(x[i]); q = q > 127 ? 127 : q < -127 ? -127 : q; w[i >> 2] |= ((unsigned)q & 0xffu) << (8 * (i & 3)); }
        __builtin_amdgcn_raw_buffer_store_b128((u32x4){w[0], w[1], w[2], w[3]}, T, (lane & 7) * 16, (((it >> 14) * 8 + (lane >> 3)) * NEXP + (it & (NEXP - 1))) * 128, 0);
    } else if (F4 == 3) {
        unsigned w[2] = {0u, 0u};
#pragma unroll
        for (int i = 0; i < 16; ++i) { int q = (int)__builtin_rintf(x[i]); q = q > 7 ? 7 : q < -7 ? -7 : q; w[i >> 3] |= ((unsigned)q & 0xfu) << (4 * (i & 7)); }
        __builtin_amdgcn_raw_buffer_store_b64((u32x2){w[0], w[1]}, T, (lane & 15) * 8, (((it >> 14) * 4 + (lane >> 4)) * NEXP + (it & (NEXP - 1))) * 128, 0);
    } else if (F4 == 1) {
        unsigned w[2] = {0u, 0u};
#pragma unroll
        for (int i = 0; i < 16; ++i) { const float v = x[i], ax = fabsf(v);
            const float k = ax < 2.f ? __builtin_rintf(ax * 2.f) : ax < 4.f ? __builtin_rintf(ax) + 2.f : __builtin_rintf(ax * 0.5f) + 4.f;
            unsigned m = (unsigned)k; m = m > 7u ? 7u : m; const unsigned c = m | (v < 0.f ? 8u : 0u);
            w[i >> 3] |= c << (4 * (i & 7)); }
        if (VMF) {
            *(LAS u32x2*)(tt + lane * 8) = (u32x2){w[0], w[1]};
            const v2i_t t = __builtin_amdgcn_ds_read_tr4_b64_v2i32((LAS v2i_t*)(tt + lane * 8));
            w[0] = (unsigned)t[0]; w[1] = (unsigned)t[1];
        }
        if (CQ) __builtin_amdgcn_raw_buffer_store_b64((u32x2){w[0], w[1]}, T, (lane & 15) * 8, (((it >> 14) * 4 + (lane >> 4)) * NEXP + (it & (NEXP - 1))) * 128, 0);
        else __builtin_amdgcn_raw_buffer_store_b64((u32x2){w[0], w[1]}, T, lane * 8, it * 512, 0);
    } else {
        unsigned w[3] = {0u, 0u, 0u};
#pragma unroll
        for (int i = 0; i < 16; ++i) { const float v = x[i], ax = fabsf(v);
            const float k = ax < 2.f ? __builtin_rintf(ax * 8.f) : ax < 4.f ? __builtin_rintf(ax * 4.f) + 8.f : __builtin_rintf(ax * 2.f) + 16.f;
            unsigned m = (unsigned)k; m = m > 31u ? 31u : m; const unsigned c = m | (v < 0.f ? 32u : 0u);
            const int bp = 6 * i, wd = bp >> 5, sh = bp & 31;
            w[wd] |= c << sh; if (sh > 26) w[wd + 1] |= c >> (32 - sh); }
        if (CQ) __builtin_amdgcn_raw_buffer_store_b96((u32x3){w[0], w[1], w[2]}, T, (lane & 15) * 12, (((it >> 14) * 4 + (lane >> 4)) * NEXP + (it & (NEXP - 1))) * 192, 0);
        else __builtin_amdgcn_raw_buffer_store_b96((u32x3){w[0], w[1], w[2]}, T, lane * 12, it * 768, 0);
    }
}
constexpr int TT_PITCH = 132, TT_BYTES = 64 * TT_PITCH;
template <class SCol, class DRow, class NS>
__device__ __forceinline__ void tile_transpose(const float* src, int ldsrc, const float* ks, bf16_t* dst, int ldd, int k0, SCol scol, DRow drow, NS ns, LAS unsigned char* tt, int lane) {
    const int sc = scol(lane); const float nsv = ns(lane);
    float tv[64];
#pragma unroll
    for (int kk = 0; kk < 64; ++kk) tv[kk] = src[(size_t)(k0 + kk) * ldsrc + sc];
#pragma unroll
    for (int kk = 0; kk < 64; ++kk) {
        const float v = tv[kk] * (ks ? ks[k0 + kk] : 1.f) * nsv;
        *(LAS unsigned short*)(tt + lane * TT_PITCH + kk * 2) = f2bf(v);
    }
#pragma unroll
    for (int i = 0; i < 8; ++i) {
        const int c = lane + 64 * i, n = c >> 3, part = c & 7;
        const LAS unsigned* rp = (const LAS unsigned*)(tt + n * TT_PITCH + part * 16);
        u32x4 w; w[0] = rp[0]; w[1] = rp[1]; w[2] = rp[2]; w[3] = rp[3];
        *(u32x4*)(dst + (size_t)drow(n) * ldd + k0 + part * 8) = w;
    }
}
__device__ __forceinline__ void p0_prep_opt(const Args& a, LAS unsigned char* lds) {
    unsigned char* ws = a.ws;
    const int tid = opaque_tid(), lane = tid & 63, wave = __builtin_amdgcn_readfirstlane(tid >> 6);
    const int gw = (int)blockIdx.x * 8 + wave, nw = (int)gridDim.x * 8;
    const long gtid = (long)blockIdx.x * 512 + tid, gsz = (long)gridDim.x * 512;
    LAS unsigned char* tt = lds + wave * TT_BYTES;
    bf16_t* WinT = (bf16_t*)(ws + WS_WIN); bf16_t* WoutT = (bf16_t*)(ws + WS_WOUT); bf16_t* WqT = (bf16_t*)(ws + WS_WQ);
    bf16_t* KeysB = (bf16_t*)(ws + WS_KEYS); bf16_t* PoolT = (bf16_t*)(ws + WS_POOL);
    bf16_t* UB = (bf16_t*)(ws + WS_UB); bf16_t* VB = (bf16_t*)(ws + WS_VB); bf16_t* XB = (bf16_t*)(ws + WS_XB); float* RS0 = (float*)(ws + WS_RS0);
    constexpr int I_IN = 16 * 48, I_OUT = 16 * 16, I_Q = 2 * 16 * 32, I_POOL = 4 * 4 * 4;
    for (int it = gw; it < I_IN + I_OUT + I_Q + I_POOL; it += nw) {
        int r = it;
        if (r < I_IN) { const int kb = r / 48, u64 = r % 48;
            tile_transpose(a.w_in, INC, a.even_g, WinT, D, kb * 64, [=](int n) { return win_srccol(u64, n); }, [=](int n) { return win_btrow(u64, n); }, [](int) { return 1.f; }, tt, lane); continue; }
        r -= I_IN;
        if (r < I_OUT) { const int kb = r / 16, nb = r % 16;
            tile_transpose(a.w_out, D, nullptr, WoutT, D, kb * 64, [=](int n) { return nb * 64 + n; }, [=](int n) { return nb * 64 + n; }, [](int) { return 1.f; }, tt, lane); continue; }
        r -= I_OUT;
        if (r < I_Q) { const int l = r / 512, kb = (r % 512) / 32, nb = r % 32;
            tile_transpose(a.w_query + (size_t)l * D * 2048, 2048, a.ffn_g + l * D, WqT + (size_t)l * 2048 * D, D, kb * 64, [=](int n) { return nb * 64 + n; }, [=](int n) { return nb * 64 + n; }, [](int) { return 1.f; }, tt, lane); continue; }
        r -= I_Q;
        { const int g = r / 16, kb = (r % 16) / 4, nb = r % 4; const float* psc = a.pool_scale + g * 256 + nb * 64;
            tile_transpose(a.pool_w + (size_t)g * 256 * 256, 256, a.odd_g + g * 256, PoolT + (size_t)g * 256 * 256, 256, kb * 64, [=](int n) { return nb * 64 + n; }, [=](int n) { return nb * 64 + n; }, [=](int n) { return psc[n]; }, tt, lane); }
    }
    for (long i = gtid; i < 2L * 2 * 8 * 128 * 128 / 4; i += gsz) { const f32x4 v = *(const f32x4*)(a.sub_keys + i * 4); *(uint2*)(KeysB + i * 4) = make_uint2(pk2(v[0], v[1]), pk2(v[2], v[3])); }
    {
        const __amdgpu_buffer_rsrc_t UT = MKRSRC(ws + WS_UB, 2 * NEXP * USTRIDE), VT = MKRSRC(ws + WS_VB, 2 * NEXP * VSTRIDE);
        float* US = (float*)(ws + WS_UB + 32 * MiB); float* VS = (float*)(ws + WS_VB + 32 * MiB);
        f32x4 nu[4], nv[4], mu[4], mv[4];
#define TB_LD(U, V, itx) do { if ((itx) < 2 * NEXP) { _Pragma("unroll") for (int q = 0; q < 4; ++q) { U[q] = *(const f32x4*)(a.peer_u + (size_t)(itx) * D + 16 * lane + 4 * q); V[q] = *(const f32x4*)(a.peer_v + (size_t)(itx) * D + 16 * lane + 4 * q); } } } while (0)
        TB_LD(nu, nv, gw); TB_LD(mu, mv, gw + nw);
#pragma unroll 1
        for (int it = gw; it < 2 * NEXP; it += nw) {
            const int l = it >> 14;
            const float* gp = a.ffn_g + l * D + 16 * lane;
            f32x4 cu[4], cv[4];
#pragma unroll
            for (int q = 0; q < 4; ++q) { cu[q] = nu[q]; cv[q] = nv[q]; nu[q] = mu[q]; nv[q] = mv[q]; }
            TB_LD(mu, mv, it + 2 * nw);
            __builtin_amdgcn_sched_barrier(0);
            f32x16 u, v; float au = 0.f, av = 0.f;
#pragma unroll
            for (int q = 0; q < 4; ++q) { const f32x4 uu = cu[q] * *(const f32x4*)(gp + 4 * q), vv = cv[q];
#pragma unroll
                for (int i = 0; i < 4; ++i) { u[4 * q + i] = uu[i]; v[4 * q + i] = vv[i]; au = fmaxf(au, fabsf(uu[i])); av = fmaxf(av, fabsf(vv[i])); } }
#pragma unroll
            for (int o = 1; o < 64; o <<= 1) { au = fmaxf(au, __shfl_xor(au, o)); av = fmaxf(av, __shfl_xor(av, o)); }
            const float su = au > 0.f ? au * (UI4 ? 1.f / 7.f : U8 ? 1.f / 127.f : U4 ? 1.f / 6.f : 1.f / 7.5f) : 1.f, sv = av > 0.f ? av * (V4 ? 1.f / 6.f : 1.f / 7.5f) : 1.f;
            if (VMF) {
                const unsigned bu = (__builtin_bit_cast(unsigned, su) + 0xffffu) & 0xffff0000u, bv = (__builtin_bit_cast(unsigned, sv) + 0xffffu) & 0xffff0000u;
                u = u * (1.f / __builtin_bit_cast(float, bu)); v = v * (1.f / __builtin_bit_cast(float, bv));
                if (lane == 0) ((unsigned*)US)[it] = (bu >> 16) | bv;
            } else { u = u * (1.f / su); v = v * (1.f / sv); if (lane == 0) { US[it] = su; VS[it] = sv; } }
            table_store<UI4 ? 3 : U8 ? 2 : U4 ? 1 : 0>(u, UT, it, lane, tt); table_store<V4 ? 1 : 0>(v, VT, it, lane, tt);
        }
#undef TB_LD
    }
    {
        f32x4 nx[4], mx[4];
        auto xsrc = [&](int row) { return row < XROWS ? a.x + (size_t)row * D : a.meta + (size_t)(row < NROWS ? row - MROW0 : 0) * D; };
#define XR_LD(X, rw) do { if ((rw) < RP) { _Pragma("unroll") for (int j = 0; j < 4; ++j) X[j] = *(const f32x4*)(xsrc(rw) + 256 * j + 4 * lane); } } while (0)
        XR_LD(nx, gw); XR_LD(mx, gw + nw);
#pragma unroll 1
        for (int row = gw; row < RP; row += nw) {
            f32x4 cx[4];
#pragma unroll
            for (int j = 0; j < 4; ++j) { cx[j] = nx[j]; nx[j] = mx[j]; }
            XR_LD(mx, row + 2 * nw);
            __builtin_amdgcn_sched_barrier(0);
            bf16_t* o = XB + (size_t)row * D;
            if (row >= NROWS) { for (int j = 0; j < 4; ++j) *(uint2*)(o + 256 * j + 4 * lane) = make_uint2(0u, 0u); if (lane == 0) RS0[row] = 1.f; continue; }
            float ss = 0.f;
#pragma unroll
            for (int j = 0; j < 4; ++j) { const f32x4 v = cx[j]; ss += v[0] * v[0] + v[1] * v[1] + v[2] * v[2] + v[3] * v[3];
                *(uint2*)(o + 256 * j + 4 * lane) = make_uint2(pk2(v[0], v[1]), pk2(v[2], v[3])); }
            ss = wave_sum(ss);
            if (lane == 0) RS0[row] = rsqrtf(ss * (1.f / D) + EPS);
        }
    }
}
template <int W>
__device__ __forceinline__ void poold_run(const bf16_t* H2, const float* RS2, bf16_t* Dm, int row0, int c8) {
    const int b = row0 >> 14, p0 = (row0 & (SEQ - 1)) + NMETA;
    float s[8];
#pragma unroll
    for (int q = 0; q < 8; ++q) s[q] = 0.f;
#pragma unroll
    for (int j = 1; j < W; ++j) { const int r = prow(b, p0 - j); const float rs = RS2[r]; const u32x4 hv = *(const u32x4*)(H2 + (size_t)r * D + c8);
#pragma unroll
        for (int q = 0; q < 4; ++q) { s[2 * q] += bflo(hv[q]) * rs; s[2 * q + 1] += bfhi(hv[q]) * rs; } }
    constexpr float inv = 1.f / (float)W;
#pragma unroll 1
    for (int t0 = 0; t0 < 32; t0 += 8) {
        u32x4 hn[8], ho[8]; float rn[8], ro[8];
#pragma unroll
        for (int t = 0; t < 8; ++t) { const int p = p0 + t0 + t, r = row0 + t0 + t, po = prow(b, p - W + 1);
            hn[t] = *(const u32x4*)(H2 + (size_t)r * D + c8); rn[t] = RS2[r]; ho[t] = *(const u32x4*)(H2 + (size_t)po * D + c8); ro[t] = RS2[po]; }
#pragma unroll
        for (int t = 0; t < 8; ++t) { u32x4 ov;
#pragma unroll
            for (int q = 0; q < 4; ++q) { const float nl = bflo(hn[t][q]) * rn[t], nh = bfhi(hn[t][q]) * rn[t];
                s[2 * q] += nl; s[2 * q + 1] += nh;
                ov[q] = pk2(s[2 * q] * inv - nl, s[2 * q + 1] * inv - nh);
                s[2 * q] -= bflo(ho[t][q]) * ro[t]; s[2 * q + 1] -= bfhi(ho[t][q]) * ro[t]; }
            *(u32x4*)(Dm + (size_t)(row0 + t0 + t) * D + c8) = ov; }
    }
}
__device__ __forceinline__ void p7_poold_opt(const Args& a, bf16_t* Dm) {
    const bf16_t* H2 = (const bf16_t*)(a.ws + WS_XB); const float* RS2 = (const float*)(a.ws + WS_RS2);
    const int tid = opaque_tid(), lane = tid & 63, wave = __builtin_amdgcn_readfirstlane(tid >> 6);
    const int gw = wave * (int)gridDim.x + (int)blockIdx.x, nw = (int)gridDim.x * 8;
    for (int it = gw; it < (XROWS / 64) * 4; it += nw) {
        const int g = it & 3, row0 = ((it >> 2) * 2 + (lane >> 5)) * 32, c8 = g * 256 + (lane & 31) * 8;
        if (g == 0) poold_run<2>(H2, RS2, Dm, row0, c8);
        else if (g == 1) poold_run<4>(H2, RS2, Dm, row0, c8);
        else if (g == 2) poold_run<8>(H2, RS2, Dm, row0, c8);
        else poold_run<16>(H2, RS2, Dm, row0, c8);
    }
}


template <class BRow>
__device__ __forceinline__ bool meta_unit(const bf16_t* A, int lda, const bf16_t* Bt, BRow brow, f32x4 (&acc)[4], LAS unsigned char* lds, int wave, int lane) {
    const int n16 = lane & 15, kg = lane >> 4, k0 = 128 * wave + 8 * kg;
    bf16x8_t af[4], bfr[4][4];
#pragma unroll
    for (int ks = 0; ks < 4; ++ks) { af[ks] = *(const bf16x8_t*)(A + (size_t)n16 * lda + k0 + 32 * ks);
#pragma unroll
        for (int t = 0; t < 4; ++t) bfr[t][ks] = *(const bf16x8_t*)(Bt + (size_t)brow(16 * t + n16) * D + k0 + 32 * ks); }
#pragma unroll
    for (int t = 0; t < 4; ++t) { acc[t] = (f32x4){0.f, 0.f, 0.f, 0.f};
#pragma unroll
        for (int ks = 0; ks < 4; ++ks) acc[t] = __builtin_amdgcn_mfma_f32_16x16x32_bf16(af[ks], bfr[t][ks], acc[t], 0, 0, 0); }
    LAS f32x4* part = (LAS f32x4*)lds;
#pragma unroll
    for (int t = 0; t < 4; ++t) part[(wave * 4 + t) * 64 + lane] = acc[t];
    __syncthreads();
    if (wave == 0) {
#pragma unroll
        for (int t = 0; t < 4; ++t) { f32x4 sum = part[t * 64 + lane];
#pragma unroll
            for (int w = 1; w < 8; ++w) sum += part[(w * 4 + t) * 64 + lane];
            acc[t] = sum; }
    }
    __syncthreads();
    return wave == 0;
}
__device__ __forceinline__ void meta_p1(const Args& a, int u64, LAS unsigned char* lds, int wave, int lane) {
    unsigned char* ws = a.ws; bf16_t* P1 = (bf16_t*)(ws + WS_P1); const float* RS0 = (const float*)(ws + WS_RS0);
    f32x4 acc[4];
    if (!meta_unit((const bf16_t*)(ws + WS_XB) + (size_t)MROW0 * D, D, (const bf16_t*)(ws + WS_WIN), [=](int d) { return win_btrow(u64, d); }, acc, lds, wave, lane)) return;
    const int n16 = lane & 15, r4 = (lane >> 4) * 4;
#pragma unroll
    for (int i = 0; i < 4; ++i) { const int row = MROW0 + r4 + i; const float sc = RS0[row];
        float v[4]; float ss = 0.f;
#pragma unroll
        for (int t = 0; t < 4; ++t) { v[t] = acc[t][i] * sc; ss += v[t] * v[t]; }
        bf16_t* o = P1 + (size_t)row * P1W;
        if (u64 < 16) {
            ss += __shfl_xor(ss, 1); ss += __shfl_xor(ss, 2); ss += __shfl_xor(ss, 4); ss += __shfl_xor(ss, 8);
            const float r = rsqrtf(ss * (1.f / 64.f) + EPS) * (u64 < 8 ? 0.125f * LOG2E : 1.f); const float* g = u64 < 8 ? a.qg : a.kg;
#pragma unroll
            for (int t = 0; t < 4; ++t) o[u64 * 64 + 16 * t + n16] = f2bf(v[t] * r * g[16 * t + n16]);
        } else if (u64 < 32) {
#pragma unroll
            for (int t = 0; t < 4; ++t) o[u64 * 64 + 16 * t + n16] = f2bf(v[t]);
        } else {
            o[2048 + 32 * (u64 - 32) + n16] = f2bf(v[0] * v[2]); o[2048 + 32 * (u64 - 32) + 16 + n16] = f2bf(v[1] * v[3]);
        }
    }
}
__device__ __forceinline__ void meta_p3(const Args& a, int u, LAS unsigned char* lds, int wave, int lane) {
    unsigned char* ws = a.ws; bf16_t* H1 = (bf16_t*)(ws + WS_H1); float* SSQ1 = (float*)(ws + WS_SSQ1);
    f32x4 acc[4];
    if (!meta_unit((const bf16_t*)a.out + (size_t)MROW0 * D, D, (const bf16_t*)(ws + WS_WOUT), [=](int d) { return u * 64 + d; }, acc, lds, wave, lane)) return;
    const int n16 = lane & 15, r4 = (lane >> 4) * 4;
#pragma unroll
    for (int i = 0; i < 4; ++i) { const int row = MROW0 + r4 + i; float ss = 0.f;
#pragma unroll
        for (int t = 0; t < 4; ++t) { const int col = u * 64 + 16 * t + n16; const bf16_t hb = f2bf(a.meta[(size_t)(r4 + i) * D + col] + acc[t][i]); const float hv = bf2f(hb); ss += hv * hv; H1[(size_t)row * D + col] = hb; }
        ss += __shfl_xor(ss, 1); ss += __shfl_xor(ss, 2); ss += __shfl_xor(ss, 4); ss += __shfl_xor(ss, 8);
        if (n16 == 0) SSQ1[(size_t)row * 16 + u] = ss; }
}
__device__ __forceinline__ void meta_p4(const Args& a, int u, LAS unsigned char* lds, int wave, int lane) {
    unsigned char* ws = a.ws; bf16_t* QP = (bf16_t*)(ws + WS_P1);
    f32x4 acc[4];
    if (!meta_unit((const bf16_t*)(ws + WS_H1) + (size_t)MROW0 * D, D, (const bf16_t*)(ws + WS_WQ), [=](int d) { return u * 64 + d; }, acc, lds, wave, lane)) return;
    const int n16 = lane & 15, r4 = (lane >> 4) * 4;
#pragma unroll
    for (int i = 0; i < 4; ++i)
#pragma unroll
        for (int t = 0; t < 4; ++t) QP[(size_t)(MROW0 + r4 + i) * 2048 + u * 64 + 16 * t + n16] = f2bf(acc[t][i]);
}

constexpr int NPHASE = 12;
constexpr int OPT_THREADS = 512, OPT_LDS = 147456;

template <int PH> __device__ __forceinline__ void run_naive(const Args& a, long gtid, long gsz) {
    bf16_t* MIX = (bf16_t*)a.out;
    if (PH == 0) p0_prep(a, gtid, gsz);
    if (PH == 1) p1_gemm_in(a, gtid, gsz);
    if (PH == 2) p2_attn_conv(a, MIX, gtid, gsz);
    if (PH == 3) p3_gemm_out(a, MIX, gtid, gsz);
    if (PH == 4) p4_gemm_q(a, 0, (const bf16_t*)(a.ws + WS_H1), NROWS, gtid, gsz);
    if (PH == 5) p5_topk(a, 0, (const float*)(a.ws + WS_SSQ1), NROWS, gtid, gsz);
    if (PH == 6) p6_peer<false>(a, 0, (const bf16_t*)(a.ws + WS_H1), (const float*)(a.ws + WS_SSQ1), (bf16_t*)(a.ws + WS_XB), (float*)(a.ws + WS_RS2), NROWS, gtid, gsz);
    if (PH == 7) p7_poold(a, MIX, gtid, gsz);
    if (PH == 8) p8_gemm_pool(a, MIX, gtid, gsz);
    if (PH == 9) p4_gemm_q(a, 1, (const bf16_t*)(a.ws + WS_H1), XROWS, gtid, gsz);
    if (PH == 10) p5_topk(a, 1, (const float*)(a.ws + WS_SSQ3), XROWS, gtid, gsz);
    if (PH == 11) p6_peer<true>(a, 1, (const bf16_t*)(a.ws + WS_H1), (const float*)(a.ws + WS_SSQ3), nullptr, nullptr, XROWS, gtid, gsz);
}
template <int PH> __global__ void __launch_bounds__(256) k_naive(Args a) {
    run_naive<PH>(a, (long)blockIdx.x * blockDim.x + threadIdx.x, (long)gridDim.x * blockDim.x);
}

template <int PH> __device__ __forceinline__ void run_opt(const Args& a, LAS unsigned char* lds) {
    unsigned char* ws = a.ws;
    if (PH == 1) {
        pg8::Gemm g{(const bf16_t*)(ws + WS_XB), (const bf16_t*)(ws + WS_WIN), D, D, D, 0}; pg8::StaticOrder S; S.init(XROWS, INC, gridDim.x, blockIdx.x);
        pg8::EpiIn E{(bf16_t*)(ws + WS_P1), (const float*)(ws + WS_RS0), a.qg, a.kg};
        pg8::gemm_phase<pg8::EpiIn, pg8::StaticOrder, true, true>(lds, g, S, E);
        if (blockIdx.x < 48) { const int tid = opaque_tid(); meta_p1(a, (int)blockIdx.x, lds, __builtin_amdgcn_readfirstlane(tid >> 6), tid & 63); }
    }
    if (PH == 3) {
        pg8::Gemm g{(const bf16_t*)a.out, (const bf16_t*)(ws + WS_WOUT), D, D, D, 0}; pg8::StaticOrder S; S.init(XROWS, D, gridDim.x, blockIdx.x);
        pg8::EpiRes<0> E{a.x, a.meta, nullptr, (bf16_t*)(ws + WS_H1), (float*)(ws + WS_SSQ1)};
        pg8::gemm_phase<pg8::EpiRes<0>, pg8::StaticOrder, true, true>(lds, g, S, E);
        if (blockIdx.x < 16) { const int tid = opaque_tid(); meta_p3(a, (int)blockIdx.x, lds, __builtin_amdgcn_readfirstlane(tid >> 6), tid & 63); }
    }
    if (PH == 4 || PH == 9) {
        const int layer = PH == 4 ? 0 : 1;
        pg8::Gemm g{(const bf16_t*)(ws + WS_H1), (const bf16_t*)(ws + WS_WQ) + (size_t)layer * 2048 * D, D, D, D, 0}; pg8::StaticOrder S; S.init(XROWS, 2048, gridDim.x, blockIdx.x);
        pg8::EpiPlain E{(bf16_t*)(ws + WS_P1), 2048};
        pg8::gemm_phase<pg8::EpiPlain, pg8::StaticOrder, true, true>(lds, g, S, E);
        if (PH == 4 && blockIdx.x < 32) { const int tid = opaque_tid(); meta_p4(a, (int)blockIdx.x, lds, __builtin_amdgcn_readfirstlane(tid >> 6), tid & 63); }
    }
    if (PH == 0) p0_prep_opt(a, lds);
    if (PH == 7) p7_poold_opt(a, (bf16_t*)a.out);
    if (PH == 2) p2_attn_opt(a, (bf16_t*)a.out, lds);
    if (PH == 5) p5_topk_opt(a, 0, (const float*)(ws + WS_SSQ1), RP / 256, lds);
    if (PH == 10) p5_topk_opt(a, 1, (const float*)(ws + WS_SSQ3), XROWS / 256, lds);
    if (PH == 6 || PH == 11) {
        const int tid = opaque_tid(), lane = tid & 63, wave = __builtin_amdgcn_readfirstlane(tid >> 6);
        const int gw = wave * gridDim.x + blockIdx.x, nw = gridDim.x * 8;
        if (CQ && VMF) { if (PH == 6) p6_peer_mf<false>(a, 0, (const bf16_t*)(ws + WS_H1), (const float*)(ws + WS_SSQ1), (bf16_t*)(ws + WS_XB), (float*)(ws + WS_RS2), NROWS, lds);
                  else p6_peer_mf<true>(a, 1, (const bf16_t*)(ws + WS_H1), (const float*)(ws + WS_SSQ3), nullptr, nullptr, XROWS, lds); }
        else if (CQ) { if (PH == 6) p6_peer_cq<false>(a, 0, (const bf16_t*)(ws + WS_H1), (const float*)(ws + WS_SSQ1), (bf16_t*)(ws + WS_XB), (float*)(ws + WS_RS2), NROWS, lds);
                  else p6_peer_cq<true>(a, 1, (const bf16_t*)(ws + WS_H1), (const float*)(ws + WS_SSQ3), nullptr, nullptr, XROWS, lds); }
        else if (PH == 6) p6_peer6<false>(a, 0, (const bf16_t*)(ws + WS_H1), (const float*)(ws + WS_SSQ1), (bf16_t*)(ws + WS_XB), (float*)(ws + WS_RS2), NROWS, gw, nw, lane);
        else p6_peer6<true>(a, 1, (const bf16_t*)(ws + WS_H1), (const float*)(ws + WS_SSQ3), nullptr, nullptr, XROWS, gw, nw, lane);
    }
    if (PH == 8) {
        int kp = 256; asm volatile("" : "+s"(kp));
        pg8::Gemm g{(const bf16_t*)a.out, (const bf16_t*)(ws + WS_POOL), D, 256, kp, 256}; pg8::StaticOrder S; S.init(XROWS, D, gridDim.x, blockIdx.x);
        pg8::EpiRes<1> E{nullptr, nullptr, (const bf16_t*)(ws + WS_XB), (bf16_t*)(ws + WS_H1), (float*)(ws + WS_SSQ3)};
        pg8::gemm_phase<pg8::EpiRes<1>, pg8::StaticOrder, true, true>(lds, g, S, E);
    }
}
template <int PH> __global__ void __launch_bounds__(OPT_THREADS, 2) k_opt(Args a) {
    extern __shared__ __attribute__((aligned(16))) unsigned char lds_raw[];
    run_opt<PH>(a, (LAS unsigned char*)lds_raw);
}

template <int PH> static void launch_naive(const Args& a, hipStream_t s) { hipLaunchKernelGGL(k_naive<PH>, dim3(1024), dim3(256), 0, s, a); }
template <int PH> static void launch_opt(const Args& a, hipStream_t s) {
    static bool attr = false;
    if (!attr) { (void)hipFuncSetAttribute((const void*)k_opt<PH>, hipFuncAttributeMaxDynamicSharedMemorySize, OPT_LDS); attr = true; }
    hipLaunchKernelGGL(k_opt<PH>, dim3(256), dim3(OPT_THREADS), OPT_LDS, s, a);
}

#define XB_TMO      128
#define XB_XCNT(j)  (256  + 64 * (j))
#define XB_XSUB(j)  (1280 + 64 * (j))
#define XB_XGEN(j)  (2304 + 64 * (j))
#define XB_TOP      3328
#define XB_TOPGEN   3392
#define XCD_BAR_WORDS 3456
#define XB_SPIN_CAP (1u << 18)

__device__ __forceinline__ unsigned xb_ld(unsigned* p)              { return __hip_atomic_load(p, __ATOMIC_RELAXED, __HIP_MEMORY_SCOPE_AGENT); }
__device__ __forceinline__ unsigned xb_add(unsigned* p, unsigned v) { return __hip_atomic_fetch_add(p, v, __ATOMIC_RELAXED, __HIP_MEMORY_SCOPE_AGENT); }
__device__ __forceinline__ unsigned xb_xcc_id() { return (unsigned)__builtin_amdgcn_s_getreg((3 << 11) | 20) & 0xFu; }
#define XB_SPIN(cond, bar) do { unsigned _sp = 0; while (cond) { __builtin_amdgcn_s_sleep(1); \
    if ((++_sp & 255u) == 0u) { if (xb_ld(&(bar)[XB_TMO])) break; if (_sp > XB_SPIN_CAP) { atomicAdd(&(bar)[XB_TMO], 1u); break; } } } } while (0)

struct XcdBarrier {
    unsigned* bar; unsigned x;
    volatile LAS unsigned* st;
};

__device__ __forceinline__ XcdBarrier xcd_barrier_post(unsigned* bar, volatile LAS unsigned* st) {
    XcdBarrier b; b.bar = bar; b.x = xb_xcc_id(); b.st = st;
    if (threadIdx.x == 0) (void)xb_add(&bar[XB_XCNT(b.x)], 1u);
    return b;
}
__device__ __forceinline__ void xcd_barrier_complete(unsigned* bar, unsigned x, unsigned& nloc, unsigned& nx) {
    const unsigned G = gridDim.x * gridDim.y * gridDim.z;
    unsigned sum, cnt, mine, sp = 0u;
    for (;;) {
        sum = 0u; cnt = 0u; mine = 0u;
#pragma unroll
        for (unsigned j = 0; j < 16; ++j) { const unsigned c = xb_ld(&bar[XB_XCNT(j)]); sum += c; cnt += (c > 0u) ? 1u : 0u; mine = (j == x) ? c : mine; }
        if (sum == G) break;
        __builtin_amdgcn_s_sleep(1);
        if ((++sp & 255u) == 0u) { if (xb_ld(&bar[XB_TMO])) break; if (sp > XB_SPIN_CAP) { atomicAdd(&bar[XB_TMO], 1u); break; } }
    }
    nloc = mine > 0u ? mine : 1u; nx = cnt > 0u ? cnt : 1u;
}

__device__ __forceinline__ void xcd_barrier(const XcdBarrier& b) {
    asm volatile("s_waitcnt vmcnt(0)" ::: "memory");
    __syncthreads();
    if (threadIdx.x == 0) {
        unsigned* bar = b.bar;
        __builtin_amdgcn_s_waitcnt(0);
        unsigned nloc = b.st[0], nx = b.st[1];
        if (nloc == 0u) { xcd_barrier_complete(bar, b.x, nloc, nx); b.st[0] = nloc; b.st[1] = nx; }
        const unsigned old = xb_add(&bar[XB_XSUB(b.x)], 1u);
        const unsigned gen = old / nloc;
        if (old + 1u == (gen + 1u) * nloc) {
            __builtin_amdgcn_fence(__ATOMIC_RELEASE, "agent");
            asm volatile("s_waitcnt vmcnt(0)" ::: "memory");
            const unsigned og = xb_add(&bar[XB_TOP], 1u);
            const unsigned tg = og / nx;
            if (og + 1u == (tg + 1u) * nx) xb_add(&bar[XB_TOPGEN], 1u);
            else XB_SPIN(xb_ld(&bar[XB_TOPGEN]) == tg, bar);
            __builtin_amdgcn_fence(__ATOMIC_ACQUIRE, "agent");
            xb_add(&bar[XB_XGEN(b.x)], 1u);
            asm volatile("s_waitcnt vmcnt(0)" ::: "memory");
        } else {
            XB_SPIN(xb_ld(&bar[XB_XGEN(b.x)]) == gen, bar);
            __builtin_amdgcn_fence(__ATOMIC_ACQUIRE, "agent");
            asm volatile("s_waitcnt vmcnt(0)" ::: "memory");
        }
    }
    __syncthreads();
}


#define GRID_SYNC() xcd_barrier(bar)
#ifndef PROBE_MASK
#define PROBE_MASK 0
#endif
#define RUN(ph) do { run_opt<ph>(a, lds); if ((PROBE_MASK >> ph) & 1) { GRID_SYNC(); run_opt<ph>(a, lds); } } while (0)
__global__ void __launch_bounds__(OPT_THREADS, 2) mega(Args a) {
    extern __shared__ __attribute__((aligned(16))) unsigned char lds_raw[];
    LAS unsigned char* lds = (LAS unsigned char*)lds_raw;
    volatile LAS unsigned* st = (volatile LAS unsigned*)(lds + OPT_LDS - 16);
    if (threadIdx.x < 4) st[threadIdx.x] = 0u;
    __syncthreads();
    const XcdBarrier bar = xcd_barrier_post((unsigned*)(a.ws + WS_CTL), st);
    RUN(0); GRID_SYNC();
    RUN(1); GRID_SYNC();
    RUN(2); GRID_SYNC();
    RUN(3); GRID_SYNC();
    RUN(4); GRID_SYNC();
    RUN(5); GRID_SYNC();
    RUN(6); GRID_SYNC();
#ifndef POOL_FUSED
#define POOL_FUSED 1
#endif
#if POOL_FUSED
    p78_pool_fused(a, lds); GRID_SYNC();
#else
    RUN(7); GRID_SYNC();
    RUN(8); GRID_SYNC();
#endif
    RUN(9); GRID_SYNC();
    RUN(10); GRID_SYNC();
    RUN(11);
}

extern "C" void kernel_launch(void* const* d_in, const int* in_sizes, int n_in, void* d_out, int out_size, void* d_ws, size_t ws_size, hipStream_t stream) {
    if (n_in != 16 || ws_size < WS_END) { fprintf(stderr, "kernel_launch: unexpected n_in %d / ws %zu\n", n_in, ws_size); return; }
    Args a{};
    a.x = (const float*)d_in[0]; a.meta = (const float*)d_in[1]; a.even_g = (const float*)d_in[2]; a.w_in = (const float*)d_in[3]; a.qg = (const float*)d_in[4]; a.kg = (const float*)d_in[5];
    a.conv_w = (const float*)d_in[6]; a.w_out = (const float*)d_in[7]; a.odd_g = (const float*)d_in[8]; a.pool_w = (const float*)d_in[9]; a.pool_scale = (const float*)d_in[10];
    a.ffn_g = (const float*)d_in[11]; a.w_query = (const float*)d_in[12]; a.sub_keys = (const float*)d_in[13]; a.peer_u = (const float*)d_in[14]; a.peer_v = (const float*)d_in[15];
    a.out = (float*)d_out; a.ws = (unsigned char*)d_ws; a.ph_lo = 0; a.ph_hi = NPHASE;
    static int grid = 0;
    if (grid == 0) {
        int dev = 0, cus = 0, per_cu = 0;
        (void)hipGetDevice(&dev);
        (void)hipDeviceGetAttribute(&cus, hipDeviceAttributeMultiprocessorCount, dev);
        (void)hipFuncSetAttribute((const void*)mega, hipFuncAttributeMaxDynamicSharedMemorySize, OPT_LDS);
        (void)hipOccupancyMaxActiveBlocksPerMultiprocessor(&per_cu, (const void*)mega, OPT_THREADS, OPT_LDS);
        if (per_cu < 1) { fprintf(stderr, "kernel_launch: occupancy query returned %d\n", per_cu); per_cu = 1; }
        grid = cus * 1;
        if (grid % 8 != 0) grid -= grid % 8;
    }
    (void)hipMemsetAsync((char*)d_ws + WS_CTL, 0, 16384, stream);
    void* args[] = {&a};
    hipError_t e = hipLaunchCooperativeKernel((const void*)mega, dim3(grid), dim3(OPT_THREADS), args, OPT_LDS, stream);
    if (e != hipSuccess) fprintf(stderr, "cooperative launch failed: %s (grid %d)\n", hipGetErrorString(e), grid);
}
```

```cpp
#include <hip/hip_runtime.h>
#include <hip/hip_cooperative_groups.h>
#include <stdint.h>
#include <stdio.h>
namespace cg = cooperative_groups;

typedef unsigned short bf16_t;
typedef unsigned u32x4 __attribute__((ext_vector_type(4)));
typedef float f32x4 __attribute__((ext_vector_type(4)));
typedef unsigned u32x3 __attribute__((ext_vector_type(3)));
typedef unsigned u32x2 __attribute__((ext_vector_type(2)));
typedef float f32x16 __attribute__((ext_vector_type(16)));
typedef unsigned u32x6 __attribute__((ext_vector_type(6)));
typedef float f32x32 __attribute__((ext_vector_type(32)));

constexpr int D = 1024, NB = 2, SEQ = 16384, NMETA = 16;
constexpr int XROWS = NB * SEQ;
constexpr int MROW0 = XROWS;
constexpr int NROWS = XROWS + NMETA;
constexpr int RP = 33024;
constexpr int NPOS = SEQ + NMETA;
constexpr int INC = 3072;
constexpr int P1W = 2560;
constexpr int NEXP = 16384;
constexpr float EPS = 1e-6f;
constexpr float LOG2E = 1.4426950408889634f;
constexpr float CARRY2_STOP = -150.5f;
#ifndef TAB_U4
#define TAB_U4 0
#endif
#ifndef TAB_V4
#define TAB_V4 1
#endif
#ifndef TAB_U8
#define TAB_U8 2
#endif
constexpr bool U4 = TAB_U4 != 0, V4 = TAB_V4 != 0;
constexpr bool U8 = TAB_U8 != 0;
#ifndef TAB_VMF
#define TAB_VMF 1
#endif
constexpr bool VMF = TAB_VMF != 0;
constexpr bool UI4 = TAB_U8 == 2;
constexpr int USTRIDE = UI4 ? 512 : U8 ? 1024 : U4 ? 512 : 768, VSTRIDE = V4 ? 512 : 768;
#ifndef TAB_CQ
#define TAB_CQ 1
#endif
constexpr bool CQ = TAB_CQ != 0;
static_assert(!CQ || !U4, "column-quarter u table is fp6 only");

constexpr size_t MiB = 1u << 20;
constexpr size_t WS_CTL = 0;
constexpr size_t WS_WIN = 1 * MiB;
constexpr size_t WS_WOUT = 7 * MiB;
constexpr size_t WS_WQ = 9 * MiB;
constexpr size_t WS_KEYS = 17 * MiB;
constexpr size_t WS_POOL = 18 * MiB;
constexpr size_t WS_RS0 = 19 * MiB;
constexpr size_t WS_SSQ1 = 20 * MiB;
constexpr size_t WS_RS2 = 23 * MiB;
constexpr size_t WS_SSQ3 = 24 * MiB;
constexpr size_t WS_UB = 32 * MiB;
constexpr size_t WS_VB = 96 * MiB;
constexpr size_t WS_XB = 160 * MiB;
constexpr size_t WS_H1 = 225 * MiB;
constexpr size_t WS_P1 = 290 * MiB;
constexpr size_t WS_IDX = 452 * MiB;
constexpr size_t WS_GATE = 469 * MiB;
constexpr size_t WS_END = 486 * MiB;

#define LAS __attribute__((address_space(3)))
#define MKRSRC(p, bytes) __builtin_amdgcn_make_buffer_rsrc((void*)(p), 0, (int)(bytes), 0x00020000)
__device__ __forceinline__ float bf2f(bf16_t v) { return __uint_as_float(((unsigned)v) << 16); }
__device__ __forceinline__ float bflo(unsigned w) { return __uint_as_float(w << 16); }
__device__ __forceinline__ float bfhi(unsigned w) { return __uint_as_float(w & 0xffff0000u); }
__device__ __forceinline__ bf16_t f2bf(float f) { unsigned u = __float_as_uint(f); return (bf16_t)((u + 0x7fffu + ((u >> 16) & 1u)) >> 16); }
__device__ __forceinline__ unsigned pk2(float lo, float hi) { unsigned r; asm("v_cvt_pk_bf16_f32 %0, %1, %2" : "=v"(r) : "v"(lo), "v"(hi)); return r; }
__device__ __forceinline__ float wave_sum(float v) {
#pragma unroll
    for (int o = 1; o < 64; o <<= 1) v += __shfl_xor(v, o);
    return v;
}
__device__ __forceinline__ int opaque_tid() { int t = (int)threadIdx.x; asm volatile("" : "+v"(t)); return t; }

__device__ __forceinline__ float dpp_xor1(float v) { return __builtin_bit_cast(float, __builtin_amdgcn_update_dpp(0, __builtin_bit_cast(int, v), 0xB1, 0xF, 0xF, true)); }
__device__ __forceinline__ float dpp_xor2(float v) { return __builtin_bit_cast(float, __builtin_amdgcn_update_dpp(0, __builtin_bit_cast(int, v), 0x4E, 0xF, 0xF, true)); }
__device__ __forceinline__ float dpp_xor8(float v) { return __builtin_bit_cast(float, __builtin_amdgcn_update_dpp(0, __builtin_bit_cast(int, v), 0x128, 0xF, 0xF, true)); }
__device__ __forceinline__ int prow(int b, int p) { return p < NMETA ? MROW0 + p : b * SEQ + (p - NMETA); }
__device__ __forceinline__ void rowpos(int row, int& b, int& p) { if (row >= MROW0) { b = 0; p = row - MROW0; } else { b = row >> 14; p = (row & (SEQ - 1)) + NMETA; } }
__host__ __device__ __forceinline__ int win_btrow(int u64, int d) { return 256 * (u64 >> 2) + 128 * (d >> 5) + 32 * (u64 & 3) + (d & 31); }
__host__ __device__ __forceinline__ int win_srccol(int u64, int d) {
    if (u64 < 24) return 64 * u64 + d;
    if (u64 < 32) return 1536 + 64 * (u64 - 24) + d;
    const int c32 = u64 - 32;
    return d < 32 ? 2048 + 32 * c32 + d : 2560 + 32 * c32 + (d - 32);
}
__device__ __forceinline__ float gelu_tanh(float x) {
    const float y = 0.7978845608028654f * (x + 0.044715f * x * x * x);
    const float e = __expf(2.f * y);
    const float t = 1.f - 2.f / (1.f + e);
    return 0.5f * x * (1.f + t);
}

struct Args {
    const float* x; const float* meta; const float* even_g; const float* w_in; const float* qg; const float* kg; const float* conv_w; const float* w_out;
    const float* odd_g; const float* pool_w; const float* pool_scale; const float* ffn_g; const float* w_query; const float* sub_keys; const float* peer_u; const float* peer_v;
    float* out; unsigned char* ws; int ph_lo, ph_hi;
};

__device__ __forceinline__ void p0_prep(const Args& a, long gtid, long gsz) {
    unsigned char* ws = a.ws;
    bf16_t* WinT = (bf16_t*)(ws + WS_WIN); bf16_t* WoutT = (bf16_t*)(ws + WS_WOUT); bf16_t* WqT = (bf16_t*)(ws + WS_WQ);
    bf16_t* KeysB = (bf16_t*)(ws + WS_KEYS); bf16_t* PoolT = (bf16_t*)(ws + WS_POOL);
    bf16_t* UB = (bf16_t*)(ws + WS_UB); bf16_t* VB = (bf16_t*)(ws + WS_VB); bf16_t* XB = (bf16_t*)(ws + WS_XB); float* RS0 = (float*)(ws + WS_RS0);
    for (long i = gtid; i < (long)INC * D; i += gsz) {
        const int k = (int)(i % D), l = (int)(i / D), u64 = l >> 6, d = l & 63;
        WinT[(size_t)win_btrow(u64, d) * D + k] = f2bf(a.w_in[(size_t)k * INC + win_srccol(u64, d)] * a.even_g[k]);
    }
    for (long i = gtid; i < (long)D * D; i += gsz) { const int k = (int)(i % D), n = (int)(i / D); WoutT[(size_t)n * D + k] = f2bf(a.w_out[(size_t)k * D + n]); }
    for (long i = gtid; i < 2L * 2048 * D; i += gsz) {
        const int k = (int)(i % D); const long r = i / D; const int n = (int)(r % 2048), l = (int)(r / 2048);
        WqT[((size_t)l * 2048 + n) * D + k] = f2bf(a.w_query[((size_t)l * D + k) * 2048 + n] * a.ffn_g[l * D + k]);
    }
    for (long i = gtid; i < 2L * 2 * 8 * 128 * 128; i += gsz) KeysB[i] = f2bf(a.sub_keys[i]);
    for (long i = gtid; i < 1024L * 256; i += gsz) {
        const int c = (int)(i % 256), n = (int)(i / 256), g = n >> 8, e = n & 255;
        PoolT[(size_t)n * 256 + c] = f2bf(a.pool_w[((size_t)g * 256 + c) * 256 + e] * a.odd_g[g * 256 + c] * a.pool_scale[n]);
    }
    for (long i = gtid; i < 2L * NEXP * D / 4; i += gsz) {
        const long e4 = i * 4; const int l = (int)(e4 / ((long)NEXP * D)), dcol = (int)(e4 % D);
        const f32x4 u = *(const f32x4*)(a.peer_u + e4), v = *(const f32x4*)(a.peer_v + e4), g = *(const f32x4*)(a.ffn_g + l * D + dcol);
        *(uint2*)(UB + e4) = make_uint2(pk2(u[0] * g[0], u[1] * g[1]), pk2(u[2] * g[2], u[3] * g[3]));
        *(uint2*)(VB + e4) = make_uint2(pk2(v[0], v[1]), pk2(v[2], v[3]));
    }
    const long gw = gtid >> 6, nw = gsz >> 6; const int lane = (int)(gtid & 63);
    for (long row = gw; row < RP; row += nw) {
        bf16_t* o = XB + (size_t)row * D;
        if (row >= NROWS) { for (int j = 0; j < 4; ++j) *(uint2*)(o + 256 * j + 4 * lane) = make_uint2(0u, 0u); if (lane == 0) RS0[row] = 1.f; continue; }
        const float* src = row < XROWS ? a.x + (size_t)row * D : a.meta + (size_t)(row - MROW0) * D;
        float ss = 0.f;
        for (int j = 0; j < 4; ++j) { const f32x4 v = *(const f32x4*)(src + 256 * j + 4 * lane); ss += v[0] * v[0] + v[1] * v[1] + v[2] * v[2] + v[3] * v[3];
            *(uint2*)(o + 256 * j + 4 * lane) = make_uint2(pk2(v[0], v[1]), pk2(v[2], v[3])); }
        ss = wave_sum(ss);
        if (lane == 0) RS0[row] = rsqrtf(ss * (1.f / D) + EPS);
    }
}

template <class BRow, class AOff, class Epi>
__device__ __forceinline__ void naive_gemm(const bf16_t* A, int lda, const bf16_t* Bt, int K, int nrows, int nunits, BRow brow, AOff aoff, Epi epi, long gtid, long gsz) {
    const int rblks = (nrows + 63) / 64;
    const long nwaves = (long)rblks * nunits;
    const int lane = (int)(gtid & 63);
    for (long w = gtid >> 6; w < nwaves; w += gsz >> 6) {
        const int unit = __builtin_amdgcn_readfirstlane((int)(w / rblks));
        const int row = (int)(w % rblks) * 64 + lane;
        const int rr = row < nrows ? row : nrows - 1;
        const bf16_t* arow = A + (size_t)rr * lda + aoff(unit);
        float acc[64];
#pragma unroll
        for (int c = 0; c < 64; ++c) acc[c] = 0.f;
        for (int k = 0; k < K; k += 8) {
            const u32x4 av = *(const u32x4*)(arow + k);
            const float a0 = bflo(av[0]), a1 = bfhi(av[0]), a2 = bflo(av[1]), a3 = bfhi(av[1]), a4 = bflo(av[2]), a5 = bfhi(av[2]), a6 = bflo(av[3]), a7 = bfhi(av[3]);
#pragma unroll
            for (int c = 0; c < 64; ++c) {
                const u32x4 bv = *(const u32x4*)(Bt + (size_t)brow(unit, c) * K + k);
                acc[c] += a0 * bflo(bv[0]) + a1 * bfhi(bv[0]) + a2 * bflo(bv[1]) + a3 * bfhi(bv[1]) + a4 * bflo(bv[2]) + a5 * bfhi(bv[2]) + a6 * bflo(bv[3]) + a7 * bfhi(bv[3]);
            }
        }
        if (row < nrows) epi(row, unit, acc);
    }
}

__device__ __forceinline__ void p1_gemm_in(const Args& a, long gtid, long gsz) {
    unsigned char* ws = a.ws;
    const bf16_t* XB = (const bf16_t*)(ws + WS_XB); const bf16_t* WinT = (const bf16_t*)(ws + WS_WIN); const float* RS0 = (const float*)(ws + WS_RS0);
    bf16_t* P1 = (bf16_t*)(ws + WS_P1);
    const float* qg = a.qg; const float* kg = a.kg;
    naive_gemm(XB, D, WinT, D, NROWS, 48,
        [](int u, int c) { return win_btrow(u, c); }, [](int) { return 0; },
        [=](int row, int u, float (&acc)[64]) {
            const float s = RS0[row];
            bf16_t* o = P1 + (size_t)row * P1W;
            if (u < 16) {
                float ss = 0.f;
#pragma unroll
                for (int c = 0; c < 64; ++c) { acc[c] *= s; ss += acc[c] * acc[c]; }
                const float r = rsqrtf(ss * (1.f / 64.f) + EPS) * (u < 8 ? 0.125f * LOG2E : 1.f);
                const float* g = u < 8 ? qg : kg;
#pragma unroll
                for (int c = 0; c < 64; ++c) o[u * 64 + c] = f2bf(acc[c] * r * g[c]);
            } else if (u < 32) {
#pragma unroll
                for (int c = 0; c < 64; ++c) o[u * 64 + c] = f2bf(acc[c] * s);
            } else {
                const int c32 = u - 32;
#pragma unroll
                for (int c = 0; c < 32; ++c) o[2048 + 32 * c32 + c] = f2bf((acc[c] * s) * (acc[32 + c] * s));
            }
        }, gtid, gsz);
}

__device__ __forceinline__ void p2_attn_conv(const Args& a, bf16_t* MIX, long gtid, long gsz) {
    const bf16_t* P1 = (const bf16_t*)(a.ws + WS_P1);
    for (long it = gtid; it < (long)NROWS * 8; it += gsz) {
        const int row = (int)(it % NROWS), h = (int)(it / NROWS);
        int b, p; rowpos(row, b, p);
        float q[64], o[64];
        const bf16_t* qp = P1 + (size_t)row * P1W + h * 64;
#pragma unroll
        for (int c = 0; c < 64; ++c) { q[c] = bf2f(qp[c]); o[c] = 0.f; }
        float carry = 0.f;
        for (int s = p - 1; s >= 0; --s) {
            const bf16_t* kp = P1 + (size_t)prow(b, s) * P1W + 512 + h * 64;
            float z = 0.f;
#pragma unroll
            for (int c = 0; c < 64; ++c) z += q[c] * bf2f(kp[c]);
            const float L = z > 0.f ? z + log2f(1.f + exp2f(-z)) : log2f(1.f + exp2f(z));
            const float w = exp2f(z - L + carry);
            const bf16_t* vp = kp + 512;
#pragma unroll
            for (int c = 0; c < 64; ++c) o[c] += w * bf2f(vp[c]);
            carry -= L;
            if (carry < CARRY2_STOP) break;
        }
        bf16_t* op = MIX + (size_t)row * D + h * 64;
#pragma unroll
        for (int c = 0; c < 64; ++c) op[c] = f2bf(o[c]);
    }
    for (long it = gtid; it < (long)NROWS * 512; it += gsz) {
        const int c = (int)(it & 511), row = (int)(it >> 9);
        int b, p; rowpos(row, b, p);
        float y = a.conv_w[2 * 512 + c] * bf2f(P1[(size_t)row * P1W + 2048 + c]);
        if (p >= 1) y += a.conv_w[1 * 512 + c] * bf2f(P1[(size_t)prow(b, p - 1) * P1W + 2048 + c]);
        if (p >= 2) y += a.conv_w[0 * 512 + c] * bf2f(P1[(size_t)prow(b, p - 2) * P1W + 2048 + c]);
        MIX[(size_t)row * D + 512 + c] = f2bf(y * bf2f(P1[(size_t)row * P1W + 1536 + c]));
    }
}

__device__ __forceinline__ void p3_gemm_out(const Args& a, const bf16_t* MIX, long gtid, long gsz) {
    const bf16_t* WoutT = (const bf16_t*)(a.ws + WS_WOUT); bf16_t* H1 = (bf16_t*)(a.ws + WS_H1); float* SSQ1 = (float*)(a.ws + WS_SSQ1);
    const float* x = a.x; const float* meta = a.meta;
    naive_gemm(MIX, D, WoutT, D, NROWS, 16,
        [](int u, int c) { return u * 64 + c; }, [](int) { return 0; },
        [=](int row, int u, float (&acc)[64]) {
            const float* h0 = (row < XROWS ? x + (size_t)row * D : meta + (size_t)(row - MROW0) * D) + u * 64;
            float ss = 0.f;
#pragma unroll
            for (int c = 0; c < 64; ++c) { const bf16_t hb = f2bf(h0[c] + acc[c]); const float hv = bf2f(hb); ss += hv * hv; H1[(size_t)row * D + u * 64 + c] = hb; }
            SSQ1[(size_t)row * 16 + u] = ss;
        }, gtid, gsz);
}

__device__ __forceinline__ void p4_gemm_q(const Args& a, int layer, const bf16_t* H, int nrows, long gtid, long gsz) {
    const bf16_t* WqT = (const bf16_t*)(a.ws + WS_WQ) + (size_t)layer * 2048 * D; bf16_t* QP = (bf16_t*)(a.ws + WS_P1);
    naive_gemm(H, D, WqT, D, nrows, 32,
        [](int u, int c) { return u * 64 + c; }, [](int) { return 0; },
        [=](int row, int u, float (&acc)[64]) {
#pragma unroll
            for (int c = 0; c < 64; ++c) QP[(size_t)row * 2048 + u * 64 + c] = f2bf(acc[c]);
        }, gtid, gsz);
}

__device__ __forceinline__ void ins16(float (&tv)[16], int (&ti)[16], float v, int i) {
#pragma unroll
    for (int j = 0; j < 16; ++j) { const bool sw = v > tv[j]; const float ov = tv[j]; const int oi = ti[j]; tv[j] = sw ? v : ov; ti[j] = sw ? i : oi; v = sw ? ov : v; i = sw ? oi : i; }
}
__device__ __forceinline__ void p5_topk(const Args& a, int layer, const float* SSQ, int nrows, long gtid, long gsz) {
    const bf16_t* QP = (const bf16_t*)(a.ws + WS_P1); const bf16_t* KeysB = (const bf16_t*)(a.ws + WS_KEYS) + (size_t)layer * 2 * 8 * 128 * 128;
    int* IDX = (int*)(a.ws + WS_IDX); float* GATE = (float*)(a.ws + WS_GATE);
    for (long it = gtid; it < (long)nrows * 8; it += gsz) {
        const int row = (int)(it % nrows), h = (int)(it / nrows);
        float sv[2][16]; int si[2][16];
#pragma unroll
        for (int p = 0; p < 2; ++p) {
#pragma unroll
            for (int j = 0; j < 16; ++j) { sv[p][j] = -INFINITY; si[p][j] = 0; }
            const bf16_t* qp = QP + (size_t)row * 2048 + h * 256 + p * 128;
            const bf16_t* kb = KeysB + ((size_t)(p * 8 + h) * 128) * 128;
            for (int k = 0; k < 128; ++k) {
                float s = 0.f;
                for (int c = 0; c < 128; c += 8) {
                    const u32x4 qv = *(const u32x4*)(qp + c), kv = *(const u32x4*)(kb + (size_t)k * 128 + c);
                    s += bflo(qv[0]) * bflo(kv[0]) + bfhi(qv[0]) * bfhi(kv[0]) + bflo(qv[1]) * bflo(kv[1]) + bfhi(qv[1]) * bfhi(kv[1])
                       + bflo(qv[2]) * bflo(kv[2]) + bfhi(qv[2]) * bfhi(kv[2]) + bflo(qv[3]) * bflo(kv[3]) + bfhi(qv[3]) * bfhi(kv[3]);
                }
                ins16(sv[p], si[p], s, k);
            }
        }
        float tv[16]; int ti[16];
#pragma unroll
        for (int j = 0; j < 16; ++j) { tv[j] = -INFINITY; ti[j] = 0; }
#pragma unroll
        for (int i = 0; i < 16; ++i)
#pragma unroll
            for (int j = 0; j < 16; ++j) ins16(tv, ti, sv[0][i] + sv[1][j], si[0][i] * 128 + si[1][j]);
        float ssq = 0.f;
        for (int j = 0; j < 16; ++j) ssq += SSQ[(size_t)row * 16 + j];
        const float rstd = rsqrtf(ssq * (1.f / D) + EPS);
        float e[16], sum = 0.f;
#pragma unroll
        for (int j = 0; j < 16; ++j) { e[j] = __expf((tv[j] - tv[0]) * rstd); sum += e[j]; }
        const float inv = 1.f / sum;
#pragma unroll
        for (int j = 0; j < 16; ++j) { IDX[(size_t)row * 128 + h * 16 + j] = ti[j]; GATE[(size_t)row * 128 + h * 16 + j] = e[j] * inv; }
    }
}

template <bool FINAL>
__device__ __forceinline__ void p6_peer(const Args& a, int layer, const bf16_t* H, const float* SSQ, bf16_t* Hout, float* RSout, int nrows, long gtid, long gsz) {
    const bf16_t* UB = (const bf16_t*)(a.ws + WS_UB) + (size_t)layer * NEXP * D; const bf16_t* VB = (const bf16_t*)(a.ws + WS_VB) + (size_t)layer * NEXP * D;
    const int* IDX = (const int*)(a.ws + WS_IDX); const float* GATE = (const float*)(a.ws + WS_GATE);
    const int lane = (int)(gtid & 63);
    for (long row = gtid >> 6; row < nrows; row += gsz >> 6) {
        const bf16_t* hp = H + (size_t)row * D;
        const u32x4 h0 = *(const u32x4*)(hp + lane * 8), h1 = *(const u32x4*)(hp + 512 + lane * 8);
        float hv[16];
#pragma unroll
        for (int j = 0; j < 4; ++j) { hv[2 * j] = bflo(h0[j]); hv[2 * j + 1] = bfhi(h0[j]); hv[8 + 2 * j] = bflo(h1[j]); hv[9 + 2 * j] = bfhi(h1[j]); }
        float ssq = 0.f;
        for (int j = 0; j < 16; ++j) ssq += SSQ[(size_t)row * 16 + j];
        const float rstd = rsqrtf(ssq * (1.f / D) + EPS);
        float y[16];
#pragma unroll
        for (int j = 0; j < 16; ++j) y[j] = 0.f;
        for (int n = 0; n < 128; ++n) {
            const int e = IDX[(size_t)row * 128 + n]; const float g = GATE[(size_t)row * 128 + n];
            const bf16_t* up = UB + (size_t)e * D; const bf16_t* vp = VB + (size_t)e * D;
            const u32x4 u0 = *(const u32x4*)(up + lane * 8), u1 = *(const u32x4*)(up + 512 + lane * 8);
            float dsum = 0.f;
#pragma unroll
            for (int j = 0; j < 4; ++j) dsum += hv[2 * j] * bflo(u0[j]) + hv[2 * j + 1] * bfhi(u0[j]) + hv[8 + 2 * j] * bflo(u1[j]) + hv[9 + 2 * j] * bfhi(u1[j]);
            dsum = wave_sum(dsum);
            const float c = g * gelu_tanh(dsum * rstd);
            const u32x4 v0 = *(const u32x4*)(vp + lane * 8), v1 = *(const u32x4*)(vp + 512 + lane * 8);
#pragma unroll
            for (int j = 0; j < 4; ++j) { y[2 * j] += c * bflo(v0[j]); y[2 * j + 1] += c * bfhi(v0[j]); y[8 + 2 * j] += c * bflo(v1[j]); y[9 + 2 * j] += c * bfhi(v1[j]); }
        }
#pragma unroll
        for (int j = 0; j < 16; ++j) y[j] += hv[j];
        if (FINAL) {
            float* o = a.out + (size_t)row * D;
            *(f32x4*)(o + lane * 8) = (f32x4){y[0], y[1], y[2], y[3]}; *(f32x4*)(o + lane * 8 + 4) = (f32x4){y[4], y[5], y[6], y[7]};
            *(f32x4*)(o + 512 + lane * 8) = (f32x4){y[8], y[9], y[10], y[11]}; *(f32x4*)(o + 512 + lane * 8 + 4) = (f32x4){y[12], y[13], y[14], y[15]};
        } else {
            u32x4 w0, w1; float ss = 0.f;
#pragma unroll
            for (int j = 0; j < 4; ++j) { w0[j] = pk2(y[2 * j], y[2 * j + 1]); w1[j] = pk2(y[8 + 2 * j], y[9 + 2 * j]); }
#pragma unroll
            for (int j = 0; j < 4; ++j) { const float a0 = bflo(w0[j]), a1 = bfhi(w0[j]), b0 = bflo(w1[j]), b1 = bfhi(w1[j]); ss += a0 * a0 + a1 * a1 + b0 * b0 + b1 * b1; }
            ss = wave_sum(ss);
            *(u32x4*)(Hout + (size_t)row * D + lane * 8) = w0; *(u32x4*)(Hout + (size_t)row * D + 512 + lane * 8) = w1;
            if (lane == 0) RSout[row] = rsqrtf(ss * (1.f / D) + EPS);
        }
    }
}

__device__ __forceinline__ void p7_poold(const Args& a, bf16_t* Dm, long gtid, long gsz) {
    const bf16_t* H2 = (const bf16_t*)(a.ws + WS_XB); const float* RS2 = (const float*)(a.ws + WS_RS2);
    for (long it = gtid; it < (long)XROWS * D; it += gsz) {
        const int c = (int)(it & (D - 1)), row = (int)(it >> 10);
        int b, p; rowpos(row, b, p);
        const int w = 2 << (c >> 8);
        const int lo = p - w + 1 > 0 ? p - w + 1 : 0;
        float s = 0.f, self = 0.f;
        for (int j = lo; j <= p; ++j) { const int r = prow(b, j); const float v = bf2f(H2[(size_t)r * D + c]) * RS2[r]; s += v; self = v; }
        Dm[(size_t)row * D + c] = f2bf(s / (float)(p - lo + 1) - self);
    }
}

__device__ __forceinline__ void p8_gemm_pool(const Args& a, const bf16_t* Dm, long gtid, long gsz) {
    const bf16_t* PoolT = (const bf16_t*)(a.ws + WS_POOL); const bf16_t* H2 = (const bf16_t*)(a.ws + WS_XB); bf16_t* H3 = (bf16_t*)(a.ws + WS_H1); float* SSQ3 = (float*)(a.ws + WS_SSQ3);
    naive_gemm(Dm, D, PoolT, 256, XROWS, 16,
        [](int u, int c) { return u * 64 + c; }, [](int u) { return (u >> 2) * 256; },
        [=](int row, int u, float (&acc)[64]) {
            float ss = 0.f;
#pragma unroll
            for (int c = 0; c < 64; ++c) { const bf16_t hb = f2bf(bf2f(H2[(size_t)row * D + u * 64 + c]) + acc[c]); const float hv = bf2f(hb); ss += hv * hv; H3[(size_t)row * D + u * 64 + c] = hb; }
            SSQ3[(size_t)row * 16 + u] = ss;
        }, gtid, gsz);
}


namespace pg8 {
#define PG8_LAS __attribute__((address_space(3)))
typedef unsigned short bf16_t;
typedef short bf16x8 __attribute__((ext_vector_type(8)));
typedef float f32x4 __attribute__((ext_vector_type(4)));
typedef unsigned u32x4 __attribute__((ext_vector_type(4)));
constexpr int BM = 256, BK = 64, HALF = 128, HTB = HALF * BK * 2  , STAGE_BYTES = 8 * HTB, NXCD = 8, WGM = 8;

__host__ __device__ __forceinline__ int lds_byte(int r, int c) { const int st = (r >> 4) * 2 + (c >> 5), rr = r & 15, cc = c & 31, ob = rr * 64 + cc * 2; return st * 1024 + (ob ^ (((ob >> 9) & 1) << 5)); }
__host__ __device__ __forceinline__ void stage_rc(int b, int& R, int& C) { const int st = b / 1024, sb = b % 1024, swz = sb ^ (((sb >> 9) & 1) << 5); R = (st >> 1) * 16 + swz / 64; C = (st & 1) * 32 + (swz % 64) / 2; }
__host__ __device__ __forceinline__ int perm32(int rho) { const int n = rho >> 4, i = rho & 15; return 8 * (i >> 2) + 4 * n + (i & 3); }

struct Unit { int pm, pn; };
struct Gemm { const bf16_t* A; const bf16_t* Bt; int lda, ldb, K, a_pn_off; };

struct StaticOrder {
    int nM, nN, nwg, G, c;
    __host__ __device__ void init(int M, int N, int G_, int c_) { nM = M / BM; nN = N / BM; nwg = nM * nN; G = G_; c = c_; }
    __host__ __device__ bool next(int i, Unit& u) const {
        const long L = (long)i * G + c; if (L >= nwg) return false;
        int wgid = (int)L; { const int q = nwg / NXCD, r = nwg % NXCD, xcd = wgid % NXCD, off = wgid / NXCD; wgid = (xcd < r ? xcd * (q + 1) : r * (q + 1) + (xcd - r) * q) + off; }
        const int nig = WGM * nN, gid = wgid / nig, fm = gid * WGM, gsz = (nM - fm) < WGM ? (nM - fm) : WGM;
        u.pm = fm + ((wgid % nig) % gsz); u.pn = (wgid % nig) / gsz; return true;
    }
    __device__ __forceinline__ void a_ready(const Unit&) const {}
    __device__ __forceinline__ void done(const Unit&) const {}
};


__device__ __forceinline__ unsigned cvt_pk_bf16(float lo, float hi) { unsigned r; asm volatile("v_cvt_pk_bf16_f32 %0, %1, %2" : "=v"(r) : "v"(lo), "v"(hi)); return r; }

struct EpiPlain {
    static constexpr bool PERM = true, AFTER_DRAIN = false;
    bf16_t* O; int ldc;
    __device__ __forceinline__ void operator()(const f32x4 (&acc)[2][2][4][2], const Unit& u, int wr, int wc, int fr, int fq) const {
        const int row0 = u.pm * BM + wr * 64 + fr, col0 = u.pn * BM + wc * 32 + 8 * fq;
#pragma unroll
        for (int ai = 0; ai < 2; ++ai)
#pragma unroll
            for (int m = 0; m < 4; ++m) { bf16_t* rowp = O + (size_t)(row0 + ai * HALF + m * 16) * ldc + col0;
#pragma unroll
                for (int bj = 0; bj < 2; ++bj) { const f32x4 v0 = acc[ai][bj][m][0], v1 = acc[ai][bj][m][1];
                    u32x4 w; w.x = cvt_pk_bf16(v0[0], v0[1]); w.y = cvt_pk_bf16(v0[2], v0[3]); w.z = cvt_pk_bf16(v1[0], v1[1]); w.w = cvt_pk_bf16(v1[2], v1[3]);
                    *(u32x4*)(rowp + bj * HALF) = w; } }
    }
};
struct EpiIn {
    static constexpr bool PERM = true, AFTER_DRAIN = false;
    bf16_t* P1; const float* RS0; const float* qg; const float* kg;
    __device__ __forceinline__ void operator()(const f32x4 (&acc)[2][2][4][2], const Unit& u, int wr, int wc, int fr, int fq) const {
        const int u64 = 4 * u.pn + wc;
        const int row0 = u.pm * BM + wr * 64 + fr;
        float rs_[2][4];
#pragma unroll
        for (int ai = 0; ai < 2; ++ai)
#pragma unroll
            for (int m = 0; m < 4; ++m) rs_[ai][m] = RS0[row0 + ai * HALF + m * 16];
        if (u64 < 16) {
            const float* g = u64 < 8 ? qg : kg; const float sc = u64 < 8 ? 0.125f * LOG2E : 1.f;
            f32x4 gv[2][2];
#pragma unroll
            for (int bj = 0; bj < 2; ++bj)
#pragma unroll
                for (int n = 0; n < 2; ++n) gv[bj][n] = *(const f32x4*)(g + 32 * bj + 8 * fq + 4 * n);
#pragma unroll
            for (int ai = 0; ai < 2; ++ai)
#pragma unroll
                for (int m = 0; m < 4; ++m) { const int row = row0 + ai * HALF + m * 16; const float s = rs_[ai][m];
                    f32x4 v[2][2]; float ss = 0.f;
#pragma unroll
                    for (int bj = 0; bj < 2; ++bj)
#pragma unroll
                        for (int n = 0; n < 2; ++n) { v[bj][n] = acc[ai][bj][m][n] * s; ss += (v[bj][n][0] * v[bj][n][0] + v[bj][n][1] * v[bj][n][1]) + (v[bj][n][2] * v[bj][n][2] + v[bj][n][3] * v[bj][n][3]); }
                    ss += __shfl_xor(ss, 16); ss += __shfl_xor(ss, 32);
                    const float r = rsqrtf(ss * (1.f / 64.f) + EPS) * sc;
                    bf16_t* rowp = P1 + (size_t)row * P1W + u64 * 64 + 8 * fq;
#pragma unroll
                    for (int bj = 0; bj < 2; ++bj) { const f32x4 a0 = v[bj][0] * gv[bj][0] * r, a1 = v[bj][1] * gv[bj][1] * r;
                        u32x4 w; w.x = cvt_pk_bf16(a0[0], a0[1]); w.y = cvt_pk_bf16(a0[2], a0[3]); w.z = cvt_pk_bf16(a1[0], a1[1]); w.w = cvt_pk_bf16(a1[2], a1[3]);
                        *(u32x4*)(rowp + 32 * bj) = w; } }
        } else if (u64 < 32) {
#pragma unroll
            for (int ai = 0; ai < 2; ++ai)
#pragma unroll
                for (int m = 0; m < 4; ++m) { const int row = row0 + ai * HALF + m * 16; const float s = rs_[ai][m];
                    bf16_t* rowp = P1 + (size_t)row * P1W + u64 * 64 + 8 * fq;
#pragma unroll
                    for (int bj = 0; bj < 2; ++bj) { const f32x4 a0 = acc[ai][bj][m][0] * s, a1 = acc[ai][bj][m][1] * s;
                        u32x4 w; w.x = cvt_pk_bf16(a0[0], a0[1]); w.y = cvt_pk_bf16(a0[2], a0[3]); w.z = cvt_pk_bf16(a1[0], a1[1]); w.w = cvt_pk_bf16(a1[2], a1[3]);
                        *(u32x4*)(rowp + 32 * bj) = w; } }
        } else {
            const int c32 = u64 - 32;
#pragma unroll
            for (int ai = 0; ai < 2; ++ai)
#pragma unroll
                for (int m = 0; m < 4; ++m) { const int row = row0 + ai * HALF + m * 16; const float s = rs_[ai][m], s2 = s * s;
                    const f32x4 a0 = acc[ai][0][m][0] * acc[ai][1][m][0] * s2, a1 = acc[ai][0][m][1] * acc[ai][1][m][1] * s2;
                    u32x4 w; w.x = cvt_pk_bf16(a0[0], a0[1]); w.y = cvt_pk_bf16(a0[2], a0[3]); w.z = cvt_pk_bf16(a1[0], a1[1]); w.w = cvt_pk_bf16(a1[2], a1[3]);
                    *(u32x4*)(P1 + (size_t)row * P1W + 2048 + 32 * c32 + 8 * fq) = w; }
        }
    }
};
template <int MODE> struct EpiRes {
    static constexpr bool PERM = true, AFTER_DRAIN = false;
    const float* x; const float* meta; const bf16_t* Hb; bf16_t* Hout; float* SSQ;
    __device__ __forceinline__ void operator()(const f32x4 (&acc)[2][2][4][2], const Unit& u, int wr, int wc, int fr, int fq) const {
        const int row0 = u.pm * BM + wr * 64 + fr, col0 = u.pn * BM + wc * 32 + 8 * fq;
        constexpr int DEP = MODE == 0 ? 4 : 8;
        f32x4 bf[8][2][2]; u32x4 bh[8][2];
#define ER_ISSUE(g) do { const int row_ = row0 + ((g) >> 2) * HALF + ((g) & 3) * 16; _Pragma("unroll") for (int bj = 0; bj < 2; ++bj) { const int col_ = col0 + bj * HALF; \
            if (MODE == 0) { const float* bp = row_ < XROWS ? x + (size_t)row_ * D + col_ : meta + (size_t)(row_ < NROWS ? row_ - MROW0 : 0) * D + col_; bf[g][bj][0] = *(const f32x4*)bp; bf[g][bj][1] = *(const f32x4*)(bp + 4); } \
            else bh[g][bj] = *(const u32x4*)(Hb + (size_t)row_ * D + col_); } } while (0)
#pragma unroll
        for (int g = 0; g < DEP; ++g) ER_ISSUE(g);
#pragma unroll
        for (int g = 0; g < 8; ++g) { const int ai = g >> 2, m = g & 3, row = row0 + ai * HALF + m * 16; float ss = 0.f;
            asm volatile("" ::: "memory");
#pragma unroll
            for (int bj = 0; bj < 2; ++bj) { const int col = col0 + bj * HALF; f32x4 b0, b1;
                if (MODE == 0) { b0 = bf[g][bj][0]; b1 = bf[g][bj][1]; }
                else { const u32x4 hb = bh[g][bj]; b0 = (f32x4){bflo(hb[0]), bfhi(hb[0]), bflo(hb[1]), bfhi(hb[1])}; b1 = (f32x4){bflo(hb[2]), bfhi(hb[2]), bflo(hb[3]), bfhi(hb[3])}; }
                const f32x4 v0 = acc[ai][bj][m][0] + b0, v1 = acc[ai][bj][m][1] + b1;
                u32x4 w; w.x = cvt_pk_bf16(v0[0], v0[1]); w.y = cvt_pk_bf16(v0[2], v0[3]); w.z = cvt_pk_bf16(v1[0], v1[1]); w.w = cvt_pk_bf16(v1[2], v1[3]);
#pragma unroll
                for (int j = 0; j < 4; ++j) { const float lo = bflo(w[j]), hi = bfhi(w[j]); ss += lo * lo + hi * hi; }
                *(u32x4*)(Hout + (size_t)row * D + col) = w; }
            ss += __shfl_xor(ss, 16); ss += __shfl_xor(ss, 32);
            if (fq == 0) SSQ[(size_t)row * 16 + 4 * u.pn + wc] = ss;
            if (g + DEP < 8) ER_ISSUE((g + DEP) & 7);
        }
#undef ER_ISSUE
    }
};
template <class Epi, class Sched, bool ALIGN_EPI = false, bool SP2 = false>
__device__ __forceinline__ void gemm_phase(PG8_LAS unsigned char* lds, const Gemm g, const Sched& S, const Epi& E) {
    const int tid = opaque_tid(), wid = __builtin_amdgcn_readfirstlane(tid >> 6), lane = tid & 63, wr = wid >> 2, wc = wid & 3, fr = lane & 15, fq = lane >> 4;
    const int K = g.K, nt = K / BK;
    unsigned voffA[2], voffB[2];
#pragma unroll
    for (int i = 0; i < 2; ++i) { int R, C; stage_rc(tid * 16 + i * 8192, R, C); const int Rb = Epi::PERM ? ((R & ~31) + perm32(R & 31)) : R;
        voffA[i] = (unsigned)(R * g.lda + C) * 2u; voffB[i] = (unsigned)(Rb * g.ldb + C) * 2u; }
    const size_t kstep = (size_t)(BK * 2);
    const size_t hstepA = (size_t)HALF * g.lda * 2, hstepB = (size_t)HALF * g.ldb * 2;
    const size_t tstepA = 2 * hstepA, tstepB = 2 * hstepB;
    const size_t apn = (size_t)g.a_pn_off * 2;
    const unsigned ldsw = (unsigned)wid * 1024u;
    const int aoff = lds_byte(wr * 64 + fr, fq * 8), boff = lds_byte(wc * 32 + fr, fq * 8);
#define PG8_SA(b, h) (((b) * 2 + (h)) * HTB)
#define PG8_SB(b, h) ((4 + (b) * 2 + (h)) * HTB)
#define PG8_STAGE(bufoff, gbase, voff) do { _Pragma("unroll") for (int _i = 0; _i < 2; ++_i) \
        __builtin_amdgcn_global_load_lds((const unsigned*)((const char*)(gbase) + (voff)[_i]), (PG8_LAS unsigned*)(lds + (bufoff) + ldsw + _i * 8192), 16, 0, 0); } while (0)
#define PG8_LDA(dst, b, h) do { _Pragma("unroll") for (int m = 0; m < 4; ++m) _Pragma("unroll") for (int k = 0; k < 2; ++k) dst[m][k] = *(const PG8_LAS bf16x8*)(lds + PG8_SA(b, h) + aoff + m * 2048 + k * 1024); } while (0)
#define PG8_LDB(dst, b, h) do { _Pragma("unroll") for (int n = 0; n < 2; ++n) _Pragma("unroll") for (int k = 0; k < 2; ++k) dst[n][k] = *(const PG8_LAS bf16x8*)(lds + PG8_SB(b, h) + boff + n * 2048 + k * 1024); } while (0)
#define PG8_MMA(ai, bj, At, Bt) do { __builtin_amdgcn_s_setprio(1); _Pragma("unroll") for (int m = 0; m < 4; ++m) _Pragma("unroll") for (int n = 0; n < 2; ++n) _Pragma("unroll") for (int k = 0; k < 2; ++k) \
        acc[ai][bj][m][n] = __builtin_amdgcn_mfma_f32_16x16x32_bf16(Bt[n][k], At[m][k], acc[ai][bj][m][n], 0, 0, 0); __builtin_amdgcn_s_setprio(0); } while (0)
#define PG8_WAIT_V(n) asm volatile("s_waitcnt vmcnt(" #n ")" ::: "memory")
#define PG8_WAIT_L(n) asm volatile("s_waitcnt lgkmcnt(" #n ")" ::: "memory")
#define PG8_BAR __builtin_amdgcn_s_barrier()
#define PG8_SCHED __builtin_amdgcn_sched_barrier(0)
    Unit cur, nxt; int ui = 0;
    if (!S.next(0, cur)) return;
    f32x4 acc[2][2][4][2];
#pragma unroll
    for (int a = 0; a < 2; ++a)
#pragma unroll
        for (int b = 0; b < 2; ++b)
#pragma unroll
            for (int m = 0; m < 4; ++m)
#pragma unroll
                for (int n = 0; n < 2; ++n) acc[a][b][m][n] = (f32x4){0.f, 0.f, 0.f, 0.f};
    bf16x8 At[4][2], B0[2][2], B1[2][2];
    const char* cA = (const char*)g.A + (size_t)cur.pm * tstepA + (size_t)cur.pn * apn; const char* cB = (const char*)g.Bt + (size_t)cur.pn * tstepB;
    S.a_ready(cur);
    if constexpr (SP2) {
        PG8_STAGE(PG8_SB(0, 0), cB, voffB); PG8_STAGE(PG8_SB(0, 1), cB + hstepB, voffB); PG8_STAGE(PG8_SA(0, 0), cA, voffA); PG8_STAGE(PG8_SA(0, 1), cA + hstepA, voffA);
        if (wr == 1) PG8_BAR;
        PG8_WAIT_V(2); PG8_BAR;
        PG8_STAGE(PG8_SB(1, 0), cB + kstep, voffB); PG8_STAGE(PG8_SA(1, 0), cA + kstep, voffA); PG8_STAGE(PG8_SB(1, 1), cB + hstepB + kstep, voffB);
        PG8_WAIT_V(6); PG8_BAR;
    } else {
        PG8_STAGE(PG8_SB(0, 0), cB, voffB); PG8_STAGE(PG8_SA(0, 0), cA, voffA); PG8_STAGE(PG8_SB(0, 1), cB + hstepB, voffB); PG8_STAGE(PG8_SA(0, 1), cA + hstepA, voffA);
        if (wr == 1) PG8_BAR;
        PG8_WAIT_V(4); PG8_BAR;
        PG8_STAGE(PG8_SB(1, 0), cB + kstep, voffB); PG8_STAGE(PG8_SA(1, 0), cA + kstep, voffA); PG8_STAGE(PG8_SB(1, 1), cB + hstepB + kstep, voffB);
        PG8_WAIT_V(6); PG8_BAR;
    }
    for (;;) {
        const bool has_next = S.next(ui + 1, nxt);
        const char* nA = has_next ? (const char*)g.A + (size_t)nxt.pm * tstepA + (size_t)nxt.pn * apn : cA; const char* nB = has_next ? (const char*)g.Bt + (size_t)nxt.pn * tstepB : cB;
        for (int t = 0; t < nt; t += 2) {
            const bool last = (t == nt - 2);
            const char* a1 = cA + (size_t)(t + 1) * kstep;
            const char* a2 = last ? nA : cA + (size_t)(t + 2) * kstep; const char* b2 = last ? nB : cB + (size_t)(t + 2) * kstep;
            const char* a3 = a2 + kstep; const char* b3 = b2 + kstep;
            if (last && has_next) S.a_ready(nxt);
            if constexpr (SP2) {
            const int relax = __builtin_amdgcn_readfirstlane((t == 0 && ui > 0) ? 1 : 0);
            PG8_LDB(B0, 0, 0); PG8_LDB(B1, 0, 1); PG8_SCHED; PG8_LDA(At, 0, 0); PG8_STAGE(PG8_SA(1, 1), a1 + hstepA, voffA);
            asm volatile("s_cmp_lg_u32 %0, 0\n\ts_cbranch_scc1 .Lrw%=\n\ts_waitcnt vmcnt(8)\n.Lrw%=:\n\ts_waitcnt vmcnt(24)" :: "s"(relax) : "scc", "memory");
            PG8_WAIT_L(0); PG8_BAR; PG8_MMA(0, 0, At, B0); PG8_MMA(0, 1, At, B1); PG8_BAR; PG8_SCHED;
            PG8_LDA(At, 0, 1); PG8_STAGE(PG8_SB(0, 0), b2, voffB); PG8_STAGE(PG8_SB(0, 1), b2 + hstepB, voffB); PG8_STAGE(PG8_SA(0, 0), a2, voffA);
            asm volatile("s_cmp_lg_u32 %0, 0\n\ts_cbranch_scc1 .Lrw%=\n\ts_waitcnt vmcnt(8)\n.Lrw%=:\n\ts_waitcnt vmcnt(24)" :: "s"(relax) : "scc", "memory");
            PG8_WAIT_L(0); PG8_BAR; PG8_MMA(1, 0, At, B0); PG8_MMA(1, 1, At, B1); PG8_BAR; PG8_SCHED;
            PG8_LDB(B0, 1, 0); PG8_LDB(B1, 1, 1); PG8_SCHED; PG8_LDA(At, 1, 0); PG8_STAGE(PG8_SA(0, 1), a2 + hstepA, voffA);
            PG8_WAIT_V(8); PG8_WAIT_L(0); PG8_BAR; PG8_MMA(0, 0, At, B0); PG8_MMA(0, 1, At, B1); PG8_BAR; PG8_SCHED;
            PG8_LDA(At, 1, 1); PG8_STAGE(PG8_SB(1, 0), b3, voffB); PG8_STAGE(PG8_SB(1, 1), b3 + hstepB, voffB); PG8_STAGE(PG8_SA(1, 0), a3, voffA);
            PG8_WAIT_V(8); PG8_WAIT_L(0); PG8_BAR; PG8_MMA(1, 0, At, B0); PG8_MMA(1, 1, At, B1); PG8_BAR; PG8_SCHED;
            } else {
            PG8_LDB(B0, 0, 0); PG8_SCHED; PG8_LDA(At, 0, 0); PG8_STAGE(PG8_SA(1, 1), a1 + hstepA, voffA);
            PG8_WAIT_L(8); PG8_BAR; PG8_WAIT_L(0); PG8_MMA(0, 0, At, B0); PG8_BAR; PG8_SCHED;
            PG8_LDB(B1, 0, 1); PG8_STAGE(PG8_SB(0, 0), b2, voffB);
            PG8_BAR; PG8_WAIT_L(0); PG8_MMA(0, 1, At, B1); PG8_BAR;
            PG8_LDA(At, 0, 1); PG8_STAGE(PG8_SA(0, 0), a2, voffA);
            PG8_BAR; PG8_WAIT_L(0); PG8_MMA(1, 0, At, B0); PG8_BAR; PG8_SCHED;
            PG8_STAGE(PG8_SB(0, 1), b2 + hstepB, voffB);
            PG8_WAIT_V(6); PG8_BAR; PG8_MMA(1, 1, At, B1); PG8_BAR;
            PG8_LDB(B0, 1, 0); PG8_SCHED; PG8_LDA(At, 1, 0); PG8_STAGE(PG8_SA(0, 1), a2 + hstepA, voffA);
            PG8_WAIT_L(8); PG8_BAR; PG8_WAIT_L(0); PG8_MMA(0, 0, At, B0); PG8_BAR; PG8_SCHED;
            PG8_LDB(B1, 1, 1); PG8_STAGE(PG8_SB(1, 0), b3, voffB);
            PG8_BAR; PG8_WAIT_L(0); PG8_MMA(0, 1, At, B1); PG8_BAR;
            PG8_LDA(At, 1, 1); PG8_STAGE(PG8_SA(1, 0), a3, voffA);
            PG8_BAR; PG8_WAIT_L(0); PG8_MMA(1, 0, At, B0); PG8_BAR; PG8_SCHED;
            PG8_STAGE(PG8_SB(1, 1), b3 + hstepB, voffB);
            PG8_WAIT_V(6); PG8_BAR; PG8_MMA(1, 1, At, B1); PG8_BAR;
            }
        }
        if constexpr (ALIGN_EPI) { if (wr == 0) PG8_BAR; }
        if constexpr (!Epi::AFTER_DRAIN) { E(acc, cur, wr, wc, fr, fq); S.done(cur); }
        if (!has_next) break;
#pragma unroll
        for (int a = 0; a < 2; ++a)
#pragma unroll
            for (int b = 0; b < 2; ++b)
#pragma unroll
                for (int m = 0; m < 4; ++m)
#pragma unroll
                    for (int n = 0; n < 2; ++n) acc[a][b][m][n] = (f32x4){0.f, 0.f, 0.f, 0.f};
        cur = nxt; cA = nA; cB = nB; ++ui;
        if constexpr (ALIGN_EPI) { if (wr == 1) PG8_BAR; }
    }
    PG8_WAIT_V(0);
    if constexpr (!ALIGN_EPI) { if (wr == 0) PG8_BAR; }
    PG8_BAR;
    if constexpr (Epi::AFTER_DRAIN) { E.fused(acc, cur, wr, wc, fr, fq, lds, wid, lane); S.done(cur); }
#undef PG8_SA
#undef PG8_SB
#undef PG8_STAGE
#undef PG8_LDA
#undef PG8_LDB
#undef PG8_MMA
#undef PG8_WAIT_V
#undef PG8_WAIT_L
#undef PG8_BAR
#undef PG8_SCHED
}
}


struct RowBatch { u32x4 r[8][2]; };
__device__ __forceinline__ void batch_load(RowBatch& B, __amdgpu_buffer_rsrc_t T, int iv0, int iv1, int c, int voff) {
#pragma unroll
    for (int j = 0; j < 8; ++j) {
        const int n = 8 * c + j;
        const int e = __builtin_amdgcn_readlane(n < 64 ? iv0 : iv1, n & 63);
        B.r[j][0] = __builtin_amdgcn_raw_buffer_load_b128(T, voff, e * 2048, 0); B.r[j][1] = __builtin_amdgcn_raw_buffer_load_b128(T, voff + 1024, e * 2048, 0);
    }
}
template <bool FINAL>
__device__ __forceinline__ void p6_peer_opt(const Args& a, int layer, const bf16_t* H, const float* SSQ, bf16_t* Hout, float* RSout, int nrows, int gw, int nw, int lane) {
    const __amdgpu_buffer_rsrc_t UB = MKRSRC(a.ws + WS_UB + (size_t)layer * NEXP * D * 2, NEXP * D * 2);
    const __amdgpu_buffer_rsrc_t VB = MKRSRC(a.ws + WS_VB + (size_t)layer * NEXP * D * 2, NEXP * D * 2);
    const __amdgpu_buffer_rsrc_t IDXr = MKRSRC(a.ws + WS_IDX, RP * 128 * 4), GATEr = MKRSRC(a.ws + WS_GATE, RP * 128 * 4);
    const __amdgpu_buffer_rsrc_t Hr = MKRSRC(H, RP * D * 2), SSQr = MKRSRC(SSQ, RP * 16 * 4);
    const __amdgpu_buffer_rsrc_t Or = FINAL ? MKRSRC(a.out, XROWS * D * 4) : MKRSRC(Hout, RP * D * 2);
    const int voff = lane * 16, v4 = lane * 4;
    for (int row = gw; row < nrows; row += nw) {
        const int iv0 = __builtin_amdgcn_raw_buffer_load_b32(IDXr, v4, row * 512, 0), iv1 = __builtin_amdgcn_raw_buffer_load_b32(IDXr, v4 + 256, row * 512, 0);
        const float gv0 = __builtin_bit_cast(float, __builtin_amdgcn_raw_buffer_load_b32(GATEr, v4, row * 512, 0)), gv1 = __builtin_bit_cast(float, __builtin_amdgcn_raw_buffer_load_b32(GATEr, v4 + 256, row * 512, 0));
        RowBatch A, B;
        batch_load(A, UB, iv0, iv1, 0, voff);
        const u32x4 h0 = __builtin_amdgcn_raw_buffer_load_b128(Hr, voff, row * 2048, 0), h1 = __builtin_amdgcn_raw_buffer_load_b128(Hr, voff + 1024, row * 2048, 0);
        float hv[16];
#pragma unroll
        for (int j = 0; j < 4; ++j) { hv[2 * j] = bflo(h0[j]); hv[2 * j + 1] = bfhi(h0[j]); hv[8 + 2 * j] = bflo(h1[j]); hv[9 + 2 * j] = bfhi(h1[j]); }
        const float sq = __builtin_bit_cast(float, __builtin_amdgcn_raw_buffer_load_b32(SSQr, (lane & 15) * 4, row * 64, 0));
        const float rstd = rsqrtf(wave_sum(sq) * (0.25f / D) + EPS);
        float cc0 = 0.f, cc1 = 0.f;
#define PEER_DOTS(BUF, c) do { _Pragma("unroll") for (int j = 0; j < 8; ++j) { const int n = 8 * (c) + j; float ds = 0.f; \
            u32x4 r0 = BUF.r[j][0], r1 = BUF.r[j][1]; asm volatile("" : "+v"(r0), "+v"(r1), "+v"(cc0), "+v"(cc1));     \
            _Pragma("unroll") for (int q = 0; q < 4; ++q) ds += hv[2 * q] * bflo(r0[q]) + hv[2 * q + 1] * bfhi(r0[q]) + hv[8 + 2 * q] * bflo(r1[q]) + hv[9 + 2 * q] * bfhi(r1[q]); \
            ds = wave_sum(ds); const float act = gelu_tanh(ds * rstd); \
            cc0 = (lane == n) ? gv0 * act : cc0; cc1 = (lane == n - 64) ? gv1 * act : cc1; } } while (0)
#pragma unroll 1
        for (int c = 0; c < 16; c += 2) {
            batch_load(B, UB, iv0, iv1, c + 1, voff);
            PEER_DOTS(A, c);
            if (c + 2 < 16) batch_load(A, UB, iv0, iv1, c + 2, voff); else batch_load(A, VB, iv0, iv1, 0, voff);
            PEER_DOTS(B, c + 1);
        }
#undef PEER_DOTS
        float y[16];
#pragma unroll
        for (int j = 0; j < 16; ++j) y[j] = 0.f;
#define PEER_ACC(BUF, c) do { _Pragma("unroll") for (int j = 0; j < 8; ++j) { const int n = 8 * (c) + j; \
            const float cf = __builtin_bit_cast(float, __builtin_amdgcn_readlane(__builtin_bit_cast(int, n < 64 ? cc0 : cc1), n & 63)); \
            u32x4 r0 = BUF.r[j][0], r1 = BUF.r[j][1]; \
            asm volatile("" : "+v"(r0), "+v"(r1), "+v"(y[0]), "+v"(y[1]), "+v"(y[2]), "+v"(y[3]), "+v"(y[4]), "+v"(y[5]), "+v"(y[6]), "+v"(y[7]), "+v"(y[8]), "+v"(y[9]), "+v"(y[10]), "+v"(y[11]), "+v"(y[12]), "+v"(y[13]), "+v"(y[14]), "+v"(y[15])); \
            _Pragma("unroll") for (int q = 0; q < 4; ++q) { y[2 * q] += cf * bflo(r0[q]); y[2 * q + 1] += cf * bfhi(r0[q]); y[8 + 2 * q] += cf * bflo(r1[q]); y[9 + 2 * q] += cf * bfhi(r1[q]); } } } while (0)
#pragma unroll 1
        for (int c = 0; c < 16; c += 2) {
            batch_load(B, VB, iv0, iv1, c + 1, voff);
            PEER_ACC(A, c);
            if (c + 2 < 16) batch_load(A, VB, iv0, iv1, c + 2, voff);
            PEER_ACC(B, c + 1);
        }
#undef PEER_ACC
        {
            const u32x4 r0 = __builtin_amdgcn_raw_buffer_load_b128(Hr, voff, row * 2048, 0), r1 = __builtin_amdgcn_raw_buffer_load_b128(Hr, voff + 1024, row * 2048, 0);
#pragma unroll
            for (int j = 0; j < 4; ++j) { y[2 * j] += bflo(r0[j]); y[2 * j + 1] += bfhi(r0[j]); y[8 + 2 * j] += bflo(r1[j]); y[9 + 2 * j] += bfhi(r1[j]); }
        }
        if (FINAL) {
            const int v8 = lane * 32;
            __builtin_amdgcn_raw_buffer_store_b128(__builtin_bit_cast(u32x4, (f32x4){y[0], y[1], y[2], y[3]}), Or, v8, row * 4096, 0);
            __builtin_amdgcn_raw_buffer_store_b128(__builtin_bit_cast(u32x4, (f32x4){y[4], y[5], y[6], y[7]}), Or, v8 + 16, row * 4096, 0);
            __builtin_amdgcn_raw_buffer_store_b128(__builtin_bit_cast(u32x4, (f32x4){y[8], y[9], y[10], y[11]}), Or, v8 + 2048, row * 4096, 0);
            __builtin_amdgcn_raw_buffer_store_b128(__builtin_bit_cast(u32x4, (f32x4){y[12], y[13], y[14], y[15]}), Or, v8 + 2064, row * 4096, 0);
        } else {
            u32x4 w0, w1; float ss = 0.f;
#pragma unroll
            for (int j = 0; j < 4; ++j) { w0[j] = pk2(y[2 * j], y[2 * j + 1]); w1[j] = pk2(y[8 + 2 * j], y[9 + 2 * j]); }
#pragma unroll
            for (int j = 0; j < 4; ++j) { const float a0 = bflo(w0[j]), a1 = bfhi(w0[j]), b0 = bflo(w1[j]), b1 = bfhi(w1[j]); ss += a0 * a0 + a1 * a1 + b0 * b0 + b1 * b1; }
            ss = wave_sum(ss);
            __builtin_amdgcn_raw_buffer_store_b128(w0, Or, voff, row * 2048, 0); __builtin_amdgcn_raw_buffer_store_b128(w1, Or, voff + 1024, row * 2048, 0);
            if (lane == 0) RSout[row] = rsqrtf(ss * (1.f / D) + EPS);
        }
    }
}


typedef float f32x2 __attribute__((ext_vector_type(2)));
struct RowBatch8 { u32x4 r[16]; };
__device__ __forceinline__ void batch_load8(RowBatch8& B, __amdgpu_buffer_rsrc_t T, int iv0, int iv1, int c, int voff) {
#pragma unroll
    for (int j = 0; j < 16; ++j) {
        const int n = 16 * c + j;
        const int e = __builtin_amdgcn_readlane(n < 64 ? iv0 : iv1, n & 63);
        B.r[j] = __builtin_amdgcn_raw_buffer_load_b128(T, voff, e * 1024, 0);
    }
}
template <bool FINAL>
__device__ __forceinline__ void p6_peer8(const Args& a, int layer, const bf16_t* H, const float* SSQ, bf16_t* Hout, float* RSout, int nrows, int gw, int nw, int lane) {
    const __amdgpu_buffer_rsrc_t UB = MKRSRC(a.ws + WS_UB + (size_t)layer * NEXP * D, NEXP * D), VB = MKRSRC(a.ws + WS_VB + (size_t)layer * NEXP * D, NEXP * D);
    const __amdgpu_buffer_rsrc_t USr = MKRSRC(a.ws + WS_UB + 32 * MiB + (size_t)layer * NEXP * 4, NEXP * 4), VSr = MKRSRC(a.ws + WS_VB + 32 * MiB + (size_t)layer * NEXP * 4, NEXP * 4);
    const __amdgpu_buffer_rsrc_t IDXr = MKRSRC(a.ws + WS_IDX, RP * 128 * 4), GATEr = MKRSRC(a.ws + WS_GATE, RP * 128 * 4);
    const __amdgpu_buffer_rsrc_t Hr = MKRSRC(H, RP * D * 2), SSQr = MKRSRC(SSQ, RP * 16 * 4);
    const __amdgpu_buffer_rsrc_t Or = FINAL ? MKRSRC(a.out, XROWS * D * 4) : MKRSRC(Hout, RP * D * 2);
    const int voff = lane * 16, v4 = lane * 4, v32 = lane * 32;
    for (int row = gw; row < nrows; row += nw) {
        const int iv0 = __builtin_amdgcn_raw_buffer_load_b32(IDXr, v4, row * 512, 0), iv1 = __builtin_amdgcn_raw_buffer_load_b32(IDXr, v4 + 256, row * 512, 0);
        RowBatch8 A, B;
        batch_load8(A, UB, iv0, iv1, 0, voff);
        float gs0 = __builtin_bit_cast(float, __builtin_amdgcn_raw_buffer_load_b32(GATEr, v4, row * 512, 0)), gs1 = __builtin_bit_cast(float, __builtin_amdgcn_raw_buffer_load_b32(GATEr, v4 + 256, row * 512, 0));
        const float su0 = __builtin_bit_cast(float, __builtin_amdgcn_raw_buffer_load_b32(USr, iv0 * 4, 0, 0)), su1 = __builtin_bit_cast(float, __builtin_amdgcn_raw_buffer_load_b32(USr, iv1 * 4, 0, 0));
        gs0 *= __builtin_bit_cast(float, __builtin_amdgcn_raw_buffer_load_b32(VSr, iv0 * 4, 0, 0)); gs1 *= __builtin_bit_cast(float, __builtin_amdgcn_raw_buffer_load_b32(VSr, iv1 * 4, 0, 0));
        const u32x4 h0 = __builtin_amdgcn_raw_buffer_load_b128(Hr, v32, row * 2048, 0), h1 = __builtin_amdgcn_raw_buffer_load_b128(Hr, v32 + 16, row * 2048, 0);
        float hv[16];
#pragma unroll
        for (int j = 0; j < 4; ++j) { hv[2 * j] = bflo(h0[j]); hv[2 * j + 1] = bfhi(h0[j]); hv[8 + 2 * j] = bflo(h1[j]); hv[9 + 2 * j] = bfhi(h1[j]); }
        const float sq = __builtin_bit_cast(float, __builtin_amdgcn_raw_buffer_load_b32(SSQr, (lane & 15) * 4, row * 64, 0));
        const float rstd = rsqrtf(wave_sum(sq) * (0.25f / D) + EPS);
        const float rs0 = rstd * su0, rs1 = rstd * su1;
        float cc0 = 0.f, cc1 = 0.f;
        const bool b5 = (lane & 32) != 0, b4 = (lane & 16) != 0, b3 = (lane & 8) != 0, b2 = (lane & 4) != 0;
        const int el = (b5 ? 8 : 0) + (b4 ? 4 : 0) + (b3 ? 2 : 0) + (b2 ? 1 : 0);
        const int lsrc = ((lane >> 3) & 1) * 32 + ((lane >> 2) & 1) * 16 + ((lane >> 1) & 1) * 8 + (lane & 1) * 4;
#define PEER_DOTS8(BUF, c) do { float pd[16]; \
            _Pragma("unroll") for (int j = 0; j < 16; ++j) { float ds = 0.f; \
                u32x4 r0 = BUF.r[j]; if (j > 0) asm volatile("" : "+v"(r0), "+v"(pd[j - 1])); else asm volatile("" : "+v"(r0), "+v"(cc0), "+v"(cc1));     \
                _Pragma("unroll") for (int q = 0; q < 4; ++q) { const f32x2 lo = __builtin_amdgcn_cvt_pk_f32_fp8((int)r0[q], false), hh = __builtin_amdgcn_cvt_pk_f32_fp8((int)r0[q], true); \
                    ds += (hv[4 * q] * lo[0] + hv[4 * q + 1] * lo[1]) + (hv[4 * q + 2] * hh[0] + hv[4 * q + 3] * hh[1]); } \
                pd[j] = ds; } \
              \
            float q8[8], q4[4], q2[2]; \
            _Pragma("unroll") for (int j = 0; j < 8; ++j) { const float snd = b5 ? pd[j] : pd[j + 8], kp = b5 ? pd[j + 8] : pd[j]; q8[j] = kp + __shfl_xor(snd, 32); } \
            _Pragma("unroll") for (int j = 0; j < 4; ++j) { const float snd = b4 ? q8[j] : q8[j + 4], kp = b4 ? q8[j + 4] : q8[j]; q4[j] = kp + __shfl_xor(snd, 16); } \
            _Pragma("unroll") for (int j = 0; j < 2; ++j) { const float snd = b3 ? q4[j] : q4[j + 2], kp = b3 ? q4[j + 2] : q4[j]; q2[j] = kp + __shfl_xor(snd, 8); } \
            float q1 = (b2 ? q2[1] : q2[0]) + __shfl_xor(b2 ? q2[0] : q2[1], 4); \
            q1 += __shfl_xor(q1, 2); q1 += __shfl_xor(q1, 1); \
            const float rsv = __shfl((c) < 4 ? rs0 : rs1, 16 * ((c) & 3) + el);        \
            const float actv = __shfl(gelu_tanh(q1 * rsv), lsrc);                       \
            const bool mine = (lane >> 4) == ((c) & 3); \
            cc0 = (mine && (c) < 4) ? gs0 * actv : cc0; cc1 = (mine && (c) >= 4) ? gs1 * actv : cc1; } while (0)
#pragma unroll 1
        for (int c = 0; c < 8; c += 2) {
            batch_load8(B, UB, iv0, iv1, c + 1, voff);
            PEER_DOTS8(A, c);
            if (c + 2 < 8) batch_load8(A, UB, iv0, iv1, c + 2, voff); else batch_load8(A, VB, iv0, iv1, 0, voff);
            PEER_DOTS8(B, c + 1);
        }
#undef PEER_DOTS8
        float y[16];
#pragma unroll
        for (int j = 0; j < 16; ++j) y[j] = 0.f;
#define PEER_ACC8(BUF, c) do { _Pragma("unroll") for (int j = 0; j < 16; ++j) { const int n = 16 * (c) + j; \
            const float cf = __builtin_bit_cast(float, __builtin_amdgcn_readlane(__builtin_bit_cast(int, n < 64 ? cc0 : cc1), n & 63)); \
            u32x4 r0 = BUF.r[j]; \
            asm volatile("" : "+v"(r0), "+v"(y[0]), "+v"(y[1]), "+v"(y[2]), "+v"(y[3]), "+v"(y[4]), "+v"(y[5]), "+v"(y[6]), "+v"(y[7]), "+v"(y[8]), "+v"(y[9]), "+v"(y[10]), "+v"(y[11]), "+v"(y[12]), "+v"(y[13]), "+v"(y[14]), "+v"(y[15])); \
            _Pragma("unroll") for (int q = 0; q < 4; ++q) { const f32x2 lo = __builtin_amdgcn_cvt_pk_f32_fp8((int)r0[q], false), hh = __builtin_amdgcn_cvt_pk_f32_fp8((int)r0[q], true); \
                y[4 * q] += cf * lo[0]; y[4 * q + 1] += cf * lo[1]; y[4 * q + 2] += cf * hh[0]; y[4 * q + 3] += cf * hh[1]; } } } while (0)
#pragma unroll 1
        for (int c = 0; c < 8; c += 2) {
            batch_load8(B, VB, iv0, iv1, c + 1, voff);
            PEER_ACC8(A, c);
            if (c + 2 < 8) batch_load8(A, VB, iv0, iv1, c + 2, voff);
            PEER_ACC8(B, c + 1);
        }
#undef PEER_ACC8
        {
            const u32x4 r0 = __builtin_amdgcn_raw_buffer_load_b128(Hr, v32, row * 2048, 0), r1 = __builtin_amdgcn_raw_buffer_load_b128(Hr, v32 + 16, row * 2048, 0);
#pragma unroll
            for (int j = 0; j < 4; ++j) { y[2 * j] += bflo(r0[j]); y[2 * j + 1] += bfhi(r0[j]); y[8 + 2 * j] += bflo(r1[j]); y[9 + 2 * j] += bfhi(r1[j]); }
        }
        if (FINAL) {
            const int v64 = lane * 64;
#pragma unroll
            for (int q = 0; q < 4; ++q) __builtin_amdgcn_raw_buffer_store_b128(__builtin_bit_cast(u32x4, (f32x4){y[4 * q], y[4 * q + 1], y[4 * q + 2], y[4 * q + 3]}), Or, v64 + 16 * q, row * 4096, 0);
        } else {
            u32x4 w0, w1; float ss = 0.f;
#pragma unroll
            for (int j = 0; j < 4; ++j) { w0[j] = pk2(y[2 * j], y[2 * j + 1]); w1[j] = pk2(y[8 + 2 * j], y[9 + 2 * j]); }
#pragma unroll
            for (int j = 0; j < 4; ++j) { const float a0 = bflo(w0[j]), a1 = bfhi(w0[j]), b0 = bflo(w1[j]), b1 = bfhi(w1[j]); ss += a0 * a0 + a1 * a1 + b0 * b0 + b1 * b1; }
            ss = wave_sum(ss);
            __builtin_amdgcn_raw_buffer_store_b128(w0, Or, v32, row * 2048, 0); __builtin_amdgcn_raw_buffer_store_b128(w1, Or, v32 + 16, row * 2048, 0);
            if (lane == 0) RSout[row] = rsqrtf(ss * (1.f / D) + EPS);
        }
    }
}


struct RowBatch6 { u32x3 r[16]; };
template <bool F4> __device__ __forceinline__ void batch_load6(RowBatch6& B, __amdgpu_buffer_rsrc_t T, int iv0, int iv1, int c, int lane) {
#pragma unroll
    for (int j = 0; j < 16; ++j) {
        const int n = 16 * c + j;
        const int e = __builtin_amdgcn_readlane(n < 64 ? iv0 : iv1, n & 63);
        if (F4) { const u32x2 t = __builtin_amdgcn_raw_buffer_load_b64(T, lane * 8, e * 512, 0); B.r[j] = (u32x3){t[0], t[1], 0u}; }
        else B.r[j] = __builtin_amdgcn_raw_buffer_load_b96(T, lane * 12, e * 768, 0);
    }
}
template <bool FINAL>
__device__ __forceinline__ void p6_peer6(const Args& a, int layer, const bf16_t* H, const float* SSQ, bf16_t* Hout, float* RSout, int nrows, int gw, int nw, int lane) {
    const __amdgpu_buffer_rsrc_t UB = MKRSRC(a.ws + WS_UB + (size_t)layer * NEXP * USTRIDE, NEXP * USTRIDE), VB = MKRSRC(a.ws + WS_VB + (size_t)layer * NEXP * VSTRIDE, NEXP * VSTRIDE);
    const __amdgpu_buffer_rsrc_t USr = MKRSRC(a.ws + WS_UB + 32 * MiB + (size_t)layer * NEXP * 4, NEXP * 4), VSr = MKRSRC(a.ws + WS_VB + 32 * MiB + (size_t)layer * NEXP * 4, NEXP * 4);
    const __amdgpu_buffer_rsrc_t IDXr = MKRSRC(a.ws + WS_IDX, RP * 128 * 4), GATEr = MKRSRC(a.ws + WS_GATE, RP * 128 * 4);
    const __amdgpu_buffer_rsrc_t Hr = MKRSRC(H, RP * D * 2), SSQr = MKRSRC(SSQ, RP * 16 * 4);
    const __amdgpu_buffer_rsrc_t Or = FINAL ? MKRSRC(a.out, XROWS * D * 4) : MKRSRC(Hout, RP * D * 2);
    const int voff = lane, v4 = lane * 4, v32 = lane * 32;
    const bool b5 = (lane & 32) != 0, b4 = (lane & 16) != 0, b3 = (lane & 8) != 0, b2 = (lane & 4) != 0;
    const int el = (b5 ? 8 : 0) + (b4 ? 4 : 0) + (b3 ? 2 : 0) + (b2 ? 1 : 0);
    const int lsrc = ((lane >> 3) & 1) * 32 + ((lane >> 2) & 1) * 16 + ((lane >> 1) & 1) * 8 + (lane & 1) * 4;
    for (int row = gw; row < nrows; row += nw) {
        const int iv0 = __builtin_amdgcn_raw_buffer_load_b32(IDXr, v4, row * 512, 0), iv1 = __builtin_amdgcn_raw_buffer_load_b32(IDXr, v4 + 256, row * 512, 0);
        RowBatch6 A, B;
        batch_load6<U4>(A, UB, iv0, iv1, 0, voff);
        float gs0 = __builtin_bit_cast(float, __builtin_amdgcn_raw_buffer_load_b32(GATEr, v4, row * 512, 0)), gs1 = __builtin_bit_cast(float, __builtin_amdgcn_raw_buffer_load_b32(GATEr, v4 + 256, row * 512, 0));
        const float su0 = __builtin_bit_cast(float, __builtin_amdgcn_raw_buffer_load_b32(USr, iv0 * 4, 0, 0)), su1 = __builtin_bit_cast(float, __builtin_amdgcn_raw_buffer_load_b32(USr, iv1 * 4, 0, 0));
        gs0 *= __builtin_bit_cast(float, __builtin_amdgcn_raw_buffer_load_b32(VSr, iv0 * 4, 0, 0)); gs1 *= __builtin_bit_cast(float, __builtin_amdgcn_raw_buffer_load_b32(VSr, iv1 * 4, 0, 0));
        const u32x4 h0 = __builtin_amdgcn_raw_buffer_load_b128(Hr, v32, row * 2048, 0), h1 = __builtin_amdgcn_raw_buffer_load_b128(Hr, v32 + 16, row * 2048, 0);
        float hv[16];
#pragma unroll
        for (int j = 0; j < 4; ++j) { hv[2 * j] = bflo(h0[j]); hv[2 * j + 1] = bfhi(h0[j]); hv[8 + 2 * j] = bflo(h1[j]); hv[9 + 2 * j] = bfhi(h1[j]); }
        const float sq = __builtin_bit_cast(float, __builtin_amdgcn_raw_buffer_load_b32(SSQr, (lane & 15) * 4, row * 64, 0));
        const float rstd = rsqrtf(wave_sum(sq) * (0.25f / D) + EPS);
        const float rs0 = rstd * su0, rs1 = rstd * su1;
        float cc0 = 0.f, cc1 = 0.f;
#define PEER_DOTS6(BUF, c) do { float pd[16]; \
            _Pragma("unroll") for (int j = 0; j < 16; j += 2) { \
                u32x6 s6 = (u32x6){BUF.r[j][0], BUF.r[j][1], BUF.r[j][2], BUF.r[j + 1][0], BUF.r[j + 1][1], BUF.r[j + 1][2]}; \
                if (j > 0) asm volatile("" : "+v"(s6), "+v"(pd[j - 1])); else asm volatile("" : "+v"(s6), "+v"(cc0), "+v"(cc1));     \
                float d0 = 0.f, d1 = 0.f; \
                if (U4) { _Pragma("unroll") for (int w = 0; w < 2; ++w) { \
                        { const f32x2 e0 = __builtin_amdgcn_cvt_scalef32_pk_f32_fp4(s6[w], 1.0f, 0), e1 = __builtin_amdgcn_cvt_scalef32_pk_f32_fp4(s6[w], 1.0f, 1), e2 = __builtin_amdgcn_cvt_scalef32_pk_f32_fp4(s6[w], 1.0f, 2), e3 = __builtin_amdgcn_cvt_scalef32_pk_f32_fp4(s6[w], 1.0f, 3); \
                          d0 += (hv[8 * w] * e0[0] + hv[8 * w + 1] * e0[1]) + (hv[8 * w + 2] * e1[0] + hv[8 * w + 3] * e1[1]) + (hv[8 * w + 4] * e2[0] + hv[8 * w + 5] * e2[1]) + (hv[8 * w + 6] * e3[0] + hv[8 * w + 7] * e3[1]); } \
                        { const f32x2 e0 = __builtin_amdgcn_cvt_scalef32_pk_f32_fp4(s6[3 + w], 1.0f, 0), e1 = __builtin_amdgcn_cvt_scalef32_pk_f32_fp4(s6[3 + w], 1.0f, 1), e2 = __builtin_amdgcn_cvt_scalef32_pk_f32_fp4(s6[3 + w], 1.0f, 2), e3 = __builtin_amdgcn_cvt_scalef32_pk_f32_fp4(s6[3 + w], 1.0f, 3); \
                          d1 += (hv[8 * w] * e0[0] + hv[8 * w + 1] * e0[1]) + (hv[8 * w + 2] * e1[0] + hv[8 * w + 3] * e1[1]) + (hv[8 * w + 4] * e2[0] + hv[8 * w + 5] * e2[1]) + (hv[8 * w + 6] * e3[0] + hv[8 * w + 7] * e3[1]); } } \
                } else { const f32x32 dv = __builtin_amdgcn_cvt_scalef32_pk32_f32_fp6(s6, 1.0f); \
                    _Pragma("unroll") for (int i = 0; i < 16; ++i) { d0 += hv[i] * dv[i]; d1 += hv[i] * dv[16 + i]; } } \
                pd[j] = d0; pd[j + 1] = d1; } \
              \
            float q8[8], q4[4], q2[2]; \
            _Pragma("unroll") for (int j = 0; j < 8; ++j) { const float snd = b5 ? pd[j] : pd[j + 8], kp = b5 ? pd[j + 8] : pd[j]; q8[j] = kp + __shfl_xor(snd, 32); } \
            _Pragma("unroll") for (int j = 0; j < 4; ++j) { const float snd = b4 ? q8[j] : q8[j + 4], kp = b4 ? q8[j + 4] : q8[j]; q4[j] = kp + __shfl_xor(snd, 16); } \
            _Pragma("unroll") for (int j = 0; j < 2; ++j) { const float snd = b3 ? q4[j] : q4[j + 2], kp = b3 ? q4[j + 2] : q4[j]; q2[j] = kp + __shfl_xor(snd, 8); } \
            float q1 = (b2 ? q2[1] : q2[0]) + __shfl_xor(b2 ? q2[0] : q2[1], 4); \
            q1 += __shfl_xor(q1, 2); q1 += __shfl_xor(q1, 1); \
            const float rsv = __shfl((c) < 4 ? rs0 : rs1, 16 * ((c) & 3) + el);        \
            const float actv = __shfl(gelu_tanh(q1 * rsv), lsrc);                       \
            const bool mine = (lane >> 4) == ((c) & 3); \
            cc0 = (mine && (c) < 4) ? gs0 * actv : cc0; cc1 = (mine && (c) >= 4) ? gs1 * actv : cc1; } while (0)
#pragma unroll 1
        for (int c = 0; c < 8; c += 2) {
            batch_load6<U4>(B, UB, iv0, iv1, c + 1, voff);
            PEER_DOTS6(A, c);
            if (c + 2 < 8) batch_load6<U4>(A, UB, iv0, iv1, c + 2, voff); else batch_load6<V4>(A, VB, iv0, iv1, 0, voff);
            PEER_DOTS6(B, c + 1);
        }
#undef PEER_DOTS6
        float y[16];
#pragma unroll
        for (int j = 0; j < 16; ++j) y[j] = 0.f;
#define ACC4_BYTE(w, bb) do { const f32x2 e0 = __builtin_amdgcn_cvt_scalef32_pk_f32_fp4(s6[w], 1.0f, bb), e1 = __builtin_amdgcn_cvt_scalef32_pk_f32_fp4(s6[3 + w], 1.0f, bb); \
            y[8 * (w) + 2 * (bb)] += cf0 * e0[0] + cf1 * e1[0]; y[8 * (w) + 2 * (bb) + 1] += cf0 * e0[1] + cf1 * e1[1]; } while (0)
#define PEER_ACC6(BUF, c) do { _Pragma("unroll") for (int j = 0; j < 16; j += 2) { const int n = 16 * (c) + j; \
            const float cf0 = __builtin_bit_cast(float, __builtin_amdgcn_readlane(__builtin_bit_cast(int, n < 64 ? cc0 : cc1), n & 63)); \
            const float cf1 = __builtin_bit_cast(float, __builtin_amdgcn_readlane(__builtin_bit_cast(int, n < 64 ? cc0 : cc1), (n + 1) & 63)); \
            u32x6 s6 = (u32x6){BUF.r[j][0], BUF.r[j][1], BUF.r[j][2], BUF.r[j + 1][0], BUF.r[j + 1][1], BUF.r[j + 1][2]}; \
            asm volatile("" : "+v"(s6), "+v"(y[0]), "+v"(y[1]), "+v"(y[2]), "+v"(y[3]), "+v"(y[4]), "+v"(y[5]), "+v"(y[6]), "+v"(y[7]), "+v"(y[8]), "+v"(y[9]), "+v"(y[10]), "+v"(y[11]), "+v"(y[12]), "+v"(y[13]), "+v"(y[14]), "+v"(y[15])); \
            if (V4) { _Pragma("unroll") for (int w = 0; w < 2; ++w) { \
                    ACC4_BYTE(w, 0); ACC4_BYTE(w, 1); ACC4_BYTE(w, 2); ACC4_BYTE(w, 3); } \
            } else { const f32x32 dv = __builtin_amdgcn_cvt_scalef32_pk32_f32_fp6(s6, 1.0f); \
                _Pragma("unroll") for (int i = 0; i < 16; ++i) y[i] += cf0 * dv[i] + cf1 * dv[16 + i]; } } } while (0)
#pragma unroll 1
        for (int c = 0; c < 8; c += 2) {
            batch_load6<V4>(B, VB, iv0, iv1, c + 1, voff);
            PEER_ACC6(A, c);
            if (c + 2 < 8) batch_load6<V4>(A, VB, iv0, iv1, c + 2, voff);
            PEER_ACC6(B, c + 1);
        }
#undef PEER_ACC6
        {
            const u32x4 r0 = __builtin_amdgcn_raw_buffer_load_b128(Hr, v32, row * 2048, 0), r1 = __builtin_amdgcn_raw_buffer_load_b128(Hr, v32 + 16, row * 2048, 0);
#pragma unroll
            for (int j = 0; j < 4; ++j) { y[2 * j] += bflo(r0[j]); y[2 * j + 1] += bfhi(r0[j]); y[8 + 2 * j] += bflo(r1[j]); y[9 + 2 * j] += bfhi(r1[j]); }
        }
        if (FINAL) {
            const int v64 = lane * 64;
#pragma unroll
            for (int q = 0; q < 4; ++q) __builtin_amdgcn_raw_buffer_store_b128(__builtin_bit_cast(u32x4, (f32x4){y[4 * q], y[4 * q + 1], y[4 * q + 2], y[4 * q + 3]}), Or, v64 + 16 * q, row * 4096, 0);
        } else {
            u32x4 w0, w1; float ss = 0.f;
#pragma unroll
            for (int j = 0; j < 4; ++j) { w0[j] = pk2(y[2 * j], y[2 * j + 1]); w1[j] = pk2(y[8 + 2 * j], y[9 + 2 * j]); }
#pragma unroll
            for (int j = 0; j < 4; ++j) { const float a0 = bflo(w0[j]), a1 = bfhi(w0[j]), b0 = bflo(w1[j]), b1 = bfhi(w1[j]); ss += a0 * a0 + a1 * a1 + b0 * b0 + b1 * b1; }
            ss = wave_sum(ss);
            __builtin_amdgcn_raw_buffer_store_b128(w0, Or, v32, row * 2048, 0); __builtin_amdgcn_raw_buffer_store_b128(w1, Or, v32 + 16, row * 2048, 0);
            if (lane == 0) RSout[row] = rsqrtf(ss * (1.f / D) + EPS);
        }
    }
}


constexpr int CQ_MAXR = 17, CQ_WLDS = CQ_MAXR * 1024 + 128;
struct QBatch { u32x3 r[8]; };
template <bool FINAL>
__device__ __forceinline__ void p6_peer_cq(const Args& a, int layer, const bf16_t* H, const float* SSQ, bf16_t* Hout, float* RSout, int nrows, LAS unsigned char* lds) {
    const int tid = opaque_tid(), lane = tid & 63, wave = __builtin_amdgcn_readfirstlane(tid >> 6), slot = lane >> 4, chunk = lane & 15;
    const int gw = wave * (int)gridDim.x + (int)blockIdx.x, nw = (int)gridDim.x * 8;
    const int nk = gw < nrows ? (nrows - gw + nw - 1) / nw : 0;
    LAS int* IDXL = (LAS int*)(lds + wave * CQ_WLDS); LAS float* CL = (LAS float*)(lds + wave * CQ_WLDS + CQ_MAXR * 512); LAS float* RSL = (LAS float*)(lds + wave * CQ_WLDS + CQ_MAXR * 1024);
    const __amdgpu_buffer_rsrc_t USr = MKRSRC(a.ws + WS_UB + 32 * MiB + (size_t)layer * NEXP * 4, NEXP * 4), VSr = MKRSRC(a.ws + WS_VB + 32 * MiB + (size_t)layer * NEXP * 4, NEXP * 4);
    const __amdgpu_buffer_rsrc_t IDXr = MKRSRC(a.ws + WS_IDX, RP * 128 * 4), GATEr = MKRSRC(a.ws + WS_GATE, RP * 128 * 4);
    const __amdgpu_buffer_rsrc_t Hr = MKRSRC(H, RP * D * 2), SSQr = MKRSRC(SSQ, RP * 16 * 4);
    const __amdgpu_buffer_rsrc_t Or = FINAL ? MKRSRC(a.out, XROWS * D * 4) : MKRSRC(Hout, RP * D * 2);
    const bool b3 = (chunk & 8) != 0, b2 = (chunk & 4) != 0, b1 = (chunk & 2) != 0, b0 = (chunk & 1) != 0, s1 = (slot & 2) != 0, s0 = (slot & 1) != 0;
    const int c12 = chunk * 12;
    for (int k0 = 0; k0 < nk; k0 += 6) {
        int t0[6], t1[6];
#pragma unroll
        for (int j = 0; j < 6; ++j) { const int kk = k0 + j < nk ? k0 + j : nk - 1, row = gw + kk * nw;
            t0[j] = __builtin_amdgcn_raw_buffer_load_b32(IDXr, lane * 4, row * 512, 0); t1[j] = __builtin_amdgcn_raw_buffer_load_b32(IDXr, lane * 4 + 256, row * 512, 0); }
#pragma unroll
        for (int j = 0; j < 6; ++j) if (k0 + j < nk) { IDXL[(k0 + j) * 128 + lane] = t0[j]; IDXL[(k0 + j) * 128 + 64 + lane] = t1[j]; }
    }
#define CQ_LOAD(BUF, T, kk, bt) do { int ev[8]; _Pragma("unroll") for (int j = 0; j < 8; ++j) ev[j] = IDXL[(kk) * 128 + 32 * (bt) + 4 * j + slot]; \
        asm volatile("" : "+v"(ev[0]), "+v"(ev[1]), "+v"(ev[2]), "+v"(ev[3]), "+v"(ev[4]), "+v"(ev[5]), "+v"(ev[6]), "+v"(ev[7]));     \
        _Pragma("unroll") for (int j = 0; j < 8; ++j) BUF.r[j] = __builtin_amdgcn_raw_buffer_load_b96(T, ev[j] * 192 + c12, 0, 0); } while (0)
#define CQ_TAB(base, qq) MKRSRC(a.ws + (base) + ((size_t)layer * 4 + (qq)) * NEXP * 192, NEXP * 192)
    const int total = 4 * nk;
    if (U8 && nk > 0) {
        const int slot8 = lane >> 3, chunk8 = lane & 7;
        const bool c2 = (chunk8 & 4) != 0, c1 = (chunk8 & 2) != 0, c0 = (chunk8 & 1) != 0;
        const __amdgpu_buffer_rsrc_t H8r = MKRSRC(a.ws + WS_P1, RP * 1024);
        LAS int* CLI = (LAS int*)CL; LAS float* HSL = RSL;
        for (int k0 = 0; k0 < nk; k0 += 4) {
            u32x4 ha[4], hb[4];
#pragma unroll
            for (int j = 0; j < 4; ++j) { const int kk = k0 + j < nk ? k0 + j : nk - 1, row = gw + kk * nw;
                ha[j] = __builtin_amdgcn_raw_buffer_load_b128(Hr, lane * 32, row * 2048, 0); hb[j] = __builtin_amdgcn_raw_buffer_load_b128(Hr, lane * 32 + 16, row * 2048, 0); }
#pragma unroll
            for (int j = 0; j < 4; ++j) if (k0 + j < nk) { const int row = gw + (k0 + j) * nw;
                float hv[16], am = 0.f;
#pragma unroll
                for (int i = 0; i < 4; ++i) { hv[2 * i] = bflo(ha[j][i]); hv[2 * i + 1] = bfhi(ha[j][i]); hv[8 + 2 * i] = bflo(hb[j][i]); hv[9 + 2 * i] = bfhi(hb[j][i]); }
#pragma unroll
                for (int i = 0; i < 16; ++i) am = fmaxf(am, fabsf(hv[i]));
#pragma unroll
                for (int o = 1; o < 64; o <<= 1) am = fmaxf(am, __shfl_xor(am, o));
                const float sc = am > 0.f ? am * (UI4 ? 1.f / 119.f : 1.f / 127.f) : 1.f, inv = 1.f / sc;
                unsigned w[4] = {0u, 0u, 0u, 0u};
                if (UI4) {
#pragma unroll
                    for (int i = 0; i < 16; ++i) { const int q = (int)__builtin_rintf(hv[i] * inv), hl = ((q + 8) & 15) - 8, hh = (q - hl) >> 4;
                        w[i >> 3] |= ((unsigned)hh & 0xfu) << (4 * (i & 7)); w[2 + (i >> 3)] |= ((unsigned)hl & 0xfu) << (4 * (i & 7)); }
                    __builtin_amdgcn_raw_buffer_store_b64((u32x2){w[0], w[1]}, H8r, lane * 8, row * 1024, 0); __builtin_amdgcn_raw_buffer_store_b64((u32x2){w[2], w[3]}, H8r, 512 + lane * 8, row * 1024, 0);
                } else {
#pragma unroll
                    for (int i = 0; i < 16; ++i) { const int q = (int)__builtin_rintf(hv[i] * inv); w[i >> 2] |= ((unsigned)q & 0xffu) << (8 * (i & 3)); }
                    __builtin_amdgcn_raw_buffer_store_b128((u32x4){w[0], w[1], w[2], w[3]}, H8r, lane * 16, row * 1024, 0);
                }
                if (lane == 0) HSL[k0 + j] = sc; }
        }
        __threadfence_block();
        struct UB4 { u32x4 r[4]; };
        constexpr int NSW = UI4 ? 4 : 8;
#define U8_TAB(ee) MKRSRC(a.ws + WS_UB + ((size_t)layer * NSW + (ee)) * NEXP * 128, NEXP * 128)
#define U8_LOAD(BUF, T, kk, bt) do { int ev[4]; _Pragma("unroll") for (int j = 0; j < 4; ++j) ev[j] = IDXL[(kk) * 128 + 32 * (bt) + 8 * j + slot8]; \
            asm volatile("" : "+v"(ev[0]), "+v"(ev[1]), "+v"(ev[2]), "+v"(ev[3])); \
            _Pragma("unroll") for (int j = 0; j < 4; ++j) BUF.r[j] = __builtin_amdgcn_raw_buffer_load_b128(T, ev[j] * 128 + chunk8 * 16, 0, 0); } while (0)
#define U8_DOTS(BUF, bt) do { _Pragma("unroll") for (int j = 0; j < 4; ++j) { const u32x4 w4 = BUF.r[j]; \
            if (UI4) { const int ah = __builtin_amdgcn_sdot8((int)w4[3], (int)h8[3], __builtin_amdgcn_sdot8((int)w4[2], (int)h8[2], __builtin_amdgcn_sdot8((int)w4[1], (int)h8[1], __builtin_amdgcn_sdot8((int)w4[0], (int)h8[0], 0, false), false), false), false); \
                const int al = __builtin_amdgcn_sdot8((int)w4[3], (int)h8l[3], __builtin_amdgcn_sdot8((int)w4[2], (int)h8l[2], __builtin_amdgcn_sdot8((int)w4[1], (int)h8l[1], __builtin_amdgcn_sdot8((int)w4[0], (int)h8l[0], 0, false), false), false), false); \
                pd[4 * (bt) + j] = ah * 16 + al; } \
            else pd[4 * (bt) + j] = __builtin_amdgcn_sdot4((int)w4[3], (int)h8[3], __builtin_amdgcn_sdot4((int)w4[2], (int)h8[2], __builtin_amdgcn_sdot4((int)w4[1], (int)h8[1], __builtin_amdgcn_sdot4((int)w4[0], (int)h8[0], 0, false), false), false), false); } } while (0)
        UB4 A0, A1, A2, A3; u32x4 h8n, h8ln = (u32x4){0u, 0u, 0u, 0u};
        { const __amdgpu_buffer_rsrc_t T0 = U8_TAB(0);
          h8n = __builtin_amdgcn_raw_buffer_load_b128(H8r, chunk8 * 16, gw * 1024, 0);
          if (UI4) h8ln = __builtin_amdgcn_raw_buffer_load_b128(H8r, 512 + chunk8 * 16, gw * 1024, 0);
          U8_LOAD(A0, T0, 0, 0); U8_LOAD(A1, T0, 0, 1); U8_LOAD(A2, T0, 0, 2); U8_LOAD(A3, T0, 0, 3); }
        const int total8 = NSW * nk;
        int e = 0, k = 0;
#pragma unroll 1
        for (int f = 0; f < total8; ++f) {
            const int row = gw + k * nw;
            const u32x4 h8 = h8n, h8l = h8ln;
            const int ib = 8 * (c2 ? 1 : 0) + 4 * (c1 ? 1 : 0) + 2 * (c0 ? 1 : 0);
            float fus[2] = {0.f, 0.f}, fvs[2] = {0.f, 0.f}, fg[2] = {0.f, 0.f}, fsq = 0.f;
            if (e == NSW - 1) {
                fsq = __builtin_bit_cast(float, __builtin_amdgcn_raw_buffer_load_b32(SSQr, (lane & 15) * 4, row * 64, 0));
#pragma unroll
                for (int m = 0; m < 2; ++m) { const int n = 8 * (ib + m) + slot8, ex = IDXL[k * 128 + n];
                    fus[m] = __builtin_bit_cast(float, __builtin_amdgcn_raw_buffer_load_b32(USr, ex * 4, 0, 0)); fvs[m] = __builtin_bit_cast(float, __builtin_amdgcn_raw_buffer_load_b32(VSr, ex * 4, 0, 0));
                    fg[m] = __builtin_bit_cast(float, __builtin_amdgcn_raw_buffer_load_b32(GATEr, n * 4, row * 512, 0)); }
            }
            int kn = k + 1, en = e; if (kn == nk) { kn = 0; ++en; }
            if (f + 1 == total8) { kn = k; en = e; }
            const __amdgpu_buffer_rsrc_t TN = U8_TAB(en);
            int pd[16];
            U8_DOTS(A0, 0);
            h8n = __builtin_amdgcn_raw_buffer_load_b128(H8r, en * 128 + chunk8 * 16, (gw + kn * nw) * 1024, 0);
            if (UI4) h8ln = __builtin_amdgcn_raw_buffer_load_b128(H8r, 512 + en * 128 + chunk8 * 16, (gw + kn * nw) * 1024, 0);
            U8_LOAD(A0, TN, kn, 0);
            U8_DOTS(A1, 1); U8_LOAD(A1, TN, kn, 1);
            U8_DOTS(A2, 2); U8_LOAD(A2, TN, kn, 2);
            U8_DOTS(A3, 3); U8_LOAD(A3, TN, kn, 3);
            int q8[8], q4[4], q2[2];
#pragma unroll
            for (int j = 0; j < 8; ++j) { const int snd = c2 ? pd[j] : pd[j + 8], kp = c2 ? pd[j + 8] : pd[j]; q8[j] = kp + __shfl_xor(snd, 4); }
#pragma unroll
            for (int j = 0; j < 4; ++j) { const int snd = c1 ? q8[j] : q8[j + 4], kp = c1 ? q8[j + 4] : q8[j]; q4[j] = kp + __builtin_amdgcn_update_dpp(0, snd, 0x4E, 0xF, 0xF, true); }
#pragma unroll
            for (int j = 0; j < 2; ++j) { const int snd = c0 ? q4[j] : q4[j + 2], kp = c0 ? q4[j + 2] : q4[j]; q2[j] = kp + __builtin_amdgcn_update_dpp(0, snd, 0xB1, 0xF, 0xF, true); }
            if (e < NSW - 1) {
#pragma unroll
                for (int m = 0; m < 2; ++m) { const int ad = k * 128 + 8 * (ib + m) + slot8; CLI[ad] = e == 0 ? q2[m] : CLI[ad] + q2[m]; }
            } else {
                const float rstd = rsqrtf(wave_sum(fsq) * (0.25f / D) + EPS), hs = HSL[k];
#pragma unroll
                for (int m = 0; m < 2; ++m) { const int ad = k * 128 + 8 * (ib + m) + slot8;
                    const float dot = (float)(CLI[ad] + q2[m]) * hs;
                    CL[ad] = fg[m] * fvs[m] * gelu_tanh(dot * rstd * fus[m]); }
            }
            k = kn; e = en;
        }
#undef U8_TAB
#undef U8_LOAD
#undef U8_DOTS
    }
    if (!U8 && nk > 0) {
        QBatch A0, A1, A2, A3; u32x4 hn0, hn1;
        { const __amdgpu_buffer_rsrc_t T0 = CQ_TAB(WS_UB, 0);
          hn0 = __builtin_amdgcn_raw_buffer_load_b128(Hr, chunk * 32, gw * 2048, 0); hn1 = __builtin_amdgcn_raw_buffer_load_b128(Hr, chunk * 32 + 16, gw * 2048, 0);
          CQ_LOAD(A0, T0, 0, 0); CQ_LOAD(A1, T0, 0, 1); CQ_LOAD(A2, T0, 0, 2); CQ_LOAD(A3, T0, 0, 3); }
        int q = 0, k = 0;
#pragma unroll 1
        for (int f = 0; f < total; ++f) {
            const int row = gw + k * nw;
            float hv[16];
#pragma unroll
            for (int j = 0; j < 4; ++j) { hv[2 * j] = bflo(hn0[j]); hv[2 * j + 1] = bfhi(hn0[j]); hv[8 + 2 * j] = bflo(hn1[j]); hv[9 + 2 * j] = bfhi(hn1[j]); }
            float pd[16], chain = 0.f;
            float fus[2] = {0.f, 0.f}, fvs[2] = {0.f, 0.f}, fg[2] = {0.f, 0.f}, fsq = 0.f;
            if (q == 3) {
                fsq = __builtin_bit_cast(float, __builtin_amdgcn_raw_buffer_load_b32(SSQr, chunk * 4, row * 64, 0));
#pragma unroll
                for (int m = 0; m < 2; ++m) { const int n = 64 * m + 4 * chunk + slot, e = IDXL[k * 128 + n];
                    fus[m] = __builtin_bit_cast(float, __builtin_amdgcn_raw_buffer_load_b32(USr, e * 4, 0, 0)); fvs[m] = __builtin_bit_cast(float, __builtin_amdgcn_raw_buffer_load_b32(VSr, e * 4, 0, 0));
                    fg[m] = __builtin_bit_cast(float, __builtin_amdgcn_raw_buffer_load_b32(GATEr, n * 4, row * 512, 0)); }
            }
#define CQ_DOTS(BUF, base) do { _Pragma("unroll") for (int j = 0; j < 8; j += 2) { \
                u32x6 s6 = (u32x6){BUF.r[j][0], BUF.r[j][1], BUF.r[j][2], BUF.r[j + 1][0], BUF.r[j + 1][1], BUF.r[j + 1][2]}; \
                asm volatile("" : "+v"(s6), "+v"(chain));     \
                const f32x32 dv = __builtin_amdgcn_cvt_scalef32_pk32_f32_fp6(s6, 1.0f); f32x2 d0 = (f32x2){0.f, 0.f}, d1 = (f32x2){0.f, 0.f}; \
                _Pragma("unroll") for (int i = 0; i < 8; ++i) { const f32x2 h2 = (f32x2){hv[2 * i], hv[2 * i + 1]}; \
                    d0 = __builtin_elementwise_fma(h2, (f32x2){dv[2 * i], dv[2 * i + 1]}, d0); d1 = __builtin_elementwise_fma(h2, (f32x2){dv[16 + 2 * i], dv[17 + 2 * i]}, d1); } \
                pd[(base) + j] = d0[0] + d0[1]; pd[(base) + j + 1] = d1[0] + d1[1]; chain = pd[(base) + j + 1]; } } while (0)
#define CQ_REDUCE(m) do { float q8[8], q4[4], q2[2]; \
                _Pragma("unroll") for (int j = 0; j < 8; ++j) { const float snd = b3 ? pd[j] : pd[j + 8], kp = b3 ? pd[j + 8] : pd[j]; q8[j] = kp + dpp_xor8(snd); } \
                _Pragma("unroll") for (int j = 0; j < 4; ++j) { const float snd = b2 ? q8[j] : q8[j + 4], kp = b2 ? q8[j + 4] : q8[j]; q4[j] = kp + __shfl_xor(snd, 4); } \
                _Pragma("unroll") for (int j = 0; j < 2; ++j) { const float snd = b1 ? q4[j] : q4[j + 2], kp = b1 ? q4[j + 2] : q4[j]; q2[j] = kp + dpp_xor2(snd); } \
                const float q1 = (b0 ? q2[1] : q2[0]) + dpp_xor1(b0 ? q2[0] : q2[1]); \
                const int ad = k * 128 + 64 * (m) + 4 * chunk + slot; CL[ad] = q == 0 ? q1 : CL[ad] + q1; } while (0)
            int kn = k + 1, qn = q; if (kn == nk) { kn = 0; ++qn; }
            if (f + 1 == total) { kn = k; qn = q; }
            const __amdgpu_buffer_rsrc_t TN = CQ_TAB(WS_UB, qn);
            CQ_DOTS(A0, 0);
            { const int rn = gw + kn * nw; hn0 = __builtin_amdgcn_raw_buffer_load_b128(Hr, qn * 512 + chunk * 32, rn * 2048, 0); hn1 = __builtin_amdgcn_raw_buffer_load_b128(Hr, qn * 512 + chunk * 32 + 16, rn * 2048, 0); }
            CQ_LOAD(A0, TN, kn, 0);
            CQ_DOTS(A1, 8); CQ_LOAD(A1, TN, kn, 1); CQ_REDUCE(0);
            CQ_DOTS(A2, 0); CQ_LOAD(A2, TN, kn, 2);
            CQ_DOTS(A3, 8); CQ_LOAD(A3, TN, kn, 3); CQ_REDUCE(1);
            if (q == 3) {
                const float rstd = rsqrtf(wave_sum(fsq) * (0.25f / D) + EPS);
#pragma unroll
                for (int m = 0; m < 2; ++m) { const int ad = k * 128 + 64 * m + 4 * chunk + slot;
                    CL[ad] = fg[m] * fvs[m] * gelu_tanh(CL[ad] * rstd * fus[m]); }
            }
            k = kn; q = qn;
        }
#undef CQ_DOTS
#undef CQ_REDUCE
    }
    if (V4 && nk > 0) {
        const int slot8 = lane >> 3, chunk8 = lane & 7;
        const bool t2 = (slot8 & 4) != 0, t1 = (slot8 & 2) != 0, t0 = (slot8 & 1) != 0;
        struct VB4 { u32x4 r[4]; };
#define V4_TAB(qq) MKRSRC(a.ws + WS_VB + ((size_t)layer * 4 + (qq)) * NEXP * 128, NEXP * 128)
#define V4_LOAD(BUF, T, kk, bt) do { int ev[4]; _Pragma("unroll") for (int j = 0; j < 4; ++j) ev[j] = IDXL[(kk) * 128 + 32 * (bt) + 8 * j + slot8]; \
            asm volatile("" : "+v"(ev[0]), "+v"(ev[1]), "+v"(ev[2]), "+v"(ev[3])); \
            _Pragma("unroll") for (int j = 0; j < 4; ++j) BUF.r[j] = __builtin_amdgcn_raw_buffer_load_b128(T, ev[j] * 128 + chunk8 * 16, 0, 0); } while (0)
#define V4_DEC(W, E, o) do { E[(o) + 0] = __builtin_amdgcn_cvt_scalef32_pk_f32_fp4(W, 1.0f, 0); E[(o) + 1] = __builtin_amdgcn_cvt_scalef32_pk_f32_fp4(W, 1.0f, 1); E[(o) + 2] = __builtin_amdgcn_cvt_scalef32_pk_f32_fp4(W, 1.0f, 2); E[(o) + 3] = __builtin_amdgcn_cvt_scalef32_pk_f32_fp4(W, 1.0f, 3); } while (0)
#define V4_ACC(BUF, bt) do { float cf[4]; _Pragma("unroll") for (int j = 0; j < 4; ++j) cf[j] = CL[k * 128 + 32 * (bt) + 8 * j + slot8]; \
            asm volatile("" : "+v"(cf[0]), "+v"(cf[1]), "+v"(cf[2]), "+v"(cf[3])); \
            _Pragma("unroll") for (int j = 0; j < 4; ++j) { u32x4 w4 = BUF.r[j]; asm volatile("" : "+v"(w4), "+v"(y2[0]), "+v"(y2[15])); \
                f32x2 e[16]; V4_DEC(w4[0], e, 0); V4_DEC(w4[1], e, 4); V4_DEC(w4[2], e, 8); V4_DEC(w4[3], e, 12); const f32x2 c0 = (f32x2){cf[j], cf[j]}; \
                _Pragma("unroll") for (int i = 0; i < 16; ++i) y2[i] = __builtin_elementwise_fma(c0, e[i], y2[i]); } } while (0)
        VB4 A0, A1, A2, A3;
        { const __amdgpu_buffer_rsrc_t T0 = V4_TAB(0); V4_LOAD(A0, T0, 0, 0); V4_LOAD(A1, T0, 0, 1); V4_LOAD(A2, T0, 0, 2); V4_LOAD(A3, T0, 0, 3); }
        int q = 0, k = 0;
#pragma unroll 1
        for (int f = 0; f < total; ++f) {
            const int row = gw + k * nw;
            f32x2 y2[16];
#pragma unroll
            for (int j = 0; j < 16; ++j) y2[j] = (f32x2){0.f, 0.f};
            int kn = k + 1, qn = q; if (kn == nk) { kn = 0; ++qn; }
            if (f + 1 == total) { kn = k; qn = q; }
            const __amdgpu_buffer_rsrc_t TN = V4_TAB(qn);
            const int hoff = q * 512 + chunk8 * 64 + slot8 * 8;
            const u32x2 hr = __builtin_amdgcn_raw_buffer_load_b64(Hr, hoff, row * 2048, 0);
            V4_ACC(A0, 0); V4_LOAD(A0, TN, kn, 0);
            V4_ACC(A1, 1); V4_LOAD(A1, TN, kn, 1);
            V4_ACC(A2, 2); V4_LOAD(A2, TN, kn, 2);
            V4_ACC(A3, 3); V4_LOAD(A3, TN, kn, 3);
            float y16[16], y8[8], y4[4];
#pragma unroll
            for (int j = 0; j < 16; ++j) { const float ylo = y2[j >> 1][j & 1], yhi = y2[8 + (j >> 1)][j & 1]; const float snd = t2 ? ylo : yhi, kp = t2 ? yhi : ylo; y16[j] = kp + __shfl_xor(snd, 32); }
#pragma unroll
            for (int j = 0; j < 8; ++j) { const float snd = t1 ? y16[j] : y16[j + 8], kp = t1 ? y16[j + 8] : y16[j]; y8[j] = kp + __shfl_xor(snd, 16); }
#pragma unroll
            for (int j = 0; j < 4; ++j) { const float snd = t0 ? y8[j] : y8[j + 4], kp = t0 ? y8[j + 4] : y8[j]; y4[j] = kp + dpp_xor8(snd); }
            y4[0] += bflo(hr[0]); y4[1] += bfhi(hr[0]); y4[2] += bflo(hr[1]); y4[3] += bfhi(hr[1]);
            if (FINAL) {
                __builtin_amdgcn_raw_buffer_store_b128(__builtin_bit_cast(u32x4, (f32x4){y4[0], y4[1], y4[2], y4[3]}), Or, 2 * hoff, row * 4096, 0);
            } else {
                const unsigned w0 = pk2(y4[0], y4[1]), w1 = pk2(y4[2], y4[3]);
                const float a0 = bflo(w0), a1 = bfhi(w0), a2 = bflo(w1), a3 = bfhi(w1);
                const float ss = wave_sum((a0 * a0 + a1 * a1) + (a2 * a2 + a3 * a3));
                __builtin_amdgcn_raw_buffer_store_b64((u32x2){w0, w1}, Or, hoff, row * 2048, 0);
                if (lane == 0) { const float t = q == 0 ? ss : RSL[k] + ss; RSL[k] = t; if (q == 3) RSout[row] = rsqrtf(t * (1.f / D) + EPS); }
            }
            k = kn; q = qn;
        }
#undef V4_TAB
#undef V4_LOAD
#undef V4_DEC
#undef V4_ACC
    }
    if (!V4 && nk > 0) {
        QBatch A0, A1, A2, A3;
        { const __amdgpu_buffer_rsrc_t T0 = CQ_TAB(WS_VB, 0); CQ_LOAD(A0, T0, 0, 0); CQ_LOAD(A1, T0, 0, 1); CQ_LOAD(A2, T0, 0, 2); CQ_LOAD(A3, T0, 0, 3); }
        int q = 0, k = 0;
#pragma unroll 1
        for (int f = 0; f < total; ++f) {
            const int row = gw + k * nw;
            f32x2 y2[8];
#pragma unroll
            for (int j = 0; j < 8; ++j) y2[j] = (f32x2){0.f, 0.f};
#define CQ_ACC(BUF, bt) do { float cf[8]; _Pragma("unroll") for (int j = 0; j < 8; ++j) cf[j] = CL[k * 128 + 32 * (bt) + 4 * j + slot]; \
            asm volatile("" : "+v"(cf[0]), "+v"(cf[1]), "+v"(cf[2]), "+v"(cf[3]), "+v"(cf[4]), "+v"(cf[5]), "+v"(cf[6]), "+v"(cf[7]));     \
            _Pragma("unroll") for (int j = 0; j < 8; j += 2) { \
                u32x6 s6 = (u32x6){BUF.r[j][0], BUF.r[j][1], BUF.r[j][2], BUF.r[j + 1][0], BUF.r[j + 1][1], BUF.r[j + 1][2]}; \
                asm volatile("" : "+v"(s6), "+v"(y2[0]), "+v"(y2[1]), "+v"(y2[2]), "+v"(y2[3]), "+v"(y2[4]), "+v"(y2[5]), "+v"(y2[6]), "+v"(y2[7])); \
                const f32x32 dv = __builtin_amdgcn_cvt_scalef32_pk32_f32_fp6(s6, 1.0f); const f32x2 c0 = (f32x2){cf[j], cf[j]}, c1 = (f32x2){cf[j + 1], cf[j + 1]}; \
                _Pragma("unroll") for (int i = 0; i < 8; ++i) { y2[i] = __builtin_elementwise_fma(c0, (f32x2){dv[2 * i], dv[2 * i + 1]}, y2[i]); y2[i] = __builtin_elementwise_fma(c1, (f32x2){dv[16 + 2 * i], dv[17 + 2 * i]}, y2[i]); } } } while (0)
            int kn = k + 1, qn = q; if (kn == nk) { kn = 0; ++qn; }
            if (f + 1 == total) { kn = k; qn = q; }
            const __amdgpu_buffer_rsrc_t TN = CQ_TAB(WS_VB, qn);
            const int hoff = q * 512 + chunk * 32 + slot * 8;
            const u32x2 hr = __builtin_amdgcn_raw_buffer_load_b64(Hr, hoff, row * 2048, 0);
            CQ_ACC(A0, 0); CQ_LOAD(A0, TN, kn, 0);
            CQ_ACC(A1, 1); CQ_LOAD(A1, TN, kn, 1);
            CQ_ACC(A2, 2); CQ_LOAD(A2, TN, kn, 2);
            CQ_ACC(A3, 3); CQ_LOAD(A3, TN, kn, 3);
#undef CQ_ACC
            float y8[8], y4[4];
#pragma unroll
            for (int j = 0; j < 8; ++j) { const float ylo = y2[j >> 1][j & 1], yhi = y2[4 + (j >> 1)][j & 1]; const float snd = s1 ? ylo : yhi, kp = s1 ? yhi : ylo; y8[j] = kp + __shfl_xor(snd, 32); }
#pragma unroll
            for (int j = 0; j < 4; ++j) { const float snd = s0 ? y8[j] : y8[j + 4], kp = s0 ? y8[j + 4] : y8[j]; y4[j] = kp + __shfl_xor(snd, 16); }
            y4[0] += bflo(hr[0]); y4[1] += bfhi(hr[0]); y4[2] += bflo(hr[1]); y4[3] += bfhi(hr[1]);
            if (FINAL) {
                __builtin_amdgcn_raw_buffer_store_b128(__builtin_bit_cast(u32x4, (f32x4){y4[0], y4[1], y4[2], y4[3]}), Or, 2 * hoff, row * 4096, 0);
            } else {
                const unsigned w0 = pk2(y4[0], y4[1]), w1 = pk2(y4[2], y4[3]);
                const float a0 = bflo(w0), a1 = bfhi(w0), a2 = bflo(w1), a3 = bfhi(w1);
                const float ss = wave_sum((a0 * a0 + a1 * a1) + (a2 * a2 + a3 * a3));
                __builtin_amdgcn_raw_buffer_store_b64((u32x2){w0, w1}, Or, hoff, row * 2048, 0);
                if (lane == 0) { const float t = q == 0 ? ss : RSL[k] + ss; RSL[k] = t; if (q == 3) RSout[row] = rsqrtf(t * (1.f / D) + EPS); }
            }
            k = kn; q = qn;
        }
    }
#undef CQ_TAB
#undef CQ_LOAD
}

typedef short bf16x8_t __attribute__((ext_vector_type(8)));
__device__ __forceinline__ float fmax_asm(float a, float b) { float r; asm("v_max_f32 %0, %1, %2" : "=v"(r) : "v"(a), "v"(b)); return r; }
__device__ __forceinline__ float fmin_asm(float a, float b) { float r; asm("v_min_f32 %0, %1, %2" : "=v"(r) : "v"(a), "v"(b)); return r; }
#define CEF(a, b) do { const float _mx = fmax_asm(a, b), _mn = fmin_asm(a, b); a = _mx; b = _mn; } while (0)
template <int BASE, int N> __device__ __forceinline__ void sort16_desc(float (&x)[N]) {
#pragma unroll
    for (int p = 1; p < 16; p <<= 1)
#pragma unroll
        for (int k = p; k >= 1; k >>= 1)
#pragma unroll
            for (int j = k % p; j + k < 16; j += 2 * k)
#pragma unroll
                for (int i = 0; i < (k < 16 - j - k ? k : 16 - j - k); ++i)
                    if ((i + j) / (2 * p) == (i + j + k) / (2 * p)) CEF(x[BASE + i + j], x[BASE + i + j + k]);
}
template <int BASE, int N> __device__ __forceinline__ void bitonic_merge16_desc(float (&x)[N]) {
#pragma unroll
    for (int j = 8; j > 0; j >>= 1)
#pragma unroll
        for (int i = 0; i < 16; ++i) { const int l = i ^ j; if (l > i) CEF(x[BASE + i], x[BASE + l]); }
}
template <int A, int B, int N> __device__ __forceinline__ void merge_top16(float (&x)[N]) {
#pragma unroll
    for (int i = 0; i < 16; ++i) x[A + i] = fmax_asm(x[A + i], x[B + 15 - i]);
    bitonic_merge16_desc<A>(x);
}
__device__ __forceinline__ void xlane_merge16(float (&x)[16]) {
    float p[16];
#pragma unroll
    for (int i = 0; i < 16; ++i) p[i] = __shfl_xor(x[i], 32);
#pragma unroll
    for (int i = 0; i < 16; ++i) x[i] = fmax_asm(x[i], p[15 - i]);
    bitonic_merge16_desc<0>(x);
}
constexpr int cand_ai(int s) { return s < 16 ? 0 : s < 24 ? 1 : s < 25 ? 2 : -1; }
constexpr int cand_aj(int s) { return s < 16 ? s : s < 24 ? s - 16 : s < 25 ? 0 : -1; }
constexpr int cand_bi(int s) { return s < 4 ? 2 : s < 8 ? 3 : s < 11 ? 4 : s < 13 ? 5 : s < 15 ? 6 : s < 17 ? 7 : s < 25 ? s - 9 : -1; }
constexpr int cand_bj(int s) { return s < 4 ? s + 1 : s < 8 ? s - 4 : s < 11 ? s - 8 : s < 13 ? s - 11 : s < 15 ? s - 13 : s < 17 ? s - 15 : s < 25 ? 0 : -1; }
constexpr int KLDS_ROW = 272, KLDS_P = 128 * KLDS_ROW;

__device__ __forceinline__ void p5_topk_opt(const Args& a, int layer, const float* SSQ, int ntiles, LAS unsigned char* lds) {
    const int tid = opaque_tid(), lane = tid & 63, wave = __builtin_amdgcn_readfirstlane(tid >> 6), r32 = lane & 31, hi = lane >> 5;
    const int h = blockIdx.x & 7;
    const bf16_t* QP = (const bf16_t*)(a.ws + WS_P1);
    const bf16_t* KeysB = (const bf16_t*)(a.ws + WS_KEYS) + (size_t)layer * 2 * 8 * 128 * 128;
    int* IDX = (int*)(a.ws + WS_IDX); float* GATE = (float*)(a.ws + WS_GATE);
#pragma unroll
    for (int p = 0; p < 2; ++p)
#pragma unroll
        for (int i = 0; i < 4; ++i) { const int chunk = tid + 512 * i, key = chunk >> 4, c16 = chunk & 15;
            const u32x4 v = *(const u32x4*)(KeysB + ((size_t)(p * 8 + h) * 128 + key) * 128 + c16 * 8);
            *(LAS u32x4*)(lds + p * KLDS_P + key * KLDS_ROW + c16 * 16) = v; }
    __syncthreads();
    const int hi4 = hi * 4;
    const int tstep = (int)(gridDim.x >> 3);
    bf16x8_t qn[2][8];
#define TK_QFETCH(P, TT) do { const bf16_t* qp_ = QP + (size_t)((TT) * 256 + wave * 32 + r32) * 2048 + h * 256 + (P) * 128 + hi * 8; \
        _Pragma("unroll") for (int ks = 0; ks < 8; ++ks) qn[P][ks] = *(const bf16x8_t*)(qp_ + ks * 16); } while (0)
    { const int t0 = (int)(blockIdx.x >> 3); if (t0 < ntiles && t0 * 256 + wave * 32 < NROWS) { TK_QFETCH(0, t0); TK_QFETCH(1, t0); } }
    for (int t = (int)(blockIdx.x >> 3); t < ntiles; t += tstep) {
        const int row = t * 256 + wave * 32 + r32;
        if (t * 256 + wave * 32 >= NROWS) continue;
        const int tn = t + tstep; const bool nvalid = tn < ntiles && tn * 256 + wave * 32 < NROWS;
        asm volatile("" ::: "memory");
        float T[2][16];
#pragma unroll
        for (int p = 0; p < 2; ++p) {
            bf16x8_t qf[8];
#pragma unroll
            for (int ks = 0; ks < 8; ++ks) qf[ks] = qn[p][ks];
            f32x16 acc[4];
#pragma unroll
            for (int mt = 0; mt < 4; ++mt) {
                acc[mt] = (f32x16){0.f, 0.f, 0.f, 0.f, 0.f, 0.f, 0.f, 0.f, 0.f, 0.f, 0.f, 0.f, 0.f, 0.f, 0.f, 0.f};
#pragma unroll
                for (int ks = 0; ks < 8; ++ks) {
                    const bf16x8_t kf = *(const LAS bf16x8_t*)(lds + p * KLDS_P + (32 * mt + r32) * KLDS_ROW + ks * 32 + hi * 16);
                    acc[mt] = __builtin_amdgcn_mfma_f32_32x32x16_bf16(kf, qf[ks], acc[mt], 0, 0, 0);
                }
            }
            if (nvalid) { if (p == 0) TK_QFETCH(0, tn); else TK_QFETCH(1, tn); }
            __builtin_amdgcn_sched_barrier(0);
            float x[64];
#pragma unroll
            for (int mt = 0; mt < 4; ++mt)
#pragma unroll
                for (int rg = 0; rg < 16; ++rg) {
                    const unsigned code = 127u - (unsigned)(32 * mt + (rg & 3) + 8 * (rg >> 2));
                    x[16 * mt + rg] = __uint_as_float((__float_as_uint(acc[mt][rg]) & ~127u) | code);
                }
            sort16_desc<0>(x); sort16_desc<16>(x); sort16_desc<32>(x); sort16_desc<48>(x);
            merge_top16<0, 16>(x); merge_top16<32, 48>(x); merge_top16<0, 32>(x);
#pragma unroll
            for (int i = 0; i < 16; ++i) T[p][i] = __uint_as_float(__float_as_uint(x[i]) - (unsigned)hi4);
            xlane_merge16(T[p]);
        }
        float v0[16], v1[16]; unsigned long long k0lo = 0, k0hi = 0, k1lo = 0, k1hi = 0;
#pragma unroll
        for (int i = 0; i < 16; ++i) {
            const unsigned b0 = __float_as_uint(T[0][i]), b1 = __float_as_uint(T[1][i]);
            v0[i] = __uint_as_float(b0 & ~127u); v1[i] = __uint_as_float(b1 & ~127u);
            const unsigned long long e0 = 127u - (b0 & 127u), e1 = 127u - (b1 & 127u);
            if (i < 8) { k0lo |= e0 << (8 * i); k1lo |= e1 << (8 * i); } else { k0hi |= e0 << (8 * (i - 8)); k1hi |= e1 << (8 * (i - 8)); }
        }
        float cnd[32];
#pragma unroll
        for (int s = 0; s < 32; ++s) {
            if (cand_ai(s) >= 0) {
                const float ca = v0[cand_ai(s)] + v1[cand_aj(s)], cb = v0[cand_bi(s)] + v1[cand_bj(s)];
                const unsigned pa = (__float_as_uint(ca) & ~255u) | (255u - (unsigned)(16 * cand_ai(s) + cand_aj(s)));
                const unsigned pb = (__float_as_uint(cb) & ~255u) | (255u - (unsigned)(16 * cand_bi(s) + cand_bj(s)));
                cnd[s] = __uint_as_float(hi ? pb : pa);
            } else cnd[s] = __uint_as_float(0xff800000u);
        }
        sort16_desc<0>(cnd); sort16_desc<16>(cnd); merge_top16<0, 16>(cnd);
        float R[16];
#pragma unroll
        for (int i = 0; i < 16; ++i) R[i] = cnd[i];
        xlane_merge16(R);
        const f32x4 q0 = *(const f32x4*)(SSQ + (size_t)row * 16), q1 = *(const f32x4*)(SSQ + (size_t)row * 16 + 4), q2 = *(const f32x4*)(SSQ + (size_t)row * 16 + 8), q3 = *(const f32x4*)(SSQ + (size_t)row * 16 + 12);
        const float ssq = ((q0[0] + q0[1]) + (q0[2] + q0[3])) + ((q1[0] + q1[1]) + (q1[2] + q1[3])) + ((q2[0] + q2[1]) + (q2[2] + q2[3])) + ((q3[0] + q3[1]) + (q3[2] + q3[3]));
        const float rl = rsqrtf(ssq * (1.f / D) + EPS) * LOG2E;
        float e[16], esum = 0.f; unsigned ex[16];
        const float vtop = __uint_as_float(__float_as_uint(R[0]) & ~255u);
#pragma unroll
        for (int i = 0; i < 16; ++i) {
            const unsigned b = __float_as_uint(R[i]); const unsigned code = 255u - (b & 255u), ci = code >> 4, cj = code & 15u;
            e[i] = __builtin_amdgcn_exp2f((__uint_as_float(b & ~255u) - vtop) * rl); esum += e[i];
            const unsigned kk0 = (unsigned)(((ci & 8u) ? k0hi : k0lo) >> (8 * (ci & 7u))) & 127u, kk1 = (unsigned)(((cj & 8u) ? k1hi : k1lo) >> (8 * (cj & 7u))) & 127u;
            ex[i] = kk0 * 128u + kk1;
        }
        const float inv = 1.f / esum;
        unsigned* dst = hi ? (unsigned*)(GATE + (size_t)row * 128 + h * 16) : (unsigned*)(IDX + (size_t)row * 128 + h * 16);
#pragma unroll
        for (int q = 0; q < 4; ++q) { u32x4 w;
#pragma unroll
            for (int i = 0; i < 4; ++i) w[i] = hi ? __float_as_uint(e[4 * q + i] * inv) : ex[4 * q + i];
            *(u32x4*)(dst + 4 * q) = w; }
    }
}


#undef TK_QFETCH
constexpr int VT_PITCH = 144, VT_BYTES = 32 * VT_PITCH;
__device__ __forceinline__ void p2_attn_opt(const Args& a, bf16_t* MIX, LAS unsigned char* lds) {
    const int tid = opaque_tid(), lane = tid & 63, wave = __builtin_amdgcn_readfirstlane(tid >> 6), r32 = lane & 31, hi = lane >> 5;
    LAS unsigned char* vt = lds + wave * VT_BYTES;
    const bf16_t* P1 = (const bf16_t*)(a.ws + WS_P1);
    const int gw = wave * (int)gridDim.x + (int)blockIdx.x, nw = (int)gridDim.x * 8;
    constexpr int NSTRIP = NB * 8 * (SEQ / 32);
    for (int it = gw; it < NSTRIP + 8; it += nw) {
        int b, h, j, qrow0; bool meta_q;
        if (it < NSTRIP) { h = it & 7; const int sj = it >> 3; b = sj >> 9; j = sj & 511; qrow0 = b * SEQ + 32 * j; meta_q = false; }
        else { h = it - NSTRIP; b = 0; j = -1; qrow0 = MROW0; meta_q = true; }
        bf16x8_t qf[4];
#pragma unroll
        for (int ks = 0; ks < 4; ++ks) qf[ks] = *(const bf16x8_t*)(P1 + (size_t)(qrow0 + r32) * P1W + h * 64 + 16 * ks + 8 * hi);
        f32x16 o[2];
#pragma unroll
        for (int dt = 0; dt < 2; ++dt) o[dt] = (f32x16){0.f, 0.f, 0.f, 0.f, 0.f, 0.f, 0.f, 0.f, 0.f, 0.f, 0.f, 0.f, 0.f, 0.f, 0.f, 0.f};
        float carry = 0.f;
        int kt = j; bool diag = true;
        bf16x8_t kn[4]; u32x4 vn[4];
#define ATT_FETCH(KT) do { const int kr0_ = (KT) < 0 ? MROW0 : b * SEQ + 32 * (KT); \
            _Pragma("unroll") for (int ks = 0; ks < 4; ++ks) kn[ks] = *(const bf16x8_t*)(P1 + (size_t)(kr0_ + r32) * P1W + 512 + h * 64 + 16 * ks + 8 * hi); \
            _Pragma("unroll") for (int c4 = 0; c4 < 4; ++c4) { const int chunk = lane + 64 * c4, key = chunk >> 3, part = chunk & 7; \
                vn[c4] = *(const u32x4*)(P1 + (size_t)(kr0_ + key) * P1W + 1024 + h * 64 + part * 8); } } while (0)
        ATT_FETCH(kt);
        for (;;) {
            const bool is_meta = kt < 0;
            const int nvalid = is_meta ? NMETA : 32;
            bf16x8_t kf[4];
#pragma unroll
            for (int ks = 0; ks < 4; ++ks) kf[ks] = kn[ks];
#pragma unroll
            for (int c4 = 0; c4 < 4; ++c4) { const int chunk = lane + 64 * c4, key = chunk >> 3, part = chunk & 7;
                *(LAS u32x4*)(vt + key * VT_PITCH + part * 16) = vn[c4]; }
            if (!is_meta) ATT_FETCH(kt - 1);
            __builtin_amdgcn_sched_barrier(0);
            f32x16 sacc = (f32x16){0.f, 0.f, 0.f, 0.f, 0.f, 0.f, 0.f, 0.f, 0.f, 0.f, 0.f, 0.f, 0.f, 0.f, 0.f, 0.f};
#pragma unroll
            for (int ks = 0; ks < 4; ++ks) sacc = __builtin_amdgcn_mfma_f32_32x32x16_bf16(kf[ks], qf[ks], sacc, 0, 0, 0);
            float L[16]; bool ok[16];
#pragma unroll
            for (int rg = 0; rg < 16; ++rg) {
                const int kap = 8 * (rg >> 2) + 4 * hi + (rg & 3);
                ok[rg] = (kap < nvalid) && (!diag || kap < r32);
                const float z = sacc[rg], t = __builtin_amdgcn_exp2f(-__builtin_fabsf(z));
                const float l = __builtin_fmaxf(z, 0.f) + __builtin_amdgcn_logf(1.f + t);
                L[rg] = ok[rg] ? l : 0.f;
            }
            float G[4], PG[4];
#pragma unroll
            for (int g = 0; g < 4; ++g) { G[g] = (L[4 * g] + L[4 * g + 1]) + (L[4 * g + 2] + L[4 * g + 3]); PG[g] = __shfl_xor(G[g], 32); }
            float w[16]; float tot = 0.f;
#pragma unroll
            for (int g = 3; g >= 0; --g) {
                float run = tot + (hi == 0 ? PG[g] : 0.f);
#pragma unroll
                for (int i = 3; i >= 0; --i) { const int rg = 4 * g + i;
                    const float lw = (sacc[rg] - L[rg]) - run + carry;
                    w[rg] = ok[rg] ? __builtin_amdgcn_exp2f(lw) : 0.f;
                    run += L[rg]; }
                tot += G[g] + PG[g];
            }
            carry -= tot;
#pragma unroll
            for (int s2 = 0; s2 < 2; ++s2) {
                u32x4 pw;
#pragma unroll
                for (int q = 0; q < 4; ++q) pw[q] = pk2(w[8 * s2 + 2 * q], w[8 * s2 + 2 * q + 1]);
                const bf16x8_t pf = __builtin_bit_cast(bf16x8_t, pw);
#pragma unroll
                for (int dt = 0; dt < 2; ++dt) {
                    typedef short v4s_t __attribute__((ext_vector_type(4)));
                    const int tq = (lane & 15) >> 2, tp = lane & 3, tg = (lane >> 4) & 1;
                    const LAS unsigned char* tb = vt + (16 * s2 + 4 * hi + tq) * VT_PITCH + (32 * dt + 16 * tg + 4 * tp) * 2;
                    const v4s_t t0 = __builtin_amdgcn_ds_read_tr16_b64_v4i16((LAS v4s_t*)tb), t1 = __builtin_amdgcn_ds_read_tr16_b64_v4i16((LAS v4s_t*)(tb + 8 * VT_PITCH));
                    const bf16x8_t vw = (bf16x8_t){t0[0], t0[1], t0[2], t0[3], t1[0], t1[1], t1[2], t1[3]};
                    o[dt] = __builtin_amdgcn_mfma_f32_32x32x16_bf16(vw, pf, o[dt], 0, 0, 0);
                }
            }
            diag = false;
            if (is_meta) break;
            if (__all(carry < CARRY2_STOP)) break;
            --kt;
        }
#undef ATT_FETCH
        if (!meta_q || r32 < NMETA) {
            bf16_t* op = MIX + (size_t)(qrow0 + r32) * D + h * 64 + 4 * hi;
#pragma unroll
            for (int dt = 0; dt < 2; ++dt)
#pragma unroll
                for (int g = 0; g < 4; ++g) *(uint2*)(op + 32 * dt + 8 * g) = make_uint2(pk2(o[dt][4 * g], o[dt][4 * g + 1]), pk2(o[dt][4 * g + 2], o[dt][4 * g + 3]));
        }
    }
    const bf16_t* GB = P1 + 1536; const bf16_t* GC = P1 + 2048;
    {
        const int c8 = (tid & 63) * 8, rstep = (int)gridDim.x * 8;
        float cw[3][8];
#pragma unroll
        for (int t = 0; t < 3; ++t)
#pragma unroll
            for (int i = 0; i < 8; ++i) cw[t][i] = a.conv_w[t * 512 + c8 + i];
        const u32x4 z4 = (u32x4){0u, 0u, 0u, 0u};
#pragma unroll 1
        for (int row0 = (int)blockIdx.x * 8 + (tid >> 6); row0 < NROWS; row0 += 4 * rstep) {
            u32x4 u2[4], u1[4], u0[4], gb[4];
#pragma unroll
            for (int r = 0; r < 4; ++r) { const int row = row0 + r * rstep, rc = row < NROWS ? row : NROWS - 1;
                int b, p; rowpos(rc, b, p);
                u2[r] = *(const u32x4*)(GC + (size_t)rc * P1W + c8);
                u1[r] = p >= 1 ? *(const u32x4*)(GC + (size_t)prow(b, p - 1) * P1W + c8) : z4;
                u0[r] = p >= 2 ? *(const u32x4*)(GC + (size_t)prow(b, p - 2) * P1W + c8) : z4;
                gb[r] = *(const u32x4*)(GB + (size_t)rc * P1W + c8); }
#pragma unroll
            for (int r = 0; r < 4; ++r) { const int row = row0 + r * rstep;
                u32x4 ov;
#pragma unroll
                for (int q = 0; q < 4; ++q) {
                    const float ylo = cw[0][2 * q] * bflo(u0[r][q]) + cw[1][2 * q] * bflo(u1[r][q]) + cw[2][2 * q] * bflo(u2[r][q]);
                    const float yhi = cw[0][2 * q + 1] * bfhi(u0[r][q]) + cw[1][2 * q + 1] * bfhi(u1[r][q]) + cw[2][2 * q + 1] * bfhi(u2[r][q]);
                    ov[q] = pk2(ylo * bflo(gb[r][q]), yhi * bfhi(gb[r][q]));
                }
                if (row < NROWS) *(u32x4*)(MIX + (size_t)row * D + 512 + c8) = ov; }
        }
    }
}


typedef int v2i_t __attribute__((ext_vector_type(2)));
typedef int i32x8_t __attribute__((ext_vector_type(8)));
constexpr int OPT_LDS_C = 147456;

constexpr int MF_AT = 4352, MF_ST = 8704, MF_RS = 17920, MF_CM = 18048, MF_WLDS = 18176, MF_PITCH = 144;
static_assert(MF_WLDS * 8 <= OPT_LDS_C - 16, "per-wave gather LDS");
__device__ __forceinline__ unsigned fp4_enc(float x, float& f) {
    const float ax = fabsf(x);
    const float kf = ax < 2.f ? __builtin_rintf(ax * 2.f) : ax < 4.f ? __builtin_rintf(ax) + 2.f : __builtin_rintf(ax * 0.5f) + 4.f;
    unsigned m = (unsigned)kf; m = m > 7u ? 7u : m;
    const float mag = m < 4u ? 0.5f * (float)m : m == 4u ? 2.f : m == 5u ? 3.f : m == 6u ? 4.f : 6.f;
    f = x < 0.f ? -mag : mag;
    return m | (x < 0.f ? 8u : 0u);
}
template <bool FINAL>
__device__ __forceinline__ void p6_peer_mf(const Args& a, int layer, const bf16_t* H, const float* SSQ, bf16_t* Hout, float* RSout, int nrows, LAS unsigned char* lds) {
    const int tid = opaque_tid(), lane = tid & 63, wave = __builtin_amdgcn_readfirstlane(tid >> 6);
    const int gw = wave * (int)gridDim.x + (int)blockIdx.x, nw = (int)gridDim.x * 8;
    const int nk = gw < nrows ? (nrows - gw + nw - 1) / nw : 0;
    LAS unsigned char* wl = lds + wave * MF_WLDS;
    LAS unsigned short* IDXS = (LAS unsigned short*)wl; LAS unsigned char* AT = wl + MF_AT; LAS unsigned char* ST = wl + MF_ST;
    LAS int* CLI = (LAS int*)ST; LAS float* RSL = (LAS float*)(wl + MF_RS); LAS float* HSL = RSL; LAS float* CM = (LAS float*)(wl + MF_CM);
    const __amdgpu_buffer_rsrc_t USr = MKRSRC(a.ws + WS_UB + 32 * MiB + (size_t)layer * NEXP * 4, NEXP * 4), VSr = MKRSRC(a.ws + WS_VB + 32 * MiB + (size_t)layer * NEXP * 4, NEXP * 4);
    const __amdgpu_buffer_rsrc_t IDXr = MKRSRC(a.ws + WS_IDX, RP * 128 * 4), GATEr = MKRSRC(a.ws + WS_GATE, RP * 128 * 4);
    const __amdgpu_buffer_rsrc_t Hr = MKRSRC(H, RP * D * 2), SSQr = MKRSRC(SSQ, RP * 16 * 4);
    const __amdgpu_buffer_rsrc_t Or = FINAL ? MKRSRC(a.out, XROWS * D * 4) : MKRSRC(Hout, RP * D * 2);
    const __amdgpu_buffer_rsrc_t H8r = MKRSRC(a.ws + WS_P1, RP * 1024);
    const int slot8 = lane >> 3, chunk8 = lane & 7;
    const bool c2 = (chunk8 & 4) != 0, c1 = (chunk8 & 2) != 0, c0 = (chunk8 & 1) != 0;
    for (int k0 = 0; k0 < nk; k0 += 6) {
        int t0[6], t1[6];
#pragma unroll
        for (int j = 0; j < 6; ++j) { const int kk = k0 + j < nk ? k0 + j : nk - 1, row = gw + kk * nw;
            t0[j] = __builtin_amdgcn_raw_buffer_load_b32(IDXr, lane * 4, row * 512, 0); t1[j] = __builtin_amdgcn_raw_buffer_load_b32(IDXr, lane * 4 + 256, row * 512, 0); }
#pragma unroll
        for (int j = 0; j < 6; ++j) if (k0 + j < nk) { IDXS[(k0 + j) * 128 + lane] = (unsigned short)t0[j]; IDXS[(k0 + j) * 128 + 64 + lane] = (unsigned short)t1[j]; }
    }
    if (nk > 0) {
        for (int k0 = 0; k0 < nk; k0 += 4) {
            u32x4 ha[4], hb[4];
#pragma unroll
            for (int j = 0; j < 4; ++j) { const int kk = k0 + j < nk ? k0 + j : nk - 1, row = gw + kk * nw;
                ha[j] = __builtin_amdgcn_raw_buffer_load_b128(Hr, lane * 32, row * 2048, 0); hb[j] = __builtin_amdgcn_raw_buffer_load_b128(Hr, lane * 32 + 16, row * 2048, 0); }
#pragma unroll
            for (int j = 0; j < 4; ++j) if (k0 + j < nk) { const int row = gw + (k0 + j) * nw;
                float hv[16], am = 0.f;
#pragma unroll
                for (int i = 0; i < 4; ++i) { hv[2 * i] = bflo(ha[j][i]); hv[2 * i + 1] = bfhi(ha[j][i]); hv[8 + 2 * i] = bflo(hb[j][i]); hv[9 + 2 * i] = bfhi(hb[j][i]); }
#pragma unroll
                for (int i = 0; i < 16; ++i) am = fmaxf(am, fabsf(hv[i]));
#pragma unroll
                for (int o = 1; o < 64; o <<= 1) am = fmaxf(am, __shfl_xor(am, o));
                const float sc = am > 0.f ? am * (UI4 ? 1.f / 119.f : 1.f / 127.f) : 1.f, inv = 1.f / sc;
                unsigned w[4] = {0u, 0u, 0u, 0u};
                if (UI4) {
#pragma unroll
                    for (int i = 0; i < 16; ++i) { const int q = (int)__builtin_rintf(hv[i] * inv), hl = ((q + 8) & 15) - 8, hh = (q - hl) >> 4;
                        w[i >> 3] |= ((unsigned)hh & 0xfu) << (4 * (i & 7)); w[2 + (i >> 3)] |= ((unsigned)hl & 0xfu) << (4 * (i & 7)); }
                    __builtin_amdgcn_raw_buffer_store_b64((u32x2){w[0], w[1]}, H8r, lane * 8, row * 1024, 0); __builtin_amdgcn_raw_buffer_store_b64((u32x2){w[2], w[3]}, H8r, 512 + lane * 8, row * 1024, 0);
                } else {
#pragma unroll
                    for (int i = 0; i < 16; ++i) { const int q = (int)__builtin_rintf(hv[i] * inv); w[i >> 2] |= ((unsigned)q & 0xffu) << (8 * (i & 3)); }
                    __builtin_amdgcn_raw_buffer_store_b128((u32x4){w[0], w[1], w[2], w[3]}, H8r, lane * 16, row * 1024, 0);
                }
                if (lane == 0) HSL[k0 + j] = sc; }
        }
        __threadfence_block();
        struct UB4 { u32x4 r[4]; };
        constexpr int NSW = UI4 ? 4 : 8;
#define U8_TAB(ee) MKRSRC(a.ws + WS_UB + ((size_t)layer * NSW + (ee)) * NEXP * 128, NEXP * 128)
#define U8_LOAD(BUF, T, kk, bt) do { int ev[4]; _Pragma("unroll") for (int j = 0; j < 4; ++j) ev[j] = IDXS[(kk) * 128 + 32 * (bt) + 8 * j + slot8]; \
            asm volatile("" : "+v"(ev[0]), "+v"(ev[1]), "+v"(ev[2]), "+v"(ev[3])); \
            _Pragma("unroll") for (int j = 0; j < 4; ++j) BUF.r[j] = __builtin_amdgcn_raw_buffer_load_b128(T, ev[j] * 128 + chunk8 * 16, 0, 0); } while (0)
#define U8_DOTS(BUF, bt) do { _Pragma("unroll") for (int j = 0; j < 4; ++j) { const u32x4 w4 = BUF.r[j]; \
            if (UI4) { const int ah = __builtin_amdgcn_sdot8((int)w4[3], (int)h8[3], __builtin_amdgcn_sdot8((int)w4[2], (int)h8[2], __builtin_amdgcn_sdot8((int)w4[1], (int)h8[1], __builtin_amdgcn_sdot8((int)w4[0], (int)h8[0], 0, false), false), false), false); \
                const int al = __builtin_amdgcn_sdot8((int)w4[3], (int)h8l[3], __builtin_amdgcn_sdot8((int)w4[2], (int)h8l[2], __builtin_amdgcn_sdot8((int)w4[1], (int)h8l[1], __builtin_amdgcn_sdot8((int)w4[0], (int)h8l[0], 0, false), false), false), false); \
                pd[4 * (bt) + j] = ah * 16 + al; } \
            else pd[4 * (bt) + j] = __builtin_amdgcn_sdot4((int)w4[3], (int)h8[3], __builtin_amdgcn_sdot4((int)w4[2], (int)h8[2], __builtin_amdgcn_sdot4((int)w4[1], (int)h8[1], __builtin_amdgcn_sdot4((int)w4[0], (int)h8[0], 0, false), false), false), false); } } while (0)
        {
            UB4 A0, A1, A2, A3; u32x4 h8n, h8ln = (u32x4){0u, 0u, 0u, 0u};
            { const __amdgpu_buffer_rsrc_t T0 = U8_TAB(0);
              h8n = __builtin_amdgcn_raw_buffer_load_b128(H8r, chunk8 * 16, gw * 1024, 0);
              if (UI4) h8ln = __builtin_amdgcn_raw_buffer_load_b128(H8r, 512 + chunk8 * 16, gw * 1024, 0);
              U8_LOAD(A0, T0, 0, 0); U8_LOAD(A1, T0, 0, 1); U8_LOAD(A2, T0, 0, 2); U8_LOAD(A3, T0, 0, 3); }
            const int total8 = NSW * nk;
            int e = 0, k = 0;
#pragma unroll 1
            for (int f = 0; f < total8; ++f) {
                const int row = gw + k * nw;
                const u32x4 h8 = h8n, h8l = h8ln;
                const int ib = 8 * (c2 ? 1 : 0) + 4 * (c1 ? 1 : 0) + 2 * (c0 ? 1 : 0);
                float fus[2] = {0.f, 0.f}, fg[2] = {0.f, 0.f}, fsq = 0.f;
                if (e == NSW - 1) {
                    fsq = __builtin_bit_cast(float, __builtin_amdgcn_raw_buffer_load_b32(SSQr, (lane & 15) * 4, row * 64, 0));
#pragma unroll
                    for (int m = 0; m < 2; ++m) { const int n = 8 * (ib + m) + slot8, ex = IDXS[k * 128 + n];
                        fus[m] = __builtin_bit_cast(float, __builtin_amdgcn_raw_buffer_load_b32(USr, ex * 4, 0, 0));
                        fg[m] = __builtin_bit_cast(float, __builtin_amdgcn_raw_buffer_load_b32(GATEr, n * 4, row * 512, 0)); }
                }
                int kn = k + 1, en = e; if (kn == nk) { kn = 0; ++en; }
                if (f + 1 == total8) { kn = k; en = e; }
                const __amdgpu_buffer_rsrc_t TN = U8_TAB(en);
                int pd[16];
                U8_DOTS(A0, 0);
                h8n = __builtin_amdgcn_raw_buffer_load_b128(H8r, en * 128 + chunk8 * 16, (gw + kn * nw) * 1024, 0);
                if (UI4) h8ln = __builtin_amdgcn_raw_buffer_load_b128(H8r, 512 + en * 128 + chunk8 * 16, (gw + kn * nw) * 1024, 0);
                U8_LOAD(A0, TN, kn, 0);
                U8_DOTS(A1, 1); U8_LOAD(A1, TN, kn, 1);
                U8_DOTS(A2, 2); U8_LOAD(A2, TN, kn, 2);
                U8_DOTS(A3, 3); U8_LOAD(A3, TN, kn, 3);
                int q8[8], q4[4], q2[2];
#pragma unroll
                for (int j = 0; j < 8; ++j) { const int snd = c2 ? pd[j] : pd[j + 8], kp = c2 ? pd[j + 8] : pd[j]; q8[j] = kp + __shfl_xor(snd, 4); }
#pragma unroll
                for (int j = 0; j < 4; ++j) { const int snd = c1 ? q8[j] : q8[j + 4], kp = c1 ? q8[j + 4] : q8[j]; q4[j] = kp + __builtin_amdgcn_update_dpp(0, snd, 0x4E, 0xF, 0xF, true); }
#pragma unroll
                for (int j = 0; j < 2; ++j) { const int snd = c0 ? q4[j] : q4[j + 2], kp = c0 ? q4[j + 2] : q4[j]; q2[j] = kp + __builtin_amdgcn_update_dpp(0, snd, 0xB1, 0xF, 0xF, true); }
                if (e < NSW - 1) {
#pragma unroll
                    for (int m = 0; m < 2; ++m) { const int ad = k * 128 + 8 * (ib + m) + slot8; CLI[ad] = e == 0 ? q2[m] : CLI[ad] + q2[m]; }
                } else {
                    const float rstd = rsqrtf(wave_sum(fsq) * (0.25f / D) + EPS), hs = HSL[k];
                    float cv[2];
#pragma unroll
                    for (int m = 0; m < 2; ++m) { const int ad = k * 128 + 8 * (ib + m) + slot8;
                        const float dot = (float)(CLI[ad] + q2[m]) * hs;
                        const unsigned pk = __builtin_bit_cast(unsigned, fus[m]);
                        cv[m] = fg[m] * __builtin_bit_cast(float, pk & 0xffff0000u) * gelu_tanh(dot * rstd * __builtin_bit_cast(float, pk << 16)); }
                    float cm = fmaxf(fabsf(cv[0]), fabsf(cv[1]));
#pragma unroll
                    for (int o = 1; o < 64; o <<= 1) cm = fmaxf(cm, __shfl_xor(cm, o));
                    const float cmx = cm > 0.f ? cm : 1.f, s6 = 6.f / cmx;
                    float r0 = cv[0] * s6, r1 = cv[1] * s6;
                    const int ab = k * 256 + (c2 ? 32 : 0) + 8 * ((c1 ? 2 : 0) + (c0 ? 1 : 0)) + slot8;
#pragma unroll
                    for (int t = 0; t < 4; ++t) { float f0, f1; const unsigned n0 = fp4_enc(r0, f0), n1 = fp4_enc(r1, f1);
                        AT[ab + 64 * t] = (unsigned char)(n0 | (n1 << 4)); r0 = (r0 - f0) * 6.f; r1 = (r1 - f1) * 6.f; }
                    if (lane == 0) CM[k] = cmx;
                }
                k = kn; e = en;
            }
        }
#undef U8_TAB
#undef U8_LOAD
#undef U8_DOTS
        {
            const int m16 = lane & 15, g4 = lane >> 4;
            struct VB4 { u32x4 r[4]; };
#define V4_TAB(qq) MKRSRC(a.ws + WS_VB + ((size_t)layer * 4 + (qq)) * NEXP * 128, NEXP * 128)
#define V4_LOAD(BUF, T, kk, bt) do { int ev[4]; _Pragma("unroll") for (int j = 0; j < 4; ++j) ev[j] = IDXS[(kk) * 128 + 32 * (bt) + 8 * j + slot8]; \
                asm volatile("" : "+v"(ev[0]), "+v"(ev[1]), "+v"(ev[2]), "+v"(ev[3])); \
                _Pragma("unroll") for (int j = 0; j < 4; ++j) BUF.r[j] = __builtin_amdgcn_raw_buffer_load_b128(T, ev[j] * 128 + chunk8 * 16, 0, 0); } while (0)
#define MF_STAGE(BUF, bt) do { _Pragma("unroll") for (int j = 0; j < 4; ++j) { const int Ip = 4 * ((bt) & 1) + j; const u32x4 w_ = BUF.r[j]; \
                *(LAS u32x4*)(ST + (16 * (Ip >> 1) + 2 * slot8 + (Ip & 1)) * MF_PITCH + 16 * chunk8) = ((Ip >> 1) & 1) ? (u32x4){w_[2], w_[3], w_[0], w_[1]} : w_; } } while (0)
#define MF_MMA(hh) do { const i32x8_t av = (i32x8_t){(int)aop[hh][0], (int)aop[hh][1], 0, 0, 0, 0, 0, 0}; \
                _Pragma("unroll") for (int nb = 0; nb < 16; ++nb) { const v2i_t b = __builtin_amdgcn_ds_read_tr4_b64_v2i32((LAS v2i_t*)(ST + (16 * g4 + m16) * MF_PITCH + ((nb & 1) ? -8 : 8) * (g4 & 1) + 8 * nb)); \
                    acc[nb] = __builtin_amdgcn_mfma_scale_f32_16x16x128_f8f6f4(av, (i32x8_t){b[0], b[1], 0, 0, 0, 0, 0, 0}, acc[nb], 4, 4, 0, 0, 0, 0); } } while (0)
            VB4 A0, A1, A2, A3;
            { const __amdgpu_buffer_rsrc_t T0 = V4_TAB(0); V4_LOAD(A0, T0, 0, 0); V4_LOAD(A1, T0, 0, 1); V4_LOAD(A2, T0, 0, 2); V4_LOAD(A3, T0, 0, 3); }
            const int total = 4 * nk;
            int q = 0, k = 0;
#pragma unroll 1
            for (int f = 0; f < total; ++f) {
                const int row = gw + k * nw;
                f32x4 acc[16];
#pragma unroll
                for (int j = 0; j < 16; ++j) acc[j] = (f32x4){0.f, 0.f, 0.f, 0.f};
                u32x2 aop[2];
#pragma unroll
                for (int hh = 0; hh < 2; ++hh) { const u32x2 t = *(const LAS u32x2*)(AT + k * 256 + (m16 & 3) * 64 + hh * 32 + 8 * g4); aop[hh] = m16 < 4 ? t : (u32x2){0u, 0u}; }
                const float cmx = CM[k];
                int kn = k + 1, qn = q; if (kn == nk) { kn = 0; ++qn; }
                if (f + 1 == total) { kn = k; qn = q; }
                const __amdgpu_buffer_rsrc_t TN = V4_TAB(qn);
                const int hoff = q * 512 + m16 * 32;
                const u32x4 hr0 = __builtin_amdgcn_raw_buffer_load_b128(Hr, hoff, row * 2048, 0), hr1 = __builtin_amdgcn_raw_buffer_load_b128(Hr, hoff + 16, row * 2048, 0);
                MF_STAGE(A0, 0); V4_LOAD(A0, TN, kn, 0);
                MF_STAGE(A1, 1); V4_LOAD(A1, TN, kn, 1);
                MF_MMA(0);
                MF_STAGE(A2, 2); V4_LOAD(A2, TN, kn, 2);
                MF_STAGE(A3, 3); V4_LOAD(A3, TN, kn, 3);
                MF_MMA(1);
                float y[16];
#pragma unroll
                for (int nb = 0; nb < 16; ++nb) y[nb] = cmx * (acc[nb][0] * (1.f / 6.f) + acc[nb][1] * (1.f / 36.f) + acc[nb][2] * (1.f / 216.f) + acc[nb][3] * (1.f / 1296.f));
#pragma unroll
                for (int i = 0; i < 4; ++i) { y[2 * i] += bflo(hr0[i]); y[2 * i + 1] += bfhi(hr0[i]); y[8 + 2 * i] += bflo(hr1[i]); y[9 + 2 * i] += bfhi(hr1[i]); }
                if (FINAL) {
                    if (lane < 16) {
#pragma unroll
                        for (int i = 0; i < 4; ++i) __builtin_amdgcn_raw_buffer_store_b128(__builtin_bit_cast(u32x4, (f32x4){y[4 * i], y[4 * i + 1], y[4 * i + 2], y[4 * i + 3]}), Or, 2 * hoff + 16 * i, row * 4096, 0);
                    }
                } else {
                    unsigned w[8]; float ss = 0.f;
#pragma unroll
                    for (int i = 0; i < 8; ++i) { w[i] = pk2(y[2 * i], y[2 * i + 1]); const float a0 = bflo(w[i]), a1 = bfhi(w[i]); ss += a0 * a0 + a1 * a1; }
                    ss = wave_sum(lane < 16 ? ss : 0.f);
                    if (lane < 16) { __builtin_amdgcn_raw_buffer_store_b128((u32x4){w[0], w[1], w[2], w[3]}, Or, hoff, row * 2048, 0); __builtin_amdgcn_raw_buffer_store_b128((u32x4){w[4], w[5], w[6], w[7]}, Or, hoff + 16, row * 2048, 0); }
                    if (lane == 0) { const float t = q == 0 ? ss : RSL[k] + ss; RSL[k] = t; if (q == 3) RSout[row] = rsqrtf(t * (1.f / D) + EPS); }
                }
                k = kn; q = qn;
            }
#undef V4_TAB
#undef V4_LOAD
#undef MF_STAGE
#undef MF_MMA
        }
    }
}

constexpr int PF_SP = 528, PF_RS = 75520, PF_DT = 76096;
static_assert(PF_DT + 128 * PF_SP <= OPT_LDS_C - 16, "fused pooling LDS");
template <int W>
__device__ __forceinline__ void pf_diffs(LAS unsigned char* lds, int tid) {
    const int cp = tid & 127, rq = tid >> 7;
    const LAS float* RSv = (const LAS float*)(lds + PF_RS);
    float s0 = 0.f, s1 = 0.f;
#pragma unroll
    for (int j = 1; j < W; ++j) { const int i = 15 + 32 * rq - j; const unsigned hv = *(const LAS unsigned*)(lds + i * PF_SP + 4 * cp); const float rs = RSv[i]; s0 = __builtin_fmaf(bflo(hv), rs, s0); s1 = __builtin_fmaf(bfhi(hv), rs, s1); }
    constexpr float inv = 1.f / (float)W;
#pragma unroll 1
    for (int t0 = 0; t0 < 32; t0 += 4) {
        unsigned hn[4], ho[4]; float rn[4], ro[4];
#pragma unroll
        for (int t = 0; t < 4; ++t) { const int i = 15 + 32 * rq + t0 + t, io = i - W + 1;
            hn[t] = *(const LAS unsigned*)(lds + i * PF_SP + 4 * cp); ho[t] = *(const LAS unsigned*)(lds + io * PF_SP + 4 * cp); rn[t] = RSv[i]; ro[t] = -RSv[io]; }
        unsigned dv[4];
#pragma unroll
        for (int t = 0; t < 4; ++t) { const float n0 = bflo(hn[t]) * rn[t], n1 = bfhi(hn[t]) * rn[t];
            s0 += n0; s1 += n1;
            dv[t] = pg8::cvt_pk_bf16(__builtin_fmaf(s0, inv, -n0), __builtin_fmaf(s1, inv, -n1));
            s0 = __builtin_fmaf(bflo(ho[t]), ro[t], s0); s1 = __builtin_fmaf(bfhi(ho[t]), ro[t], s1); }
#pragma unroll
        for (int t = 0; t < 4; ++t) *(LAS unsigned*)(lds + PF_DT + (32 * rq + t0 + t) * PF_SP + 4 * cp) = dv[t];
    }
}
__device__ __forceinline__ void p78_pool_fused(const Args& a, LAS unsigned char* lds) {
    const int tid = opaque_tid(), lane = tid & 63, wave = __builtin_amdgcn_readfirstlane(tid >> 6), r32 = lane & 31, hi = lane >> 5;
    const bf16_t* H2 = (const bf16_t*)(a.ws + WS_XB); const float* RS2 = (const float*)(a.ws + WS_RS2); const bf16_t* PoolT = (const bf16_t*)(a.ws + WS_POOL);
    bf16_t* H3 = (bf16_t*)(a.ws + WS_H1); float* SSQ = (float*)(a.ws + WS_SSQ3);
    LAS float* RSv = (LAS float*)(lds + PF_RS);
    u32x4 sv[9]; float rv[9];
#define PF_FETCH(UU) do { const int t_ = opaque_tid(), rr_ = t_ >> 5, c16_ = t_ & 31; const int g_ = (UU) & 3, r0_ = ((UU) >> 2) * 128, b_ = r0_ >> 14, p0_ = (r0_ & (SEQ - 1)) + NMETA; \
        _Pragma("unroll") for (int ps = 0; ps < 9; ++ps) { const int i = ps * 16 + rr_, ic = i < 143 ? i : 142, row = ic < 15 ? prow(b_, p0_ - (15 - ic)) : r0_ + ic - 15; \
            sv[ps] = *(const u32x4*)(H2 + (size_t)row * D + g_ * 256 + 8 * c16_); rv[ps] = RS2[row]; } } while (0)
    if ((int)blockIdx.x < (XROWS / 128) * 4) PF_FETCH((int)blockIdx.x);
#pragma unroll 1
    for (int u = (int)blockIdx.x; u < (XROWS / 128) * 4; u += (int)gridDim.x) {
        const int g = u & 3, r0 = (u >> 2) * 128;
        bf16x8_t wf[16];
#pragma unroll
        for (int ks = 0; ks < 16; ++ks) wf[ks] = *(const bf16x8_t*)(PoolT + (size_t)(g * 256 + 32 * wave + r32) * 256 + 16 * ks + 8 * hi);
        { const int t_ = opaque_tid(), rr_ = t_ >> 5, c16_ = t_ & 31;
#pragma unroll
          for (int ps = 0; ps < 9; ++ps) { const int i = ps * 16 + rr_; if (i < 143) { *(LAS u32x4*)(lds + i * PF_SP + 16 * c16_) = sv[ps]; if (c16_ == 0) RSv[i] = rv[ps]; } } }
        { const int un = u + (int)gridDim.x; if (un < (XROWS / 128) * 4) PF_FETCH(un); }
        __builtin_amdgcn_sched_barrier(0);
        __syncthreads();
        { const int t_ = opaque_tid(); if (g == 0) pf_diffs<2>(lds, t_); else if (g == 1) pf_diffs<4>(lds, t_); else if (g == 2) pf_diffs<8>(lds, t_); else pf_diffs<16>(lds, t_); }
        __syncthreads();
        f32x16 acc[4];
#pragma unroll
        for (int mb = 0; mb < 4; ++mb) acc[mb] = (f32x16){0.f, 0.f, 0.f, 0.f, 0.f, 0.f, 0.f, 0.f, 0.f, 0.f, 0.f, 0.f, 0.f, 0.f, 0.f, 0.f};
        {
            bf16x8_t dfa[4];
#define PF_LDF(DST, ks) do { _Pragma("unroll") for (int mb = 0; mb < 4; ++mb) DST[mb] = *(const LAS bf16x8_t*)(lds + PF_DT + (32 * mb + r32) * PF_SP + 32 * (ks) + 16 * hi); } while (0)
#define PF_MMA(SRC, ks) do { _Pragma("unroll") for (int mb = 0; mb < 4; ++mb) acc[mb] = __builtin_amdgcn_mfma_f32_32x32x16_bf16(wf[ks], SRC[mb], acc[mb], 0, 0, 0); } while (0)
#pragma unroll
            for (int ks = 0; ks < 16; ++ks) { PF_LDF(dfa, ks); __builtin_amdgcn_sched_barrier(0); PF_MMA(dfa, ks); __builtin_amdgcn_sched_barrier(0); }
#undef PF_LDF
#undef PF_MMA
        }
        __syncthreads();
#pragma unroll
        for (int mb = 0; mb < 4; ++mb)
#pragma unroll
            for (int q = 0; q < 4; ++q)
                *(LAS u32x2*)(lds + PF_DT + (32 * mb + r32) * PF_SP + (32 * wave + 8 * q + 4 * hi) * 2) = (u32x2){pg8::cvt_pk_bf16(acc[mb][4 * q], acc[mb][4 * q + 1]), pg8::cvt_pk_bf16(acc[mb][4 * q + 2], acc[mb][4 * q + 3])};
        __syncthreads();
        {
            const int t_ = opaque_tid(), rr = t_ >> 5, c16 = t_ & 31;
#pragma unroll
            for (int ps = 0; ps < 8; ++ps) { const int r = ps * 16 + rr;
                const u32x4 ov = *(const LAS u32x4*)(lds + PF_DT + r * PF_SP + 16 * c16), hv = *(const LAS u32x4*)(lds + (15 + r) * PF_SP + 16 * c16);
                u32x4 w; float ss = 0.f;
#pragma unroll
                for (int j = 0; j < 4; ++j) { w[j] = pg8::cvt_pk_bf16(bflo(hv[j]) + bflo(ov[j]), bfhi(hv[j]) + bfhi(ov[j])); const float lo = bflo(w[j]), h2 = bfhi(w[j]); ss += lo * lo + h2 * h2; }
                *(u32x4*)(H3 + (size_t)(r0 + r) * D + g * 256 + 8 * c16) = w;
                ss += dpp_xor1(ss); ss += dpp_xor2(ss); ss += __shfl_xor(ss, 4);
                if ((c16 & 7) == 0) SSQ[(size_t)(r0 + r) * 16 + 4 * g + (c16 >> 3)] = ss; }
        }
        __syncthreads();
    }
#undef PF_FETCH
}
template <int F4> __device__ __forceinline__ void table_store(const f32x16& x, __amdgpu_buffer_rsrc_t T, int it, int lane, LAS unsigned char* tt) {
    if (F4 == 2) {
        unsigned w[4] = {0u, 0u, 0u, 0u};
#pragma unroll
        for (int i = 0; i < 16; ++i) { int q = (int)__builtin_rintf(x[i]); q = q > 127 ? 127 : q < -127 ? -127 : q; w[i >> 2] |= ((unsigned)q & 0xffu) << (8 * (i & 3)); }
        __builtin_amdgcn_raw_buffer_store_b128((u32x4){w[0], w[1], w[2], w[3]}, T, (lane & 7) * 16, (((it >> 14) * 8 + (lane >> 3)) * NEXP + (it & (NEXP - 1))) * 128, 0);
    } else if (F4 == 3) {
        unsigned w[2] = {0u, 0u};
#pragma unroll
        for (int i = 0; i < 16; ++i) { int q = (int)__builtin_rintf(x[i]); q = q > 7 ? 7 : q < -7 ? -7 : q; w[i >> 3] |= ((unsigned)q & 0xfu) << (4 * (i & 7)); }
        __builtin_amdgcn_raw_buffer_store_b64((u32x2){w[0], w[1]}, T, (lane & 15) * 8, (((it >> 14) * 4 + (lane >> 4)) * NEXP + (it & (NEXP - 1))) * 128, 0);
    } else if (F4 == 1) {
        unsigned w[2] = {0u, 0u};
#pragma unroll
        for (int i = 0; i < 16; ++i) { const float v = x[i], ax = fabsf(v);
            const float k = ax < 2.f ? __builtin_rintf(ax * 2.f) : ax < 4.f ? __builtin_rintf(ax) + 2.f : __builtin_rintf(ax * 0.5f) + 4.f;
            unsigned m = (unsigned)k; m = m > 7u ? 7u : m; const unsigned c = m | (v < 0.f ? 8u : 0u);
            w[i >> 3] |= c << (4 * (i & 7)); }
        if (VMF) {
            *(LAS u32x2*)(tt + lane * 8) = (u32x2){w[0], w[1]};
            const v2i_t t = __builtin_amdgcn_ds_read_tr4_b64_v2i32((LAS v2i_t*)(tt + lane * 8));
            w[0] = (unsigned)t[0]; w[1] = (unsigned)t[1];
        }
        if (CQ) __builtin_amdgcn_raw_buffer_store_b64((u32x2){w[0], w[1]}, T, (lane & 15) * 8, (((it >> 14) * 4 + (lane >> 4)) * NEXP + (it & (NEXP - 1))) * 128, 0);
        else __builtin_amdgcn_raw_buffer_store_b64((u32x2){w[0], w[1]}, T, lane * 8, it * 512, 0);
    } else {
        unsigned w[3] = {0u, 0u, 0u};
#pragma unroll
        for (int i = 0; i < 16; ++i) { const float v = x[i], ax = fabsf(v);
            const float k = ax < 2.f ? __builtin_rintf(ax * 8.f) : ax < 4.f ? __builtin_rintf(ax * 4.f) + 8.f : __builtin_rintf(ax * 2.f) + 16.f;
            unsigned m = (unsigned)k; m = m > 31u ? 31u : m; const unsigned c = m | (v < 0.f ? 32u : 0u);
            const int bp = 6 * i, wd = bp >> 5, sh = bp & 31;
            w[wd] |= c << sh; if (sh > 26) w[wd + 1] |= c >> (32 - sh); }
        if (CQ) __builtin_amdgcn_raw_buffer_store_b96((u32x3){w[0], w[1], w[2]}, T, (lane & 15) * 12, (((it >> 14) * 4 + (lane >> 4)) * NEXP + (it & (NEXP - 1))) * 192, 0);
        else __builtin_amdgcn_raw_buffer_store_b96((u32x3){w[0], w[1], w[2]}, T, lane * 12, it * 768, 0);
    }
}
constexpr int TT_PITCH = 132, TT_BYTES = 64 * TT_PITCH;
template <class SCol, class DRow, class NS>
__device__ __forceinline__ void tile_transpose(const float* src, int ldsrc, const float* ks, bf16_t* dst, int ldd, int k0, SCol scol, DRow drow, NS ns, LAS unsigned char* tt, int lane) {
    const int sc = scol(lane); const float nsv = ns(lane);
    float tv[64];
#pragma unroll
    for (int kk = 0; kk < 64; ++kk) tv[kk] = src[(size_t)(k0 + kk) * ldsrc + sc];
#pragma unroll
    for (int kk = 0; kk < 64; ++kk) {
        const float v = tv[kk] * (ks ? ks[k0 + kk] : 1.f) * nsv;
        *(LAS unsigned short*)(tt + lane * TT_PITCH + kk * 2) = f2bf(v);
    }
#pragma unroll
    for (int i = 0; i < 8; ++i) {
        const int c = lane + 64 * i, n = c >> 3, part = c & 7;
        const LAS unsigned* rp = (const LAS unsigned*)(tt + n * TT_PITCH + part * 16);
        u32x4 w; w[0] = rp[0]; w[1] = rp[1]; w[2] = rp[2]; w[3] = rp[3];
        *(u32x4*)(dst + (size_t)drow(n) * ldd + k0 + part * 8) = w;
    }
}
__device__ __forceinline__ void p0_prep_opt(const Args& a, LAS unsigned char* lds) {
    unsigned char* ws = a.ws;
    const int tid = opaque_tid(), lane = tid & 63, wave = __builtin_amdgcn_readfirstlane(tid >> 6);
    const int gw = (int)blockIdx.x * 8 + wave, nw = (int)gridDim.x * 8;
    const long gtid = (long)blockIdx.x * 512 + tid, gsz = (long)gridDim.x * 512;
    LAS unsigned char* tt = lds + wave * TT_BYTES;
    bf16_t* WinT = (bf16_t*)(ws + WS_WIN); bf16_t* WoutT = (bf16_t*)(ws + WS_WOUT); bf16_t* WqT = (bf16_t*)(ws + WS_WQ);
    bf16_t* KeysB = (bf16_t*)(ws + WS_KEYS); bf16_t* PoolT = (bf16_t*)(ws + WS_POOL);
    bf16_t* UB = (bf16_t*)(ws + WS_UB); bf16_t* VB = (bf16_t*)(ws + WS_VB); bf16_t* XB = (bf16_t*)(ws + WS_XB); float* RS0 = (float*)(ws + WS_RS0);
    constexpr int I_IN = 16 * 48, I_OUT = 16 * 16, I_Q = 2 * 16 * 32, I_POOL = 4 * 4 * 4;
    for (int it = gw; it < I_IN + I_OUT + I_Q + I_POOL; it += nw) {
        int r = it;
        if (r < I_IN) { const int kb = r / 48, u64 = r % 48;
            tile_transpose(a.w_in, INC, a.even_g, WinT, D, kb * 64, [=](int n) { return win_srccol(u64, n); }, [=](int n) { return win_btrow(u64, n); }, [](int) { return 1.f; }, tt, lane); continue; }
        r -= I_IN;
        if (r < I_OUT) { const int kb = r / 16, nb = r % 16;
            tile_transpose(a.w_out, D, nullptr, WoutT, D, kb * 64, [=](int n) { return nb * 64 + n; }, [=](int n) { return nb * 64 + n; }, [](int) { return 1.f; }, tt, lane); continue; }
        r -= I_OUT;
        if (r < I_Q) { const int l = r / 512, kb = (r % 512) / 32, nb = r % 32;
            tile_transpose(a.w_query + (size_t)l * D * 2048, 2048, a.ffn_g + l * D, WqT + (size_t)l * 2048 * D, D, kb * 64, [=](int n) { return nb * 64 + n; }, [=](int n) { return nb * 64 + n; }, [](int) { return 1.f; }, tt, lane); continue; }
        r -= I_Q;
        { const int g = r / 16, kb = (r % 16) / 4, nb = r % 4; const float* psc = a.pool_scale + g * 256 + nb * 64;
            tile_transpose(a.pool_w + (size_t)g * 256 * 256, 256, a.odd_g + g * 256, PoolT + (size_t)g * 256 * 256, 256, kb * 64, [=](int n) { return nb * 64 + n; }, [=](int n) { return nb * 64 + n; }, [=](int n) { return psc[n]; }, tt, lane); }
    }
    for (long i = gtid; i < 2L * 2 * 8 * 128 * 128 / 4; i += gsz) { const f32x4 v = *(const f32x4*)(a.sub_keys + i * 4); *(uint2*)(KeysB + i * 4) = make_uint2(pk2(v[0], v[1]), pk2(v[2], v[3])); }
    {
        const __amdgpu_buffer_rsrc_t UT = MKRSRC(ws + WS_UB, 2 * NEXP * USTRIDE), VT = MKRSRC(ws + WS_VB, 2 * NEXP * VSTRIDE);
        float* US = (float*)(ws + WS_UB + 32 * MiB); float* VS = (float*)(ws + WS_VB + 32 * MiB);
        f32x4 nu[4], nv[4], mu[4], mv[4];
#define TB_LD(U, V, itx) do { if ((itx) < 2 * NEXP) { _Pragma("unroll") for (int q = 0; q < 4; ++q) { U[q] = *(const f32x4*)(a.peer_u + (size_t)(itx) * D + 16 * lane + 4 * q); V[q] = *(const f32x4*)(a.peer_v + (size_t)(itx) * D + 16 * lane + 4 * q); } } } while (0)
        TB_LD(nu, nv, gw); TB_LD(mu, mv, gw + nw);
#pragma unroll 1
        for (int it = gw; it < 2 * NEXP; it += nw) {
            const int l = it >> 14;
            const float* gp = a.ffn_g + l * D + 16 * lane;
            f32x4 cu[4], cv[4];
#pragma unroll
            for (int q = 0; q < 4; ++q) { cu[q] = nu[q]; cv[q] = nv[q]; nu[q] = mu[q]; nv[q] = mv[q]; }
            TB_LD(mu, mv, it + 2 * nw);
            __builtin_amdgcn_sched_barrier(0);
            f32x16 u, v; float au = 0.f, av = 0.f, qu = 0.f;
#pragma unroll
            for (int q = 0; q < 4; ++q) { const f32x4 uu = cu[q] * *(const f32x4*)(gp + 4 * q), vv = cv[q];
#pragma unroll
                for (int i = 0; i < 4; ++i) { u[4 * q + i] = uu[i]; v[4 * q + i] = vv[i]; au = fmaxf(au, fabsf(uu[i])); av = fmaxf(av, fabsf(vv[i])); qu += uu[i] * uu[i]; } }
#pragma unroll
            for (int o = 1; o < 64; o <<= 1) { au = fmaxf(au, __shfl_xor(au, o)); av = fmaxf(av, __shfl_xor(av, o)); qu += __shfl_xor(qu, o); }
            if (UI4) au = fminf(au, 2.5f * sqrtf(qu * (1.f / D)));
            const float su = au > 0.f ? au * (UI4 ? 1.f / 7.f : U8 ? 1.f / 127.f : U4 ? 1.f / 6.f : 1.f / 7.5f) : 1.f, sv = av > 0.f ? av * (V4 ? 1.f / 6.f : 1.f / 7.5f) : 1.f;
            if (VMF) {
                const unsigned bu = (__builtin_bit_cast(unsigned, su) + 0xffffu) & 0xffff0000u, bv = (__builtin_bit_cast(unsigned, sv) + 0xffffu) & 0xffff0000u;
                u = u * (1.f / __builtin_bit_cast(float, bu)); v = v * (1.f / __builtin_bit_cast(float, bv));
                if (lane == 0) ((unsigned*)US)[it] = (bu >> 16) | bv;
            } else { u = u * (1.f / su); v = v * (1.f / sv); if (lane == 0) { US[it] = su; VS[it] = sv; } }
            table_store<UI4 ? 3 : U8 ? 2 : U4 ? 1 : 0>(u, UT, it, lane, tt); table_store<V4 ? 1 : 0>(v, VT, it, lane, tt);
        }
#undef TB_LD
    }
    {
        f32x4 nx[4], mx[4];
        auto xsrc = [&](int row) { return row < XROWS ? a.x + (size_t)row * D : a.meta + (size_t)(row < NROWS ? row - MROW0 : 0) * D; };
#define XR_LD(X, rw) do { if ((rw) < RP) { _Pragma("unroll") for (int j = 0; j < 4; ++j) X[j] = *(const f32x4*)(xsrc(rw) + 256 * j + 4 * lane); } } while (0)
        XR_LD(nx, gw); XR_LD(mx, gw + nw);
#pragma unroll 1
        for (int row = gw; row < RP; row += nw) {
            f32x4 cx[4];
#pragma unroll
            for (int j = 0; j < 4; ++j) { cx[j] = nx[j]; nx[j] = mx[j]; }
            XR_LD(mx, row + 2 * nw);
            __builtin_amdgcn_sched_barrier(0);
            bf16_t* o = XB + (size_t)row * D;
            if (row >= NROWS) { for (int j = 0; j < 4; ++j) *(uint2*)(o + 256 * j + 4 * lane) = make_uint2(0u, 0u); if (lane == 0) RS0[row] = 1.f; continue; }
            float ss = 0.f;
#pragma unroll
            for (int j = 0; j < 4; ++j) { const f32x4 v = cx[j]; ss += v[0] * v[0] + v[1] * v[1] + v[2] * v[2] + v[3] * v[3];
                *(uint2*)(o + 256 * j + 4 * lane) = make_uint2(pk2(v[0], v[1]), pk2(v[2], v[3])); }
            ss = wave_sum(ss);
            if (lane == 0) RS0[row] = rsqrtf(ss * (1.f / D) + EPS);
        }
    }
}
template <int W>
__device__ __forceinline__ void poold_run(const bf16_t* H2, const float* RS2, bf16_t* Dm, int row0, int c8) {
    const int b = row0 >> 14, p0 = (row0 & (SEQ - 1)) + NMETA;
    float s[8];
#pragma unroll
    for (int q = 0; q < 8; ++q) s[q] = 0.f;
#pragma unroll
    for (int j = 1; j < W; ++j) { const int r = prow(b, p0 - j); const float rs = RS2[r]; const u32x4 hv = *(const u32x4*)(H2 + (size_t)r * D + c8);
#pragma unroll
        for (int q = 0; q < 4; ++q) { s[2 * q] += bflo(hv[q]) * rs; s[2 * q + 1] += bfhi(hv[q]) * rs; } }
    constexpr float inv = 1.f / (float)W;
#pragma unroll 1
    for (int t0 = 0; t0 < 32; t0 += 8) {
        u32x4 hn[8], ho[8]; float rn[8], ro[8];
#pragma unroll
        for (int t = 0; t < 8; ++t) { const int p = p0 + t0 + t, r = row0 + t0 + t, po = prow(b, p - W + 1);
            hn[t] = *(const u32x4*)(H2 + (size_t)r * D + c8); rn[t] = RS2[r]; ho[t] = *(const u32x4*)(H2 + (size_t)po * D + c8); ro[t] = RS2[po]; }
#pragma unroll
        for (int t = 0; t < 8; ++t) { u32x4 ov;
#pragma unroll
            for (int q = 0; q < 4; ++q) { const float nl = bflo(hn[t][q]) * rn[t], nh = bfhi(hn[t][q]) * rn[t];
                s[2 * q] += nl; s[2 * q + 1] += nh;
                ov[q] = pk2(s[2 * q] * inv - nl, s[2 * q + 1] * inv - nh);
                s[2 * q] -= bflo(ho[t][q]) * ro[t]; s[2 * q + 1] -= bfhi(ho[t][q]) * ro[t]; }
            *(u32x4*)(Dm + (size_t)(row0 + t0 + t) * D + c8) = ov; }
    }
}
__device__ __forceinline__ void p7_poold_opt(const Args& a, bf16_t* Dm) {
    const bf16_t* H2 = (const bf16_t*)(a.ws + WS_XB); const float* RS2 = (const float*)(a.ws + WS_RS2);
    const int tid = opaque_tid(), lane = tid & 63, wave = __builtin_amdgcn_readfirstlane(tid >> 6);
    const int gw = wave * (int)gridDim.x + (int)blockIdx.x, nw = (int)gridDim.x * 8;
    for (int it = gw; it < (XROWS / 64) * 4; it += nw) {
        const int g = it & 3, row0 = ((it >> 2) * 2 + (lane >> 5)) * 32, c8 = g * 256 + (lane & 31) * 8;
        if (g == 0) poold_run<2>(H2, RS2, Dm, row0, c8);
        else if (g == 1) poold_run<4>(H2, RS2, Dm, row0, c8);
        else if (g == 2) poold_run<8>(H2, RS2, Dm, row0, c8);
        else poold_run<16>(H2, RS2, Dm, row0, c8);
    }
}


template <class BRow>
__device__ __forceinline__ bool meta_unit(const bf16_t* A, int lda, const bf16_t* Bt, BRow brow, f32x4 (&acc)[4], LAS unsigned char* lds, int wave, int lane) {
    const int n16 = lane & 15, kg = lane >> 4, k0 = 128 * wave + 8 * kg;
    bf16x8_t af[4], bfr[4][4];
#pragma unroll
    for (int ks = 0; ks < 4; ++ks) { af[ks] = *(const bf16x8_t*)(A + (size_t)n16 * lda + k0 + 32 * ks);
#pragma unroll
        for (int t = 0; t < 4; ++t) bfr[t][ks] = *(const bf16x8_t*)(Bt + (size_t)brow(16 * t + n16) * D + k0 + 32 * ks); }
#pragma unroll
    for (int t = 0; t < 4; ++t) { acc[t] = (f32x4){0.f, 0.f, 0.f, 0.f};
#pragma unroll
        for (int ks = 0; ks < 4; ++ks) acc[t] = __builtin_amdgcn_mfma_f32_16x16x32_bf16(af[ks], bfr[t][ks], acc[t], 0, 0, 0); }
    LAS f32x4* part = (LAS f32x4*)lds;
#pragma unroll
    for (int t = 0; t < 4; ++t) part[(wave * 4 + t) * 64 + lane] = acc[t];
    __syncthreads();
    if (wave == 0) {
#pragma unroll
        for (int t = 0; t < 4; ++t) { f32x4 sum = part[t * 64 + lane];
#pragma unroll
            for (int w = 1; w < 8; ++w) sum += part[(w * 4 + t) * 64 + lane];
            acc[t] = sum; }
    }
    __syncthreads();
    return wave == 0;
}
__device__ __forceinline__ void meta_p1(const Args& a, int u64, LAS unsigned char* lds, int wave, int lane) {
    unsigned char* ws = a.ws; bf16_t* P1 = (bf16_t*)(ws + WS_P1); const float* RS0 = (const float*)(ws + WS_RS0);
    f32x4 acc[4];
    if (!meta_unit((const bf16_t*)(ws + WS_XB) + (size_t)MROW0 * D, D, (const bf16_t*)(ws + WS_WIN), [=](int d) { return win_btrow(u64, d); }, acc, lds, wave, lane)) return;
    const int n16 = lane & 15, r4 = (lane >> 4) * 4;
    float sc4[4], gq[4];
#pragma unroll
    for (int i = 0; i < 4; ++i) sc4[i] = RS0[MROW0 + r4 + i];
#pragma unroll
    for (int t = 0; t < 4; ++t) gq[t] = u64 < 16 ? (u64 < 8 ? a.qg : a.kg)[16 * t + n16] : 1.f;
#pragma unroll
    for (int i = 0; i < 4; ++i) { const int row = MROW0 + r4 + i; const float sc = sc4[i];
        float v[4]; float ss = 0.f;
#pragma unroll
        for (int t = 0; t < 4; ++t) { v[t] = acc[t][i] * sc; ss += v[t] * v[t]; }
        bf16_t* o = P1 + (size_t)row * P1W;
        if (u64 < 16) {
            ss += __shfl_xor(ss, 1); ss += __shfl_xor(ss, 2); ss += __shfl_xor(ss, 4); ss += __shfl_xor(ss, 8);
            const float r = rsqrtf(ss * (1.f / 64.f) + EPS) * (u64 < 8 ? 0.125f * LOG2E : 1.f);
#pragma unroll
            for (int t = 0; t < 4; ++t) o[u64 * 64 + 16 * t + n16] = f2bf(v[t] * r * gq[t]);
        } else if (u64 < 32) {
#pragma unroll
            for (int t = 0; t < 4; ++t) o[u64 * 64 + 16 * t + n16] = f2bf(v[t]);
        } else {
            o[2048 + 32 * (u64 - 32) + n16] = f2bf(v[0] * v[2]); o[2048 + 32 * (u64 - 32) + 16 + n16] = f2bf(v[1] * v[3]);
        }
    }
}
__device__ __forceinline__ void meta_p3(const Args& a, int u, LAS unsigned char* lds, int wave, int lane) {
    unsigned char* ws = a.ws; bf16_t* H1 = (bf16_t*)(ws + WS_H1); float* SSQ1 = (float*)(ws + WS_SSQ1);
    f32x4 acc[4];
    if (!meta_unit((const bf16_t*)a.out + (size_t)MROW0 * D, D, (const bf16_t*)(ws + WS_WOUT), [=](int d) { return u * 64 + d; }, acc, lds, wave, lane)) return;
    const int n16 = lane & 15, r4 = (lane >> 4) * 4;
    float mres[4][4];
#pragma unroll
    for (int i = 0; i < 4; ++i)
#pragma unroll
        for (int t = 0; t < 4; ++t) mres[i][t] = a.meta[(size_t)(r4 + i) * D + u * 64 + 16 * t + n16];
#pragma unroll
    for (int i = 0; i < 4; ++i) { const int row = MROW0 + r4 + i; float ss = 0.f;
#pragma unroll
        for (int t = 0; t < 4; ++t) { const int col = u * 64 + 16 * t + n16; const bf16_t hb = f2bf(mres[i][t] + acc[t][i]); const float hv = bf2f(hb); ss += hv * hv; H1[(size_t)row * D + col] = hb; }
        ss += __shfl_xor(ss, 1); ss += __shfl_xor(ss, 2); ss += __shfl_xor(ss, 4); ss += __shfl_xor(ss, 8);
        if (n16 == 0) SSQ1[(size_t)row * 16 + u] = ss; }
}
__device__ __forceinline__ void meta_p4(const Args& a, int u, LAS unsigned char* lds, int wave, int lane) {
    unsigned char* ws = a.ws; bf16_t* QP = (bf16_t*)(ws + WS_P1);
    f32x4 acc[4];
    if (!meta_unit((const bf16_t*)(ws + WS_H1) + (size_t)MROW0 * D, D, (const bf16_t*)(ws + WS_WQ), [=](int d) { return u * 64 + d; }, acc, lds, wave, lane)) return;
    const int n16 = lane & 15, r4 = (lane >> 4) * 4;
#pragma unroll
    for (int i = 0; i < 4; ++i)
#pragma unroll
        for (int t = 0; t < 4; ++t) QP[(size_t)(MROW0 + r4 + i) * 2048 + u * 64 + 16 * t + n16] = f2bf(acc[t][i]);
}

constexpr int NPHASE = 12;
constexpr int OPT_THREADS = 512, OPT_LDS = 147456;

template <int PH> __device__ __forceinline__ void run_naive(const Args& a, long gtid, long gsz) {
    bf16_t* MIX = (bf16_t*)a.out;
    if (PH == 0) p0_prep(a, gtid, gsz);
    if (PH == 1) p1_gemm_in(a, gtid, gsz);
    if (PH == 2) p2_attn_conv(a, MIX, gtid, gsz);
    if (PH == 3) p3_gemm_out(a, MIX, gtid, gsz);
    if (PH == 4) p4_gemm_q(a, 0, (const bf16_t*)(a.ws + WS_H1), NROWS, gtid, gsz);
    if (PH == 5) p5_topk(a, 0, (const float*)(a.ws + WS_SSQ1), NROWS, gtid, gsz);
    if (PH == 6) p6_peer<false>(a, 0, (const bf16_t*)(a.ws + WS_H1), (const float*)(a.ws + WS_SSQ1), (bf16_t*)(a.ws + WS_XB), (float*)(a.ws + WS_RS2), NROWS, gtid, gsz);
    if (PH == 7) p7_poold(a, MIX, gtid, gsz);
    if (PH == 8) p8_gemm_pool(a, MIX, gtid, gsz);
    if (PH == 9) p4_gemm_q(a, 1, (const bf16_t*)(a.ws + WS_H1), XROWS, gtid, gsz);
    if (PH == 10) p5_topk(a, 1, (const float*)(a.ws + WS_SSQ3), XROWS, gtid, gsz);
    if (PH == 11) p6_peer<true>(a, 1, (const bf16_t*)(a.ws + WS_H1), (const float*)(a.ws + WS_SSQ3), nullptr, nullptr, XROWS, gtid, gsz);
}
template <int PH> __global__ void __launch_bounds__(256) k_naive(Args a) {
    run_naive<PH>(a, (long)blockIdx.x * blockDim.x + threadIdx.x, (long)gridDim.x * blockDim.x);
}

template <int PH> __device__ __forceinline__ void run_opt(const Args& a, LAS unsigned char* lds) {
    unsigned char* ws = a.ws;
    if (PH == 1) {
        pg8::Gemm g{(const bf16_t*)(ws + WS_XB), (const bf16_t*)(ws + WS_WIN), D, D, D, 0}; pg8::StaticOrder S; S.init(XROWS, INC, gridDim.x, blockIdx.x);
        pg8::EpiIn E{(bf16_t*)(ws + WS_P1), (const float*)(ws + WS_RS0), a.qg, a.kg};
        if (blockIdx.x < 48) { const int tid = opaque_tid(); meta_p1(a, (int)blockIdx.x, lds, __builtin_amdgcn_readfirstlane(tid >> 6), tid & 63); __syncthreads(); }
        pg8::gemm_phase<pg8::EpiIn, pg8::StaticOrder, true, true>(lds, g, S, E);
    }
    if (PH == 3) {
        pg8::Gemm g{(const bf16_t*)a.out, (const bf16_t*)(ws + WS_WOUT), D, D, D, 0}; pg8::StaticOrder S; S.init(XROWS, D, gridDim.x, blockIdx.x);
        pg8::EpiRes<0> E{a.x, a.meta, nullptr, (bf16_t*)(ws + WS_H1), (float*)(ws + WS_SSQ1)};
        if (blockIdx.x < 16) { const int tid = opaque_tid(); meta_p3(a, (int)blockIdx.x, lds, __builtin_amdgcn_readfirstlane(tid >> 6), tid & 63); __syncthreads(); }
        pg8::gemm_phase<pg8::EpiRes<0>, pg8::StaticOrder, true, true>(lds, g, S, E);
    }
    if (PH == 4 || PH == 9) {
        const int layer = PH == 4 ? 0 : 1;
        pg8::Gemm g{(const bf16_t*)(ws + WS_H1), (const bf16_t*)(ws + WS_WQ) + (size_t)layer * 2048 * D, D, D, D, 0}; pg8::StaticOrder S; S.init(XROWS, 2048, gridDim.x, blockIdx.x);
        pg8::EpiPlain E{(bf16_t*)(ws + WS_P1), 2048};
        if (PH == 4 && blockIdx.x < 32) { const int tid = opaque_tid(); meta_p4(a, (int)blockIdx.x, lds, __builtin_amdgcn_readfirstlane(tid >> 6), tid & 63); __syncthreads(); }
        pg8::gemm_phase<pg8::EpiPlain, pg8::StaticOrder, true, true>(lds, g, S, E);
    }
    if (PH == 0) p0_prep_opt(a, lds);
    if (PH == 7) p7_poold_opt(a, (bf16_t*)a.out);
    if (PH == 2) p2_attn_opt(a, (bf16_t*)a.out, lds);
    if (PH == 5) p5_topk_opt(a, 0, (const float*)(ws + WS_SSQ1), RP / 256, lds);
    if (PH == 10) p5_topk_opt(a, 1, (const float*)(ws + WS_SSQ3), XROWS / 256, lds);
    if (PH == 6 || PH == 11) {
        const int tid = opaque_tid(), lane = tid & 63, wave = __builtin_amdgcn_readfirstlane(tid >> 6);
        const int gw = wave * gridDim.x + blockIdx.x, nw = gridDim.x * 8;
        if (CQ && VMF) { if (PH == 6) p6_peer_mf<false>(a, 0, (const bf16_t*)(ws + WS_H1), (const float*)(ws + WS_SSQ1), (bf16_t*)(ws + WS_XB), (float*)(ws + WS_RS2), NROWS, lds);
                  else p6_peer_mf<true>(a, 1, (const bf16_t*)(ws + WS_H1), (const float*)(ws + WS_SSQ3), nullptr, nullptr, XROWS, lds); }
        else if (CQ) { if (PH == 6) p6_peer_cq<false>(a, 0, (const bf16_t*)(ws + WS_H1), (const float*)(ws + WS_SSQ1), (bf16_t*)(ws + WS_XB), (float*)(ws + WS_RS2), NROWS, lds);
                  else p6_peer_cq<true>(a, 1, (const bf16_t*)(ws + WS_H1), (const float*)(ws + WS_SSQ3), nullptr, nullptr, XROWS, lds); }
        else if (PH == 6) p6_peer6<false>(a, 0, (const bf16_t*)(ws + WS_H1), (const float*)(ws + WS_SSQ1), (bf16_t*)(ws + WS_XB), (float*)(ws + WS_RS2), NROWS, gw, nw, lane);
        else p6_peer6<true>(a, 1, (const bf16_t*)(ws + WS_H1), (const float*)(ws + WS_SSQ3), nullptr, nullptr, XROWS, gw, nw, lane);
    }
    if (PH == 8) {
        int kp = 256; asm volatile("" : "+s"(kp));
        pg8::Gemm g{(const bf16_t*)a.out, (const bf16_t*)(ws + WS_POOL), D, 256, kp, 256}; pg8::StaticOrder S; S.init(XROWS, D, gridDim.x, blockIdx.x);
        pg8::EpiRes<1> E{nullptr, nullptr, (const bf16_t*)(ws + WS_XB), (bf16_t*)(ws + WS_H1), (float*)(ws + WS_SSQ3)};
        pg8::gemm_phase<pg8::EpiRes<1>, pg8::StaticOrder, true, true>(lds, g, S, E);
    }
}
template <int PH> __global__ void __launch_bounds__(OPT_THREADS, 2) k_opt(Args a) {
    extern __shared__ __attribute__((aligned(16))) unsigned char lds_raw[];
    run_opt<PH>(a, (LAS unsigned char*)lds_raw);
}

template <int PH> static void launch_naive(const Args& a, hipStream_t s) { hipLaunchKernelGGL(k_naive<PH>, dim3(1024), dim3(256), 0, s, a); }
template <int PH> static void launch_opt(const Args& a, hipStream_t s) {
    static bool attr = false;
    if (!attr) { (void)hipFuncSetAttribute((const void*)k_opt<PH>, hipFuncAttributeMaxDynamicSharedMemorySize, OPT_LDS); attr = true; }
    hipLaunchKernelGGL(k_opt<PH>, dim3(256), dim3(OPT_THREADS), OPT_LDS, s, a);
}

#define XB_TMO      128
#define XB_XCNT(j)  (256  + 64 * (j))
#define XB_XSUB(j)  (1280 + 64 * (j))
#define XB_XGEN(j)  (2304 + 64 * (j))
#define XB_TOP      3328
#define XB_TOPGEN   3392
#define XCD_BAR_WORDS 3456
#define XB_SPIN_CAP (1u << 18)

__device__ __forceinline__ unsigned xb_ld(unsigned* p)              { return __hip_atomic_load(p, __ATOMIC_RELAXED, __HIP_MEMORY_SCOPE_AGENT); }
__device__ __forceinline__ unsigned xb_add(unsigned* p, unsigned v) { return __hip_atomic_fetch_add(p, v, __ATOMIC_RELAXED, __HIP_MEMORY_SCOPE_AGENT); }
__device__ __forceinline__ unsigned xb_xcc_id() { return (unsigned)__builtin_amdgcn_s_getreg((3 << 11) | 20) & 0xFu; }
#define XB_SPIN(cond, bar) do { unsigned _sp = 0; while (cond) { __builtin_amdgcn_s_sleep(1); \
    if ((++_sp & 255u) == 0u) { if (xb_ld(&(bar)[XB_TMO])) break; if (_sp > XB_SPIN_CAP) { atomicAdd(&(bar)[XB_TMO], 1u); break; } } } } while (0)

struct XcdBarrier {
    unsigned* bar; unsigned x;
    volatile LAS unsigned* st;
};

__device__ __forceinline__ XcdBarrier xcd_barrier_post(unsigned* bar, volatile LAS unsigned* st) {
    XcdBarrier b; b.bar = bar; b.x = xb_xcc_id(); b.st = st;
    if (threadIdx.x == 0) (void)xb_add(&bar[XB_XCNT(b.x)], 1u);
    return b;
}
__device__ __forceinline__ void xcd_barrier_complete(unsigned* bar, unsigned x, unsigned& nloc, unsigned& nx) {
    const unsigned G = gridDim.x * gridDim.y * gridDim.z;
    unsigned sum, cnt, mine, sp = 0u;
    for (;;) {
        sum = 0u; cnt = 0u; mine = 0u;
#pragma unroll
        for (unsigned j = 0; j < 16; ++j) { const unsigned c = xb_ld(&bar[XB_XCNT(j)]); sum += c; cnt += (c > 0u) ? 1u : 0u; mine = (j == x) ? c : mine; }
        if (sum == G) break;
        __builtin_amdgcn_s_sleep(1);
        if ((++sp & 255u) == 0u) { if (xb_ld(&bar[XB_TMO])) break; if (sp > XB_SPIN_CAP) { atomicAdd(&bar[XB_TMO], 1u); break; } }
    }
    nloc = mine > 0u ? mine : 1u; nx = cnt > 0u ? cnt : 1u;
}

__device__ __forceinline__ void xcd_barrier(const XcdBarrier& b) {
    asm volatile("s_waitcnt vmcnt(0)" ::: "memory");
    __syncthreads();
    if (threadIdx.x == 0) {
        unsigned* bar = b.bar;
        __builtin_amdgcn_s_waitcnt(0);
        unsigned nloc = b.st[0], nx = b.st[1];
        if (nloc == 0u) { xcd_barrier_complete(bar, b.x, nloc, nx); b.st[0] = nloc; b.st[1] = nx; }
        const unsigned old = xb_add(&bar[XB_XSUB(b.x)], 1u);
        const unsigned gen = old / nloc;
        if (old + 1u == (gen + 1u) * nloc) {
            __builtin_amdgcn_fence(__ATOMIC_RELEASE, "agent");
            asm volatile("s_waitcnt vmcnt(0)" ::: "memory");
            const unsigned og = xb_add(&bar[XB_TOP], 1u);
            const unsigned tg = og / nx;
            if (og + 1u == (tg + 1u) * nx) xb_add(&bar[XB_TOPGEN], 1u);
            else XB_SPIN(xb_ld(&bar[XB_TOPGEN]) == tg, bar);
            __builtin_amdgcn_fence(__ATOMIC_ACQUIRE, "agent");
            xb_add(&bar[XB_XGEN(b.x)], 1u);
            asm volatile("s_waitcnt vmcnt(0)" ::: "memory");
        } else {
            XB_SPIN(xb_ld(&bar[XB_XGEN(b.x)]) == gen, bar);
            __builtin_amdgcn_fence(__ATOMIC_ACQUIRE, "agent");
            asm volatile("s_waitcnt vmcnt(0)" ::: "memory");
        }
    }
    __syncthreads();
}


#define GRID_SYNC() xcd_barrier(bar)
#ifndef PROBE_MASK
#define PROBE_MASK 0
#endif
#define RUN(ph) do { run_opt<ph>(a, lds); if ((PROBE_MASK >> ph) & 1) { GRID_SYNC(); run_opt<ph>(a, lds); } } while (0)
__global__ void __launch_bounds__(OPT_THREADS, 2) mega(Args a) {
    extern __shared__ __attribute__((aligned(16))) unsigned char lds_raw[];
    LAS unsigned char* lds = (LAS unsigned char*)lds_raw;
    volatile LAS unsigned* st = (volatile LAS unsigned*)(lds + OPT_LDS - 16);
    if (threadIdx.x < 4) st[threadIdx.x] = 0u;
    __syncthreads();
    const XcdBarrier bar = xcd_barrier_post((unsigned*)(a.ws + WS_CTL), st);
    RUN(0); GRID_SYNC();
    RUN(1); GRID_SYNC();
    RUN(2); GRID_SYNC();
    RUN(3); GRID_SYNC();
    RUN(4); GRID_SYNC();
    RUN(5); GRID_SYNC();
    RUN(6); GRID_SYNC();
#ifndef POOL_FUSED
#define POOL_FUSED 1
#endif
#if POOL_FUSED
    p78_pool_fused(a, lds); GRID_SYNC();
#else
    RUN(7); GRID_SYNC();
    RUN(8); GRID_SYNC();
#endif
    RUN(9); GRID_SYNC();
    RUN(10); GRID_SYNC();
    RUN(11);
}

extern "C" void kernel_launch(void* const* d_in, const int* in_sizes, int n_in, void* d_out, int out_size, void* d_ws, size_t ws_size, hipStream_t stream) {
    if (n_in != 16 || ws_size < WS_END) { fprintf(stderr, "kernel_launch: unexpected n_in %d / ws %zu\n", n_in, ws_size); return; }
    Args a{};
    a.x = (const float*)d_in[0]; a.meta = (const float*)d_in[1]; a.even_g = (const float*)d_in[2]; a.w_in = (const float*)d_in[3]; a.qg = (const float*)d_in[4]; a.kg = (const float*)d_in[5];
    a.conv_w = (const float*)d_in[6]; a.w_out = (const float*)d_in[7]; a.odd_g = (const float*)d_in[8]; a.pool_w = (const float*)d_in[9]; a.pool_scale = (const float*)d_in[10];
    a.ffn_g = (const float*)d_in[11]; a.w_query = (const float*)d_in[12]; a.sub_keys = (const float*)d_in[13]; a.peer_u = (const float*)d_in[14]; a.peer_v = (const float*)d_in[15];
    a.out = (float*)d_out; a.ws = (unsigned char*)d_ws; a.ph_lo = 0; a.ph_hi = NPHASE;
    static int grid = 0;
    if (grid == 0) {
        int dev = 0, cus = 0, per_cu = 0;
        (void)hipGetDevice(&dev);
        (void)hipDeviceGetAttribute(&cus, hipDeviceAttributeMultiprocessorCount, dev);
        (void)hipFuncSetAttribute((const void*)mega, hipFuncAttributeMaxDynamicSharedMemorySize, OPT_LDS);
        (void)hipOccupancyMaxActiveBlocksPerMultiprocessor(&per_cu, (const void*)mega, OPT_THREADS, OPT_LDS);
        if (per_cu < 1) { fprintf(stderr, "kernel_launch: occupancy query returned %d\n", per_cu); per_cu = 1; }
        grid = cus * 1;
        if (grid % 8 != 0) grid -= grid % 8;
    }
    (void)hipMemsetAsync((char*)d_ws + WS_CTL, 0, 16384, stream);
    void* args[] = {&a};
    hipError_t e = hipLaunchCooperativeKernel((const void*)mega, dim3(grid), dim3(OPT_THREADS), args, OPT_LDS, stream);
    if (e != hipSuccess) fprintf(stderr, "cooperative launch failed: %s (grid %d)\n", hipGetErrorString(e), grid);
}
```
